# Optimizing an MI355X kernel written in HIP

```python
import math
import jax
import jax.numpy as jnp
from jax import lax
import numpy as np

D_MODEL = 2048
BATCH = 4
SEQ = 8192
DEPTH = 4

GRID_W = 64
CTX_LEN = 256
N_BRANCH = 4
D_BRANCH = D_MODEL // N_BRANCH
CHUNK = 128
GMLP_GROUPS = 4
GMLP_GW = D_BRANCH // GMLP_GROUPS
CONV_W = 31
HEAD_DIM = 64
N_Q_HEADS = D_BRANCH // HEAD_DIM
N_KV_HEADS = 2
Q_PER_KV = N_Q_HEADS // N_KV_HEADS
WINDOW = 128
BLOCK = 128
ROPE_BASE = 10000.0
S5_GW = 16
S5_GROUPS = D_BRANCH // S5_GW
S5_STATE = 64
D_FF = 4 * D_MODEL
N_MOD = 6
EPS = 1e-6
NEG_INF = -1e30
COLS_A = 2 * D_BRANCH
COLS_B = 2 * D_BRANCH
COLS_Q = N_Q_HEADS * HEAD_DIM
COLS_KV = N_KV_HEADS * HEAD_DIM
COLS_D = D_BRANCH
IN_COLS = COLS_A + COLS_B + COLS_Q + 2 * COLS_KV + COLS_D

kernel_name = 'hybrid_parallel_gmlp_conformer_swa_s5_dit'


def rms_norm(x, g):
    xf = x.astype(jnp.float32)
    y = xf * lax.rsqrt(jnp.mean(xf * xf, axis=-1, keepdims=True) + EPS)
    return (y * g.astype(jnp.float32)).astype(x.dtype)


def layer_norm(x, g, b):
    xf = x.astype(jnp.float32)
    xc = xf - jnp.mean(xf, axis=-1, keepdims=True)
    var = jnp.mean(xc * xc, axis=-1, keepdims=True)
    return (xc * lax.rsqrt(var + EPS) * g.astype(jnp.float32) + b.astype(jnp.float32)).astype(x.dtype)


def rope_1d(x, pos):
    d = x.shape[-1]
    inv = ROPE_BASE ** (-jnp.arange(0, d, 2, dtype=jnp.float32) / d)
    ang = pos.astype(jnp.float32)[:, None] * inv[None, :]
    cos = jnp.cos(ang)[:, None, :]
    sin = jnp.sin(ang)[:, None, :]
    xf = x.astype(jnp.float32)
    x1, x2 = xf[..., : d // 2], xf[..., d // 2:]
    return jnp.concatenate([x1 * cos - x2 * sin, x1 * sin + x2 * cos], axis=-1).astype(x.dtype)


def axial_rope(x, row, col):
    half = HEAD_DIM // 2
    return jnp.concatenate([rope_1d(x[..., :half], row), rope_1d(x[..., half:], col)], axis=-1)


def split_in(z):
    parts = []
    start = 0
    for width in (COLS_A, COLS_B, COLS_Q, COLS_KV, COLS_KV, COLS_D):
        parts.append(z[..., start:start + width])
        start += width
    return parts


def gmlp_chunk_mix(za, ln_g, ln_b, w_s, b_s):
    za = jax.nn.gelu(za)
    u, v = jnp.split(za, 2, axis=-1)
    v = layer_norm(v, ln_g, ln_b)
    B, L, _ = v.shape
    vb = v.reshape(B, L // CHUNK, CHUNK, GMLP_GROUPS, GMLP_GW)
    mixed = jnp.einsum('gpq,bnqgc->bnpgc', w_s, vb) + b_s.T[None, None, :, :, None]
    return u * mixed.reshape(B, L, D_BRANCH)


def conformer_conv(zb, w_dw, b_dw, ln_g, ln_b):
    a, g = jnp.split(zb, 2, axis=-1)
    y = a * jax.nn.sigmoid(g)
    y = lax.conv_general_dilated(
        y, w_dw[:, None, :], window_strides=(1,), padding=[(CONV_W // 2, CONV_W // 2)],
        dimension_numbers=('NWC', 'WIO', 'NWC'), feature_group_count=D_BRANCH) + b_dw
    return jax.nn.silu(layer_norm(y, ln_g, ln_b))


def windowed_attention(q, k, v, kc, vc, sink):
    B, S = q.shape[:2]
    nb = S // BLOCK
    scale = HEAD_DIM ** -0.5
    qb = q.reshape(B, nb, BLOCK, N_KV_HEADS, Q_PER_KV, HEAD_DIM)

    def band(t):
        tp = jnp.pad(t, ((0, 0), (BLOCK, BLOCK), (0, 0), (0, 0)))
        tp = tp.reshape(B, nb + 2, BLOCK, N_KV_HEADS, HEAD_DIM)
        return jnp.concatenate([tp[:, :-2], tp[:, 1:-1], tp[:, 2:]], axis=2)

    kb, vb = band(k), band(v)
    blk = jnp.arange(nb)[:, None, None]
    qpos = blk * BLOCK + jnp.arange(BLOCK)[None, :, None]
    kpos = (blk - 1) * BLOCK + jnp.arange(3 * BLOCK)[None, None, :]
    allowed = (jnp.abs(qpos - kpos) <= WINDOW) & (kpos >= 0) & (kpos < S)
    s_loc = jnp.einsum('bnqhgd,bnkhd->bnhgqk', qb, kb, preferred_element_type=jnp.float32) * scale
    s_loc = jnp.where(allowed[None, :, None, None], s_loc, NEG_INF)
    s_ctx = jnp.einsum('bnqhgd,bchd->bnhgqc', qb, kc, preferred_element_type=jnp.float32) * scale
    sink_col = jnp.broadcast_to(sink.astype(jnp.float32).reshape(1, 1, N_KV_HEADS, Q_PER_KV, 1, 1),
                                s_loc.shape[:-1] + (1,))
    p = jax.nn.softmax(jnp.concatenate([s_loc, s_ctx, sink_col], axis=-1), axis=-1)
    n_loc = 3 * BLOCK
    n_ctx = kc.shape[1]
    p_loc = p[..., :n_loc].astype(v.dtype)
    p_ctx = p[..., n_loc:n_loc + n_ctx].astype(v.dtype)
    o = (jnp.einsum('bnhgqk,bnkhd->bnqhgd', p_loc, vb)
         + jnp.einsum('bnhgqc,bchd->bnqhgd', p_ctx, vc))
    return o.reshape(B, S, N_Q_HEADS * HEAD_DIM)


def context_attention(qc, kc, vc, sink):
    B, C = qc.shape[:2]
    scale = HEAD_DIM ** -0.5
    qg = qc.reshape(B, C, N_KV_HEADS, Q_PER_KV, HEAD_DIM)
    s = jnp.einsum('bqhgd,bkhd->bhgqk', qg, kc, preferred_element_type=jnp.float32) * scale
    sink_col = jnp.broadcast_to(sink.astype(jnp.float32).reshape(1, N_KV_HEADS, Q_PER_KV, 1, 1),
                                s.shape[:-1] + (1,))
    p = jax.nn.softmax(jnp.concatenate([s, sink_col], axis=-1), axis=-1)
    o = jnp.einsum('bhgqk,bkhd->bqhgd', p[..., :C].astype(vc.dtype), vc)
    return o.reshape(B, C, N_Q_HEADS * HEAD_DIM)


def s5_discretise(a_re, a_im, log_step, b_re, b_im):
    lam = lax.complex(a_re.astype(jnp.float32), a_im.astype(jnp.float32))
    dt = jnp.exp(log_step.astype(jnp.float32))[:, None]
    log_lbar = lam * dt
    lbar = jnp.exp(log_lbar)
    b = lax.complex(b_re.astype(jnp.float32), b_im.astype(jnp.float32))
    bbar = ((lbar - 1.0) / lam)[..., None] * b
    return log_lbar, lbar, bbar


def _ssm_combine(left, right):
    a1, b1 = left
    a2, b2 = right
    return a1 * a2, a2 * b1 + b2


def s5_scan(u, disc, s0):
    log_lbar, lbar, bbar = disc
    bu = jnp.einsum('blgc,gpc->blgp', u.astype(jnp.float32).astype(jnp.complex64), bbar)
    a = jnp.broadcast_to(lbar, bu.shape)
    _, s = lax.associative_scan(_ssm_combine, (a, bu), axis=1)
    if s0 is not None:
        steps = jnp.arange(1, u.shape[1] + 1, dtype=jnp.float32)
        s = s + jnp.exp(log_lbar[None] * steps[:, None, None])[None] * s0[:, None]
    return s


def s5_readout(u, s_f, s_b, c_re, c_im, d_skip, w_glu):
    cf = lax.complex(c_re[0].astype(jnp.float32), c_im[0].astype(jnp.float32))
    cb = lax.complex(c_re[1].astype(jnp.float32), c_im[1].astype(jnp.float32))
    y = (jnp.einsum('gcp,blgp->blgc', cf, s_f) + jnp.einsum('gcp,blgp->blgc', cb, s_b)).real
    B, L = u.shape[:2]
    y = y.reshape(B, L, D_BRANCH) + d_skip.astype(jnp.float32) * u.reshape(B, L, D_BRANCH).astype(jnp.float32)
    y = jax.nn.gelu(y).astype(u.dtype)
    a, g = jnp.split(y @ w_glu, 2, axis=-1)
    return a * jax.nn.sigmoid(g)


def merge_branches(h, branches, w_br, w_gate, b_gate, w_out):
    merged = None
    for kb, br in enumerate(branches):
        term = jax.nn.sigmoid(h @ w_gate[kb] + b_gate[kb]) * (br @ w_br[kb])
        merged = term if merged is None else merged + term
    return merged @ w_out


def sq_relu_mlp(h, w1, w2):
    return jnp.square(jax.nn.relu(h @ w1)) @ w2


def setup_inputs(seed: int = 0) -> dict:
    key = jax.random.key(seed)
    keys = jax.random.split(key, 40)

    def nrm(i, shape, s):
        return jax.random.normal(keys[i], shape, jnp.float32) * s

    L, D, G, P = DEPTH, D_MODEL, S5_GROUPS, S5_STATE
    n_idx = jnp.arange(P, dtype=jnp.float32)
    return {
        'x': nrm(0, (BATCH, SEQ, D), 1.0),
        'c': nrm(1, (BATCH, D), 1.0),
        'ctx': nrm(2, (BATCH, CTX_LEN, D), 1.0),
        'c_ctx': nrm(3, (D,), 1.0),
        'w_mod': nrm(4, (L, D, N_MOD * D), 0.5 * D ** -0.5),
        'b_mod': nrm(5, (L, N_MOD * D), 0.02),
        'norm1_g': 1.0 + nrm(6, (L, D), 0.02),
        'norm2_g': 1.0 + nrm(7, (L, D), 0.02),
        'w_in': nrm(8, (L, D, IN_COLS), D ** -0.5),
        'gmlp_ln_g': 1.0 + nrm(9, (L, D_BRANCH), 0.02),
        'gmlp_ln_b': nrm(10, (L, D_BRANCH), 0.02),
        'gmlp_ws': nrm(11, (L, GMLP_GROUPS, CHUNK, CHUNK), CHUNK ** -0.5),
        'gmlp_bs': 1.0 + nrm(12, (L, GMLP_GROUPS, CHUNK), 0.02),
        'conv_w': nrm(13, (L, CONV_W, D_BRANCH), CONV_W ** -0.5),
        'conv_b': nrm(14, (L, D_BRANCH), 0.02),
        'conv_ln_g': 1.0 + nrm(15, (L, D_BRANCH), 0.02),
        'conv_ln_b': nrm(16, (L, D_BRANCH), 0.02),
        'attn_sink': nrm(17, (L, N_Q_HEADS), 0.5),
        's5_a_re': -0.5 + nrm(18, (L, 2, G, P), 0.01),
        's5_a_im': math.pi * n_idx + nrm(19, (L, 2, G, P), 0.01),
        's5_log_step': jax.random.uniform(keys[20], (L, 2, G), jnp.float32, math.log(1e-3), math.log(1e-1)),
        's5_b_re': nrm(21, (L, G, P, S5_GW), (2 * S5_GW) ** -0.5),
        's5_b_im': nrm(22, (L, G, P, S5_GW), (2 * S5_GW) ** -0.5),
        's5_c_re': nrm(23, (L, 2, G, S5_GW, P), 0.25),
        's5_c_im': nrm(24, (L, 2, G, S5_GW, P), 0.25),
        's5_d': nrm(25, (L, D_BRANCH), 0.5),
        's5_w_glu': nrm(26, (L, D_BRANCH, 2 * D_BRANCH), D_BRANCH ** -0.5),
        'w_branch': nrm(27, (L, N_BRANCH, D_BRANCH, D), D_BRANCH ** -0.5),
        'w_gate': nrm(28, (L, N_BRANCH, D, D), D ** -0.5),
        'b_gate': nrm(29, (L, N_BRANCH, D), 0.02),
        'w_out': nrm(30, (L, D, D), D ** -0.5),
        'w_ff1': nrm(31, (L, D, D_FF), D ** -0.5),
        'w_ff2': nrm(32, (L, D_FF, D), D_FF ** -0.5),
        'final_g': 1.0 + nrm(33, (D,), 0.02),
    }


def reference(x, c, ctx, c_ctx, w_mod, b_mod, norm1_g, norm2_g, w_in,
              gmlp_ln_g, gmlp_ln_b, gmlp_ws, gmlp_bs,
              conv_w, conv_b, conv_ln_g, conv_ln_b,
              attn_sink,
              s5_a_re, s5_a_im, s5_log_step, s5_b_re, s5_b_im, s5_c_re, s5_c_im, s5_d, s5_w_glu,
              w_branch, w_gate, b_gate, w_out, w_ff1, w_ff2, final_g):
    B, S, _ = x.shape
    n_ctx = ctx.shape[1]
    rows = S // GRID_W
    row = jnp.repeat(jnp.arange(rows), GRID_W)
    col = jnp.tile(jnp.arange(GRID_W), rows)
    cond_x = jax.nn.silu(c)
    cond_c = jax.nn.silu(c_ctx)
    for l in range(DEPTH):
        mod_x = (cond_x @ w_mod[l] + b_mod[l])[:, None, :]
        mod_c = cond_c @ w_mod[l] + b_mod[l]
        shift1, scale1, gate1, shift2, scale2, gate2 = jnp.split(mod_x, N_MOD, axis=-1)
        cshift1, cscale1, cgate1, cshift2, cscale2, cgate2 = jnp.split(mod_c, N_MOD, axis=-1)
        disc_f = s5_discretise(s5_a_re[l, 0], s5_a_im[l, 0], s5_log_step[l, 0], s5_b_re[l], s5_b_im[l])
        disc_b = s5_discretise(s5_a_re[l, 1], s5_a_im[l, 1], s5_log_step[l, 1], s5_b_re[l], s5_b_im[l])

        hc = rms_norm(ctx, norm1_g[l]) * (1.0 + cscale1) + cshift1
        zc_a, zc_b, qc, kc, vc, zc_d = split_in(hc @ w_in[l])
        kc = kc.reshape(B, n_ctx, N_KV_HEADS, HEAD_DIM)
        vc = vc.reshape(B, n_ctx, N_KV_HEADS, HEAD_DIM)
        uc = zc_d.reshape(B, n_ctx, S5_GROUPS, S5_GW)
        sc_f = s5_scan(uc, disc_f, None)
        sc_b_rev = s5_scan(jnp.flip(uc, 1), disc_b, None)

        h = rms_norm(x, norm1_g[l]) * (1.0 + scale1) + shift1
        z_a, z_b, q, k, v, z_d = split_in(h @ w_in[l])
        q = axial_rope(q.reshape(B, S, N_Q_HEADS, HEAD_DIM), row, col)
        k = axial_rope(k.reshape(B, S, N_KV_HEADS, HEAD_DIM), row, col)
        v = v.reshape(B, S, N_KV_HEADS, HEAD_DIM)
        u = z_d.reshape(B, S, S5_GROUPS, S5_GW)
        s_f = s5_scan(u, disc_f, sc_f[:, -1])
        s_b = jnp.flip(s5_scan(jnp.flip(u, 1), disc_b, sc_b_rev[:, -1]), 1)
        branches = (
            gmlp_chunk_mix(z_a, gmlp_ln_g[l], gmlp_ln_b[l], gmlp_ws[l], gmlp_bs[l]),
            conformer_conv(z_b, conv_w[l], conv_b[l], conv_ln_g[l], conv_ln_b[l]),
            windowed_attention(q, k, v, kc, vc, attn_sink[l]),
            s5_readout(u, s_f, s_b, s5_c_re[l], s5_c_im[l], s5_d[l], s5_w_glu[l]),
        )
        x = x + gate1 * merge_branches(h, branches, w_branch[l], w_gate[l], b_gate[l], w_out[l])
        h2 = rms_norm(x, norm2_g[l]) * (1.0 + scale2) + shift2
        x = x + gate2 * sq_relu_mlp(h2, w_ff1[l], w_ff2[l])

        if l < DEPTH - 1:
            branches_c = (
                gmlp_chunk_mix(zc_a, gmlp_ln_g[l], gmlp_ln_b[l], gmlp_ws[l], gmlp_bs[l]),
                conformer_conv(zc_b, conv_w[l], conv_b[l], conv_ln_g[l], conv_ln_b[l]),
                context_attention(qc, kc, vc, attn_sink[l]),
                s5_readout(uc, sc_f, jnp.flip(sc_b_rev, 1), s5_c_re[l], s5_c_im[l], s5_d[l], s5_w_glu[l]),
            )
            ctx = ctx + cgate1 * merge_branches(hc, branches_c, w_branch[l], w_gate[l], b_gate[l], w_out[l])
            hc2 = rms_norm(ctx, norm2_g[l]) * (1.0 + cscale2) + cshift2
            ctx = ctx + cgate2 * sq_relu_mlp(hc2, w_ff1[l], w_ff2[l])
    return rms_norm(x, final_g)
```

```cpp
#include <hip/hip_runtime.h>
#include <cstdio>
#include <cstdint>

namespace pg8 {
#define PG8_LAS __attribute__((address_space(3)))
typedef unsigned short bf16_t;
typedef short bf16x8 __attribute__((ext_vector_type(8)));
typedef float f32x4 __attribute__((ext_vector_type(4)));
typedef unsigned u32x4 __attribute__((ext_vector_type(4)));
constexpr int BM = 256, BK = 64, HALF = 128, HTB = HALF * BK * 2  , STAGE_BYTES = 8 * HTB, NXCD = 8, WGM = 8;

__host__ __device__ __forceinline__ int lds_byte(int r, int c) { const int st = (r >> 4) * 2 + (c >> 5), rr = r & 15, cc = c & 31, ob = rr * 64 + cc * 2; return st * 1024 + (ob ^ (((ob >> 9) & 1) << 5)); }
__host__ __device__ __forceinline__ void stage_rc(int b, int& R, int& C) { const int st = b / 1024, sb = b % 1024, swz = sb ^ (((sb >> 9) & 1) << 5); R = (st >> 1) * 16 + swz / 64; C = (st & 1) * 32 + (swz % 64) / 2; }
__host__ __device__ __forceinline__ int perm32(int rho) { const int n = rho >> 4, i = rho & 15; return 8 * (i >> 2) + 4 * n + (i & 3); }

struct Unit { int pm, pn; };
struct Gemm { const bf16_t* A; const bf16_t* Bt; int M, N, K, pad; };

struct StaticOrder {
    int nM, nN, nwg, G, c;
    __host__ __device__ void init(int M, int N, int G_, int c_) { nM = M / BM; nN = N / BM; nwg = nM * nN; G = G_; c = c_; }
    __host__ __device__ bool next(int i, Unit& u) const {
        const long L = (long)i * G + c; if (L >= nwg) return false;
        int wgid = (int)L; { const int q = nwg / NXCD, r = nwg % NXCD, xcd = wgid % NXCD, off = wgid / NXCD; wgid = (xcd < r ? xcd * (q + 1) : r * (q + 1) + (xcd - r) * q) + off; }
        const int nig = WGM * nN, gid = wgid / nig, fm = gid * WGM, gsz = (nM - fm) < WGM ? (nM - fm) : WGM;
        u.pm = fm + ((wgid % nig) % gsz); u.pn = (wgid % nig) / gsz; return true;
    }
    __device__ __forceinline__ void a_ready(const Unit&) const {}
    __device__ __forceinline__ void done(const Unit&) const {}
};


template <class Epi, class Sched, bool ALIGN_EPI = false, bool SP2 = false>
__device__ __forceinline__ void gemm_phase(PG8_LAS unsigned char* lds, const Gemm g, const Sched& S, const Epi& E) {
    const int tid = threadIdx.x, wid = __builtin_amdgcn_readfirstlane(tid >> 6), lane = tid & 63, wr = wid >> 2, wc = wid & 3, fr = lane & 15, fq = lane >> 4;
    const int K = g.K, nt = K / BK;
    unsigned voffA[2], voffB[2];
#pragma unroll
    for (int i = 0; i < 2; ++i) { int R, C; stage_rc(tid * 16 + i * 8192, R, C); const int Rb = Epi::PERM ? ((R & ~31) + perm32(R & 31)) : R;
        voffA[i] = (unsigned)(R * K + C) * 2u; voffB[i] = (unsigned)(Rb * K + C) * 2u; }
    const size_t kstep = (size_t)(BK * 2);
    const size_t hstep = (size_t)HALF * K * 2;
    const size_t tstep = 2 * hstep;
    const unsigned ldsw = (unsigned)wid * 1024u;
    const int aoff = lds_byte(wr * 64 + fr, fq * 8), boff = lds_byte(wc * 32 + fr, fq * 8);
#define PG8_SA(b, h) (((b) * 2 + (h)) * HTB)
#define PG8_SB(b, h) ((4 + (b) * 2 + (h)) * HTB)
#define PG8_STAGE(bufoff, gbase, voff) do { _Pragma("unroll") for (int _i = 0; _i < 2; ++_i) \
        __builtin_amdgcn_global_load_lds((const unsigned*)((const char*)(gbase) + (voff)[_i]), (PG8_LAS unsigned*)(lds + (bufoff) + ldsw + _i * 8192), 16, 0, 0); } while (0)
#define PG8_LDA(dst, b, h) do { _Pragma("unroll") for (int m = 0; m < 4; ++m) _Pragma("unroll") for (int k = 0; k < 2; ++k) dst[m][k] = *(const PG8_LAS bf16x8*)(lds + PG8_SA(b, h) + aoff + m * 2048 + k * 1024); } while (0)
#define PG8_LDB(dst, b, h) do { _Pragma("unroll") for (int n = 0; n < 2; ++n) _Pragma("unroll") for (int k = 0; k < 2; ++k) dst[n][k] = *(const PG8_LAS bf16x8*)(lds + PG8_SB(b, h) + boff + n * 2048 + k * 1024); } while (0)
#define PG8_MMA(ai, bj, At, Bt) do { __builtin_amdgcn_s_setprio(1); _Pragma("unroll") for (int m = 0; m < 4; ++m) _Pragma("unroll") for (int n = 0; n < 2; ++n) _Pragma("unroll") for (int k = 0; k < 2; ++k) \
        acc[ai][bj][m][n] = __builtin_amdgcn_mfma_f32_16x16x32_bf16(Bt[n][k], At[m][k], acc[ai][bj][m][n], 0, 0, 0); __builtin_amdgcn_s_setprio(0); } while (0)
#define PG8_WAIT_V(n) asm volatile("s_waitcnt vmcnt(" #n ")" ::: "memory")
#define PG8_WAIT_L(n) asm volatile("s_waitcnt lgkmcnt(" #n ")" ::: "memory")
#define PG8_BAR __builtin_amdgcn_s_barrier()
#define PG8_SCHED __builtin_amdgcn_sched_barrier(0)
    Unit cur, nxt; int ui = 0;
    if (!S.next(0, cur)) return;
    f32x4 acc[2][2][4][2];
#pragma unroll
    for (int a = 0; a < 2; ++a)
#pragma unroll
        for (int b = 0; b < 2; ++b)
#pragma unroll
            for (int m = 0; m < 4; ++m)
#pragma unroll
                for (int n = 0; n < 2; ++n) acc[a][b][m][n] = (f32x4){0.f, 0.f, 0.f, 0.f};
    bf16x8 At[4][2], B0[2][2], B1[2][2];
    const char* cA = (const char*)g.A + (size_t)cur.pm * tstep; const char* cB = (const char*)g.Bt + (size_t)cur.pn * tstep;
    S.a_ready(cur);
    if constexpr (SP2) {
        PG8_STAGE(PG8_SB(0, 0), cB, voffB); PG8_STAGE(PG8_SB(0, 1), cB + hstep, voffB); PG8_STAGE(PG8_SA(0, 0), cA, voffA); PG8_STAGE(PG8_SA(0, 1), cA + hstep, voffA);
        if (wr == 1) PG8_BAR;
        PG8_WAIT_V(2); PG8_BAR;
        PG8_STAGE(PG8_SB(1, 0), cB + kstep, voffB); PG8_STAGE(PG8_SA(1, 0), cA + kstep, voffA); PG8_STAGE(PG8_SB(1, 1), cB + hstep + kstep, voffB);
        PG8_WAIT_V(6); PG8_BAR;
    } else {
        PG8_STAGE(PG8_SB(0, 0), cB, voffB); PG8_STAGE(PG8_SA(0, 0), cA, voffA); PG8_STAGE(PG8_SB(0, 1), cB + hstep, voffB); PG8_STAGE(PG8_SA(0, 1), cA + hstep, voffA);
        if (wr == 1) PG8_BAR;
        PG8_WAIT_V(4); PG8_BAR;
        PG8_STAGE(PG8_SB(1, 0), cB + kstep, voffB); PG8_STAGE(PG8_SA(1, 0), cA + kstep, voffA); PG8_STAGE(PG8_SB(1, 1), cB + hstep + kstep, voffB);
        PG8_WAIT_V(6); PG8_BAR;
    }
    for (;;) {
        const bool has_next = S.next(ui + 1, nxt);
        const char* nA = has_next ? (const char*)g.A + (size_t)nxt.pm * tstep : cA; const char* nB = has_next ? (const char*)g.Bt + (size_t)nxt.pn * tstep : cB;
        for (int t = 0; t < nt; t += 2) {
            const bool last = (t == nt - 2);
            const char* a1 = cA + (size_t)(t + 1) * kstep;
            const char* a2 = last ? nA : cA + (size_t)(t + 2) * kstep; const char* b2 = last ? nB : cB + (size_t)(t + 2) * kstep;
            const char* a3 = a2 + kstep; const char* b3 = b2 + kstep;
            if (last && has_next) S.a_ready(nxt);
            if constexpr (SP2) {
            PG8_LDB(B0, 0, 0); PG8_LDB(B1, 0, 1); PG8_SCHED; PG8_LDA(At, 0, 0); PG8_STAGE(PG8_SA(1, 1), a1 + hstep, voffA);
            PG8_WAIT_V(8); PG8_WAIT_L(0); PG8_BAR; PG8_MMA(0, 0, At, B0); PG8_MMA(0, 1, At, B1); PG8_BAR; PG8_SCHED;
            PG8_LDA(At, 0, 1); PG8_STAGE(PG8_SB(0, 0), b2, voffB); PG8_STAGE(PG8_SB(0, 1), b2 + hstep, voffB); PG8_STAGE(PG8_SA(0, 0), a2, voffA);
            PG8_WAIT_V(8); PG8_WAIT_L(0); PG8_BAR; PG8_MMA(1, 0, At, B0); PG8_MMA(1, 1, At, B1); PG8_BAR; PG8_SCHED;
            PG8_LDB(B0, 1, 0); PG8_LDB(B1, 1, 1); PG8_SCHED; PG8_LDA(At, 1, 0); PG8_STAGE(PG8_SA(0, 1), a2 + hstep, voffA);
            PG8_WAIT_V(8); PG8_WAIT_L(0); PG8_BAR; PG8_MMA(0, 0, At, B0); PG8_MMA(0, 1, At, B1); PG8_BAR; PG8_SCHED;
            PG8_LDA(At, 1, 1); PG8_STAGE(PG8_SB(1, 0), b3, voffB); PG8_STAGE(PG8_SB(1, 1), b3 + hstep, voffB); PG8_STAGE(PG8_SA(1, 0), a3, voffA);
            PG8_WAIT_V(8); PG8_WAIT_L(0); PG8_BAR; PG8_MMA(1, 0, At, B0); PG8_MMA(1, 1, At, B1); PG8_BAR; PG8_SCHED;
            } else {
            PG8_LDB(B0, 0, 0); PG8_SCHED; PG8_LDA(At, 0, 0); PG8_STAGE(PG8_SA(1, 1), a1 + hstep, voffA);
            PG8_WAIT_L(8); PG8_BAR; PG8_WAIT_L(0); PG8_MMA(0, 0, At, B0); PG8_BAR; PG8_SCHED;
            PG8_LDB(B1, 0, 1); PG8_STAGE(PG8_SB(0, 0), b2, voffB);
            PG8_BAR; PG8_WAIT_L(0); PG8_MMA(0, 1, At, B1); PG8_BAR;
            PG8_LDA(At, 0, 1); PG8_STAGE(PG8_SA(0, 0), a2, voffA);
            PG8_BAR; PG8_WAIT_L(0); PG8_MMA(1, 0, At, B0); PG8_BAR; PG8_SCHED;
            PG8_STAGE(PG8_SB(0, 1), b2 + hstep, voffB);
            PG8_WAIT_V(6); PG8_BAR; PG8_MMA(1, 1, At, B1); PG8_BAR;
            PG8_LDB(B0, 1, 0); PG8_SCHED; PG8_LDA(At, 1, 0); PG8_STAGE(PG8_SA(0, 1), a2 + hstep, voffA);
            PG8_WAIT_L(8); PG8_BAR; PG8_WAIT_L(0); PG8_MMA(0, 0, At, B0); PG8_BAR; PG8_SCHED;
            PG8_LDB(B1, 1, 1); PG8_STAGE(PG8_SB(1, 0), b3, voffB);
            PG8_BAR; PG8_WAIT_L(0); PG8_MMA(0, 1, At, B1); PG8_BAR;
            PG8_LDA(At, 1, 1); PG8_STAGE(PG8_SA(1, 0), a3, voffA);
            PG8_BAR; PG8_WAIT_L(0); PG8_MMA(1, 0, At, B0); PG8_BAR; PG8_SCHED;
            PG8_STAGE(PG8_SB(1, 1), b3 + hstep, voffB);
            PG8_WAIT_V(6); PG8_BAR; PG8_MMA(1, 1, At, B1); PG8_BAR;
            }
        }
        if constexpr (ALIGN_EPI) { if (wr == 0) PG8_BAR; }
        if constexpr (!Epi::AFTER_DRAIN) { E(acc, cur, wr, wc, fr, fq); S.done(cur); }
        if (!has_next) break;
#pragma unroll
        for (int a = 0; a < 2; ++a)
#pragma unroll
            for (int b = 0; b < 2; ++b)
#pragma unroll
                for (int m = 0; m < 4; ++m)
#pragma unroll
                    for (int n = 0; n < 2; ++n) acc[a][b][m][n] = (f32x4){0.f, 0.f, 0.f, 0.f};
        cur = nxt; cA = nA; cB = nB; ++ui;
        if constexpr (ALIGN_EPI) { if (wr == 1) PG8_BAR; }
    }
    PG8_WAIT_V(0);
    if constexpr (!ALIGN_EPI) { if (wr == 0) PG8_BAR; }
    PG8_BAR;
    if constexpr (Epi::AFTER_DRAIN) { E.fused(acc, cur, wr, wc, fr, fq, lds, wid, lane); S.done(cur); }
#undef PG8_SA
#undef PG8_SB
#undef PG8_STAGE
#undef PG8_LDA
#undef PG8_LDB
#undef PG8_MMA
#undef PG8_WAIT_V
#undef PG8_WAIT_L
#undef PG8_BAR
#undef PG8_SCHED
}
}

typedef unsigned short bf16;
typedef short bf16x8 __attribute__((ext_vector_type(8)));
typedef float f32x4 __attribute__((ext_vector_type(4)));
typedef float f32x2 __attribute__((ext_vector_type(2)));
typedef unsigned u32x4 __attribute__((ext_vector_type(4)));
typedef unsigned u32x2 __attribute__((ext_vector_type(2)));
#define LAS __attribute__((address_space(3)))
constexpr int D = 2048, NB = 4, SEQ = 8192, DEPTH = 4, CTXL = 256;
constexpr int NLAT = NB * SEQ, NCTX = NB * CTXL, NTOK = NLAT + NCTX;
constexpr int DB = 512, INC = 3328, DFF = 8192, NMOD = 6;
constexpr float EPS = 1e-6f, LOG2E = 1.4426950408889634f, QSCALE = 0.125f * 1.4426950408889634f;
constexpr size_t MiB = 1u << 20;
constexpr size_t WS_CTL = 0, WS_MOD = 1 * MiB, WS_ROPE = 2 * MiB, WS_GWS = 2 * MiB + 256 * 1024;
constexpr size_t WS_WIN = 64 * MiB, WS_WG = 77 * MiB, WS_WBR = 109 * MiB, WS_WOUT = 117 * MiB, WS_WF1 = 125 * MiB, WS_WF2 = 157 * MiB, WS_WGLU = 189 * MiB;
constexpr size_t WS_XC = 190 * MiB, WS_H = 198 * MiB, WS_GA = 330 * MiB, WS_YB = 396 * MiB, WS_Q = 429 * MiB, WS_K = 462 * MiB, WS_VT = 471 * MiB, WS_U = 480 * MiB;
constexpr size_t WS_BR = 514 * MiB, WS_MG = 646 * MiB, WS_G = 778 * MiB, WS_YF = 1306 * MiB, WS_YBK = 1372 * MiB, WS_END = 1438 * MiB;
constexpr size_t WS_YG = WS_GA, WS_MBUF = WS_H;
constexpr size_t WS_VCT = WS_VT + 8 * MiB;

__device__ __forceinline__ unsigned f2bf(float f) { unsigned u = __builtin_bit_cast(unsigned, f); return (u + 0x7fffu + ((u >> 16) & 1u)) >> 16; }
__device__ __forceinline__ unsigned pk2(float lo, float hi) { return f2bf(lo) | (f2bf(hi) << 16); }
__device__ __forceinline__ float bf2f(unsigned b) { return __builtin_bit_cast(float, b << 16); }
__device__ __forceinline__ float bflo(unsigned w) { return __builtin_bit_cast(float, w << 16); }
__device__ __forceinline__ float bfhi(unsigned w) { return __builtin_bit_cast(float, w & 0xffff0000u); }
__device__ __forceinline__ float sigmoidf_(float x) { return __builtin_amdgcn_rcpf(1.f + __builtin_amdgcn_exp2f(-x * LOG2E)); }
__device__ __forceinline__ float gelu_tanh(float x) { const float y = 0.7978845608028654f * (x + 0.044715f * x * x * x); return x * sigmoidf_(2.f * y); }
__device__ __forceinline__ float siluf_(float x) { return x * sigmoidf_(x); }
__device__ __forceinline__ float wave_sum(float v) {
#pragma unroll
    for (int o = 1; o < 64; o <<= 1) v += __shfl_xor(v, o);
    return v;
}
struct Args { const float* in[34]; float* out; unsigned char* ws; int layer, which; };
enum { I_X = 0, I_C, I_CTX, I_CCTX, I_WMOD, I_BMOD, I_N1G, I_N2G, I_WIN, I_GLNG, I_GLNB, I_GWS, I_GBS, I_CW, I_CB, I_CLNG, I_CLNB, I_SINK, I_ARE, I_AIM, I_LSTEP, I_BRE, I_BIM, I_CRE, I_CIM,
       I_S5D, I_WGLU, I_WBR, I_WGATE, I_BGATE, I_WOUT, I_WF1, I_WF2, I_FINALG };

__global__ void __launch_bounds__(256) k_prologue(Args a) {
    __shared__ float sc[5][2048];
    const float* c = a.in[I_C]; const float* cc = a.in[I_CCTX];
    for (int i = threadIdx.x; i < 5 * 2048; i += 256) { const int s = i >> 11, k = i & 2047; const float v = s < 4 ? c[s * 2048 + k] : cc[k]; sc[s][k] = v / (1.f + expf(-v)); }
    __syncthreads();
    if (blockIdx.x == 192) {
        f32x2* rt = (f32x2*)(a.ws + WS_ROPE);
        for (int i = threadIdx.x; i < 2048; i += 256) { const int pos = i >> 4, fi = i & 15; const double inv = pow(10000.0, -(double)fi / 16.0); const double ang = (double)pos * inv;
            rt[i] = (f32x2){(float)cos(ang), (float)sin(ang)}; }
        return;
    }
    const int col = blockIdx.x * 256 + threadIdx.x;
    const int l = col / 12288, j = col % 12288;
    const float* w = a.in[I_WMOD] + (size_t)l * 2048 * 12288 + j;
    float acc[5] = {0.f, 0.f, 0.f, 0.f, 0.f};
#pragma unroll 8
    for (int k = 0; k < 2048; ++k) { const float wv = w[(size_t)k * 12288];
#pragma unroll
        for (int s = 0; s < 5; ++s) acc[s] += sc[s][k] * wv; }
    const float b = a.in[I_BMOD][l * 12288 + j];
    float* mv = (float*)(a.ws + WS_MOD);
#pragma unroll
    for (int s = 0; s < 5; ++s) mv[(size_t)(l * 5 + s) * 12288 + j] = acc[s] + b;
}

__device__ __forceinline__ int inproj_map(int n) {
    if (n < 1024) return n;
    if (n < 2048) { const int m = n - 1024; return 1024 + (m < 512 ? 2 * m : 2 * (m - 512) + 1); }
    if (n < 2688) { const int base = n < 2560 ? 2048 : 2560; const int m = n - base, head = m >> 6, d = m & 63, half = d >> 5, i = d & 31; return base + head * 64 + half * 32 + 2 * (i & 15) + (i >> 4); }
    return n;
}
__device__ __forceinline__ int rowmap(int mode, int n) {
    if (mode == 1) return inproj_map(n);
    if (mode == 2) return n < 512 ? 2 * n : 2 * (n - 512) + 1;
    return n;
}
__device__ __forceinline__ void cvt_item(const float* W, int K, int N, bf16* WT, int mode, LAS float* scr, int item, int lane) {
    const int nblk = N / 32, kb = item / nblk, nb = item % nblk, k0 = 64 * kb, n0 = 32 * nb;
#pragma unroll 8
    for (int i = 0; i < 32; ++i) { const int kk = 2 * i + (lane >> 5); scr[kk * 33 + (lane & 31)] = W[(size_t)(k0 + kk) * N + n0 + (lane & 31)]; }
    asm volatile("s_waitcnt lgkmcnt(0)" ::: "memory");
    const int c = lane & 7;
#pragma unroll
    for (int j = 0; j < 4; ++j) { const int n = (lane >> 3) + 8 * j; const LAS float* s = scr + (8 * c) * 33 + n;
        u32x4 o; o.x = pk2(s[0 * 33], s[1 * 33]); o.y = pk2(s[2 * 33], s[3 * 33]); o.z = pk2(s[4 * 33], s[5 * 33]); o.w = pk2(s[6 * 33], s[7 * 33]);
        *(u32x4*)(WT + (size_t)rowmap(mode, n0 + n) * K + k0 + 8 * c) = o; }
    asm volatile("s_waitcnt lgkmcnt(0)" ::: "memory");
}
__device__ __forceinline__ void convert_layer(const Args& a, int l, LAS float* scr, int gw, int NGW, int lane, int gtid, int nthr) {
    unsigned char* ws = a.ws;
    constexpr int I_IN = 32 * 104, I_G = 32 * 64, I_B = 8 * 64, I_O = 32 * 64, I_1 = 32 * 256, I_2 = 128 * 64, I_GL = 8 * 32;
    constexpr int NITEMS = I_IN + 4 * I_G + 4 * I_B + I_O + I_1 + I_2 + I_GL;
    for (int it = gw; it < NITEMS; it += NGW) {
        int r = it;
        if (r < I_IN) { cvt_item(a.in[I_WIN] + (size_t)l * D * INC, D, INC, (bf16*)(ws + WS_WIN), 1, scr, r, lane); continue; } r -= I_IN;
        if (r < 4 * I_G) { const int k = r / I_G; cvt_item(a.in[I_WGATE] + (size_t)(l * 4 + k) * D * D, D, D, (bf16*)(ws + WS_WG) + (size_t)k * D * D, 0, scr, r % I_G, lane); continue; } r -= 4 * I_G;
        if (r < 4 * I_B) { const int k = r / I_B; cvt_item(a.in[I_WBR] + (size_t)(l * 4 + k) * DB * D, DB, D, (bf16*)(ws + WS_WBR) + (size_t)k * D * DB, 0, scr, r % I_B, lane); continue; } r -= 4 * I_B;
        if (r < I_O) { cvt_item(a.in[I_WOUT] + (size_t)l * D * D, D, D, (bf16*)(ws + WS_WOUT), 0, scr, r, lane); continue; } r -= I_O;
        if (r < I_1) { cvt_item(a.in[I_WF1] + (size_t)l * D * DFF, D, DFF, (bf16*)(ws + WS_WF1), 0, scr, r, lane); continue; } r -= I_1;
        if (r < I_2) { cvt_item(a.in[I_WF2] + (size_t)l * DFF * D, DFF, D, (bf16*)(ws + WS_WF2), 0, scr, r, lane); continue; } r -= I_2;
        cvt_item(a.in[I_WGLU] + (size_t)l * DB * 1024, DB, 1024, (bf16*)(ws + WS_WGLU), 2, scr, r, lane);
    }
    bf16* gws = (bf16*)(ws + WS_GWS); const float* gsrc = a.in[I_GWS] + (size_t)l * 65536;
    for (int i = gtid; i < 65536; i += nthr) gws[i] = (bf16)f2bf(gsrc[i]);
}
__global__ void __launch_bounds__(512) k_convert(Args a) {
    extern __shared__ __attribute__((aligned(16))) unsigned char lds[];
    const int tid = threadIdx.x, lane = tid & 63, wave = tid >> 6;
    convert_layer(a, a.layer, (LAS float*)lds + wave * 64 * 33, blockIdx.x * 8 + wave, gridDim.x * 8, lane, blockIdx.x * 512 + tid, gridDim.x * 512);
}

__device__ __forceinline__ const float* xrow_src(const Args& a, int layer, int which, int r) {
    if (layer == 0 && which == 1) return r < NLAT ? a.in[I_X] + (size_t)r * D : a.in[I_CTX] + (size_t)(r - NLAT) * D;
    return r < NLAT ? a.out + (size_t)r * D : (const float*)(a.ws + WS_XC) + (size_t)(r - NLAT) * D;
}
__device__ __forceinline__ void norm_rows(const Args& a, int layer, int which, int gw, int NGW, int lane) {
    const float* ng = a.in[which == 1 ? I_N1G : I_N2G] + layer * D;
    bf16* H = (bf16*)(a.ws + WS_H);
    for (int r = gw; r < NTOK; r += NGW) {
        const f32x4* xr = (const f32x4*)xrow_src(a, layer, which, r) + lane;
        f32x4 v[8]; float ss = 0.f;
#pragma unroll
        for (int j = 0; j < 8; ++j) { v[j] = xr[64 * j]; ss += (v[j].x * v[j].x + v[j].y * v[j].y) + (v[j].z * v[j].z + v[j].w * v[j].w); }
        const float rs = 1.f / sqrtf(wave_sum(ss) * (1.f / D) + EPS);
        const int s = r < NLAT ? (r >> 13) : 4;
        const float* mv = (const float*)(a.ws + WS_MOD) + (size_t)(layer * 5 + s) * 12288 + (which == 1 ? 0 : 3) * D;
        u32x2* o8 = (u32x2*)(H + (size_t)r * D) + lane;
#pragma unroll
        for (int j = 0; j < 8; ++j) { const int col = (lane + 64 * j) * 4;
            const f32x4 g = *(const f32x4*)(ng + col), sh = *(const f32x4*)(mv + col), sc = *(const f32x4*)(mv + D + col);
            const f32x4 y = (v[j] * rs * g) * (sc + 1.f) + sh;
            o8[64 * j] = (u32x2){pk2(y.x, y.y), pk2(y.z, y.w)}; }
    }
}
__global__ void __launch_bounds__(512) k_norm(Args a) { norm_rows(a, a.layer, a.which, blockIdx.x * 8 + (threadIdx.x >> 6), gridDim.x * 8, threadIdx.x & 63); }

__global__ void __launch_bounds__(512) k_final(Args a) {
    const int lane = threadIdx.x & 63, gw = blockIdx.x * 8 + (threadIdx.x >> 6), NGW = gridDim.x * 8;
    const float* fg = a.in[I_FINALG];
    for (int r = gw; r < NLAT; r += NGW) {
        f32x4* xr = (f32x4*)(a.out + (size_t)r * D) + lane;
        f32x4 v[8]; float ss = 0.f;
#pragma unroll
        for (int j = 0; j < 8; ++j) { v[j] = xr[64 * j]; ss += (v[j].x * v[j].x + v[j].y * v[j].y) + (v[j].z * v[j].z + v[j].w * v[j].w); }
        const float rs = 1.f / sqrtf(wave_sum(ss) * (1.f / D) + EPS);
#pragma unroll
        for (int j = 0; j < 8; ++j) { const int col = (lane + 64 * j) * 4; xr[64 * j] = v[j] * rs * *(const f32x4*)(fg + col); }
    }
}

using pg8::Unit;
#define EPI_LOOP _Pragma("unroll") for (int ai = 0; ai < 2; ++ai) _Pragma("unroll") for (int m = 0; m < 4; ++m) _Pragma("unroll") for (int bj = 0; bj < 2; ++bj)

struct EpiInProj {
    static constexpr bool PERM = true, AFTER_DRAIN = false;
    bf16 *ga, *yb, *q, *k, *vT, *vcT, *u; const f32x2* rope;
    __device__ __forceinline__ void operator()(const f32x4 (&acc)[2][2][4][2], const Unit& un, int wr, int wc, int fr, int fq) const {
        const int pn = un.pn, rbase = un.pm * 256 + wr * 64 + fr, cw = wc * 32 + 8 * fq;
        const bool lat = un.pm < (NLAT / 256);
        EPI_LOOP {
            const int row = rbase + ai * 128 + m * 16; const int ct = bj * 128 + cw;
            const f32x4 v0 = acc[ai][bj][m][0], v1 = acc[ai][bj][m][1];
            if (pn < 4) {
                u32x4 w; w.x = pk2(gelu_tanh(v0.x), gelu_tanh(v0.y)); w.y = pk2(gelu_tanh(v0.z), gelu_tanh(v0.w)); w.z = pk2(gelu_tanh(v1.x), gelu_tanh(v1.y)); w.w = pk2(gelu_tanh(v1.z), gelu_tanh(v1.w));
                *(u32x4*)(ga + (size_t)row * 1024 + pn * 256 + ct) = w;
            } else if (pn < 8) {
                u32x2 w; w.x = pk2(v0.x * sigmoidf_(v0.y), v0.z * sigmoidf_(v0.w)); w.y = pk2(v1.x * sigmoidf_(v1.y), v1.z * sigmoidf_(v1.w));
                *(u32x2*)(yb + (size_t)row * 512 + (((pn - 4) * 256 + ct) >> 1)) = w;
            } else if (pn < 10 || (pn == 10 && bj == 0)) {
                const bool isq = pn < 10; const int cs = isq ? (pn - 8) * 256 + ct : ct;
                float x[8] = {v0.x, v0.y, v0.z, v0.w, v1.x, v1.y, v1.z, v1.w};
                if (lat) { const int t = row & (SEQ - 1), pih = cs & 63, half = pih >> 5, i0 = (pih & 31) >> 1; const int pos = half ? (t & 63) : (t >> 6);
#pragma unroll
                    for (int jj = 0; jj < 4; ++jj) { const f32x2 cs2 = rope[pos * 16 + i0 + jj]; const float x1 = x[2 * jj], x2 = x[2 * jj + 1]; x[2 * jj] = x1 * cs2.x - x2 * cs2.y; x[2 * jj + 1] = x1 * cs2.y + x2 * cs2.x; } }
                const float sc = isq ? QSCALE : 1.f;
                u32x4 w; w.x = pk2(x[0] * sc, x[1] * sc); w.y = pk2(x[2] * sc, x[3] * sc); w.z = pk2(x[4] * sc, x[5] * sc); w.w = pk2(x[6] * sc, x[7] * sc);
                if (isq) *(u32x4*)(q + (size_t)row * 512 + cs) = w; else *(u32x4*)(k + (size_t)row * 128 + cs) = w;
            } else if (pn == 10) {
                const int dc = ct - 128; const float x[8] = {v0.x, v0.y, v0.z, v0.w, v1.x, v1.y, v1.z, v1.w};
                if (lat) { const int b = row >> 13, t = row & (SEQ - 1);
#pragma unroll
                    for (int e = 0; e < 8; ++e) vT[((size_t)(b * 128 + dc + e)) * SEQ + t] = (bf16)f2bf(x[e]); }
                else { const int rc = row - NLAT, b = rc >> 8, t = rc & 255;
#pragma unroll
                    for (int e = 0; e < 8; ++e) vcT[((size_t)(b * 128 + dc + e)) * CTXL + t] = (bf16)f2bf(x[e]); }
            } else {
                u32x4 w; w.x = pk2(v0.x, v0.y); w.y = pk2(v0.z, v0.w); w.z = pk2(v1.x, v1.y); w.w = pk2(v1.z, v1.w);
                *(u32x4*)(u + (size_t)row * 512 + (pn - 11) * 256 + ct) = w;
            }
        }
    }
};
struct EpiGlu {
    static constexpr bool PERM = true, AFTER_DRAIN = false;
    bf16* o;
    __device__ __forceinline__ void operator()(const f32x4 (&acc)[2][2][4][2], const Unit& un, int wr, int wc, int fr, int fq) const {
        const int rbase = un.pm * 256 + wr * 64 + fr, cw = un.pn * 256 + wc * 32 + 8 * fq;
        EPI_LOOP { const int row = rbase + ai * 128 + m * 16; const f32x4 v0 = acc[ai][bj][m][0], v1 = acc[ai][bj][m][1];
            u32x2 w; w.x = pk2(v0.x * sigmoidf_(v0.y), v0.z * sigmoidf_(v0.w)); w.y = pk2(v1.x * sigmoidf_(v1.y), v1.z * sigmoidf_(v1.w));
            *(u32x2*)(o + (size_t)row * 512 + ((cw + bj * 128) >> 1)) = w; }
    }
};
template <int ACT  > struct EpiAct {
    static constexpr bool PERM = true, AFTER_DRAIN = false;
    bf16* o; const float* bias; int ldc, pad;
    __device__ __forceinline__ void operator()(const f32x4 (&acc)[2][2][4][2], const Unit& un, int wr, int wc, int fr, int fq) const {
        const int rbase = un.pm * 256 + wr * 64 + fr, cw = un.pn * 256 + wc * 32 + 8 * fq;
        EPI_LOOP { const int row = rbase + ai * 128 + m * 16, col = cw + bj * 128; f32x4 v0 = acc[ai][bj][m][0], v1 = acc[ai][bj][m][1];
            if (ACT == 0) { const f32x4 b0 = *(const f32x4*)(bias + col), b1 = *(const f32x4*)(bias + col + 4); v0 += b0; v1 += b1;
                v0 = (f32x4){sigmoidf_(v0.x), sigmoidf_(v0.y), sigmoidf_(v0.z), sigmoidf_(v0.w)}; v1 = (f32x4){sigmoidf_(v1.x), sigmoidf_(v1.y), sigmoidf_(v1.z), sigmoidf_(v1.w)}; }
            else { v0 = __builtin_elementwise_max(v0, (f32x4){0.f, 0.f, 0.f, 0.f}); v1 = __builtin_elementwise_max(v1, (f32x4){0.f, 0.f, 0.f, 0.f}); v0 = v0 * v0; v1 = v1 * v1; }
            u32x4 w; w.x = pk2(v0.x, v0.y); w.y = pk2(v0.z, v0.w); w.z = pk2(v1.x, v1.y); w.w = pk2(v1.z, v1.w);
            *(u32x4*)(o + (size_t)row * ldc + col) = w; }
    }
};
struct EpiMerge {
    static constexpr bool PERM = true, AFTER_DRAIN = false;
    const bf16* gate; float* mbuf; bf16* mg; int kb, pad;
    __device__ __forceinline__ void operator()(const f32x4 (&acc)[2][2][4][2], const Unit& un, int wr, int wc, int fr, int fq) const {
        const int rbase = un.pm * 256 + wr * 64 + fr, cw = un.pn * 256 + wc * 32 + 8 * fq;
        EPI_LOOP { const int row = rbase + ai * 128 + m * 16, col = cw + bj * 128; const f32x4 v0 = acc[ai][bj][m][0], v1 = acc[ai][bj][m][1];
            const u32x4 gw = *(const u32x4*)(gate + (size_t)row * DFF + kb * D + col);
            f32x4 r0 = (f32x4){bflo(gw.x) * v0.x, bfhi(gw.x) * v0.y, bflo(gw.y) * v0.z, bfhi(gw.y) * v0.w}, r1 = (f32x4){bflo(gw.z) * v1.x, bfhi(gw.z) * v1.y, bflo(gw.w) * v1.z, bfhi(gw.w) * v1.w};
            float* mp = mbuf + (size_t)row * D + col;
            if (kb > 0) { r0 += *(const f32x4*)mp; r1 += *(const f32x4*)(mp + 4); }
            if (kb < 3) { *(f32x4*)mp = r0; *(f32x4*)(mp + 4) = r1; }
            else { u32x4 w; w.x = pk2(r0.x, r0.y); w.y = pk2(r0.z, r0.w); w.z = pk2(r1.x, r1.y); w.w = pk2(r1.z, r1.w); *(u32x4*)(mg + (size_t)row * D + col) = w; } }
    }
};
struct EpiResid {
    static constexpr bool PERM = true, AFTER_DRAIN = false;
    const float *srcl, *srcc; float *dstl, *dstc; const float* modg;
    __device__ __forceinline__ void operator()(const f32x4 (&acc)[2][2][4][2], const Unit& un, int wr, int wc, int fr, int fq) const {
        const int rbase = un.pm * 256 + wr * 64 + fr, cw = un.pn * 256 + wc * 32 + 8 * fq;
        const bool lat = un.pm < (NLAT / 256);
        const int slot = lat ? (un.pm >> 5) : 4;
        const float* src = lat ? srcl : srcc; float* dst = lat ? dstl : dstc; const int radj = lat ? 0 : NLAT;
        const float* gp = modg + (size_t)slot * 12288;
        EPI_LOOP { const int row = rbase + ai * 128 + m * 16, col = cw + bj * 128; const f32x4 v0 = acc[ai][bj][m][0], v1 = acc[ai][bj][m][1];
            const f32x4 g0 = *(const f32x4*)(gp + col), g1 = *(const f32x4*)(gp + col + 4);
            const float* sp = src + (size_t)(row - radj) * D + col; float* dp = dst + (size_t)(row - radj) * D + col;
            const f32x4 x0 = *(const f32x4*)sp, x1 = *(const f32x4*)(sp + 4);
            *(f32x4*)dp = x0 + g0 * v0; *(f32x4*)(dp + 4) = x1 + g1 * v1; }
    }
};
template <class Epi> __global__ void __launch_bounds__(512, 2) k_gemm(pg8::Gemm g, Epi E) {
    extern __shared__ __attribute__((aligned(16))) unsigned char lds[];
    pg8::StaticOrder S; S.init(g.M, g.N, (int)gridDim.x, (int)blockIdx.x);
    pg8::gemm_phase<Epi, pg8::StaticOrder, true, true>((PG8_LAS unsigned char*)lds, g, S, E);
}

#define MFMA16(a, b, c) __builtin_amdgcn_mfma_f32_16x16x32_bf16((a), (b), (c), 0, 0, 0)
#define WAVE_LDS_SYNC() asm volatile("s_waitcnt lgkmcnt(0)" ::: "memory")
__device__ __forceinline__ void gmlp_unit(const Args& a, int l, int ch, LAS unsigned char* lds, int tid) {
    const int lane = tid & 63, w = tid >> 6, fr = lane & 15, kg = lane >> 4;
    LAS f32x2* st = (LAS f32x2*)lds; LAS bf16* vt = (LAS bf16*)(lds + 1024);
    const bf16* GA = (const bf16*)(a.ws + WS_GA); bf16* BRA = (bf16*)(a.ws + WS_BR); const bf16* GWS = (const bf16*)(a.ws + WS_GWS);
    const float* lng = a.in[I_GLNG] + l * DB; const float* lnb = a.in[I_GLNB] + l * DB; const float* bs = a.in[I_GBS] + l * 512;
    const int row0 = ch * 128;
    for (int rr = 0; rr < 16; ++rr) { const int r = w * 16 + rr;
        const u32x4 x = *(const u32x4*)(GA + (size_t)(row0 + r) * 1024 + 512 + lane * 8);
        const float f[8] = {bflo(x.x), bfhi(x.x), bflo(x.y), bfhi(x.y), bflo(x.z), bfhi(x.z), bflo(x.w), bfhi(x.w)};
        float s = 0.f;
#pragma unroll
        for (int e = 0; e < 8; ++e) s += f[e];
        const float mean = wave_sum(s) * (1.f / 512.f); float s2 = 0.f;
#pragma unroll
        for (int e = 0; e < 8; ++e) { const float d = f[e] - mean; s2 += d * d; }
        const float rstd = 1.f / sqrtf(wave_sum(s2) * (1.f / 512.f) + EPS);
        if (lane == 0) st[r] = (f32x2){mean, rstd}; }
    __syncthreads();
    for (int g = 0; g < 4; ++g) {
        { const int q = tid >> 2, cs = (tid & 3) * 32; const f32x2 ms = st[q];
#pragma unroll
            for (int k4 = 0; k4 < 4; ++k4) { const int c0 = cs + k4 * 8; const u32x4 x = *(const u32x4*)(GA + (size_t)(row0 + q) * 1024 + 512 + g * 128 + c0);
                const float f[8] = {bflo(x.x), bfhi(x.x), bflo(x.y), bfhi(x.y), bflo(x.z), bfhi(x.z), bflo(x.w), bfhi(x.w)};
#pragma unroll
                for (int e = 0; e < 8; ++e) { const int c = c0 + e; vt[c * 136 + q] = (bf16)f2bf((f[e] - ms.x) * ms.y * lng[g * 128 + c] + lnb[g * 128 + c]); } } }
        __syncthreads();
        f32x4 acc[8];
#pragma unroll
        for (int mt = 0; mt < 8; ++mt) acc[mt] = (f32x4){0.f, 0.f, 0.f, 0.f};
#pragma unroll
        for (int ks = 0; ks < 4; ++ks) { const bf16x8 bfr = *(const LAS bf16x8*)(vt + (16 * w + fr) * 136 + ks * 32 + kg * 8);
#pragma unroll
            for (int mt = 0; mt < 8; ++mt) { const bf16x8 af = *(const bf16x8*)(GWS + (size_t)(g * 128 + mt * 16 + fr) * 128 + ks * 32 + kg * 8); acc[mt] = MFMA16(af, bfr, acc[mt]); } }
        const int gc = g * 128 + 16 * w + fr;
#pragma unroll
        for (int mt = 0; mt < 8; ++mt)
#pragma unroll
            for (int j = 0; j < 4; ++j) { const int p = mt * 16 + kg * 4 + j; const float uv = bf2f(GA[(size_t)(row0 + p) * 1024 + gc]);
                BRA[(size_t)(row0 + p) * 512 + gc] = (bf16)f2bf(uv * (acc[mt][j] + bs[g * 128 + p])); }
        __syncthreads();
    }
}
__global__ void __launch_bounds__(512) k_gmlp(Args a) { extern __shared__ __attribute__((aligned(16))) unsigned char lds[]; gmlp_unit(a, a.layer, blockIdx.x, (LAS unsigned char*)lds, threadIdx.x); }

__device__ __forceinline__ void conv_unit(const Args& a, int l, int un, LAS unsigned char* lds, int tid) {
    LAS float* ybuf = (LAS float*)lds;
    const bf16* YB = (const bf16*)(a.ws + WS_YB); bf16* BRB = (bf16*)(a.ws + WS_BR) + (size_t)NTOK * 512;
    const int lane = tid & 63, w = tid >> 6;
    const int t0 = un * 32; int s0, s1;
    if (t0 < NLAT) { s0 = t0 & ~(SEQ - 1); s1 = s0 + SEQ; } else { s0 = NLAT + ((t0 - NLAT) & ~(CTXL - 1)); s1 = s0 + CTXL; }
    const int cp = tid & 255, half = tid >> 8, rb = t0 + half * 16 - 15;
    const float* cw = a.in[I_CW] + (size_t)l * 31 * 512 + 2 * cp;
    f32x2 wt[31];
#pragma unroll
    for (int i = 0; i < 31; ++i) wt[i] = *(const f32x2*)(cw + i * 512);
    f32x2 o[16];
#pragma unroll
    for (int j = 0; j < 16; ++j) o[j] = (f32x2){0.f, 0.f};
#pragma unroll
    for (int r = 0; r < 46; ++r) { const int row = rb + r; f32x2 v = (f32x2){0.f, 0.f};
        if (row >= s0 && row < s1) { const unsigned x = *(const unsigned*)(YB + (size_t)row * 512 + 2 * cp); v = (f32x2){bflo(x), bfhi(x)}; }
#pragma unroll
        for (int j = 0; j < 16; ++j) if (r - j >= 0 && r - j <= 30) o[j] += wt[r - j] * v; }
    const f32x2 cb = *(const f32x2*)(a.in[I_CB] + l * 512 + 2 * cp);
#pragma unroll
    for (int j = 0; j < 16; ++j) *(LAS f32x2*)(ybuf + (half * 16 + j) * 512 + 2 * cp) = o[j] + cb;
    __syncthreads();
    const float* lg = a.in[I_CLNG] + l * 512 + lane * 8; const float* lb = a.in[I_CLNB] + l * 512 + lane * 8;
    for (int tt = 0; tt < 4; ++tt) { const int tok = 4 * w + tt; float f[8]; float s = 0.f;
        { const f32x4 p0 = *(const LAS f32x4*)(ybuf + tok * 512 + lane * 8), p1 = *(const LAS f32x4*)(ybuf + tok * 512 + lane * 8 + 4); f[0] = p0.x; f[1] = p0.y; f[2] = p0.z; f[3] = p0.w; f[4] = p1.x; f[5] = p1.y; f[6] = p1.z; f[7] = p1.w; }
#pragma unroll
        for (int e = 0; e < 8; ++e) s += f[e];
        const float mean = wave_sum(s) * (1.f / 512.f); float s2 = 0.f;
#pragma unroll
        for (int e = 0; e < 8; ++e) { f[e] -= mean; s2 += f[e] * f[e]; }
        const float rstd = 1.f / sqrtf(wave_sum(s2) * (1.f / 512.f) + EPS);
#pragma unroll
        for (int e = 0; e < 8; ++e) f[e] = siluf_(f[e] * rstd * lg[e] + lb[e]);
        u32x4 wv; wv.x = pk2(f[0], f[1]); wv.y = pk2(f[2], f[3]); wv.z = pk2(f[4], f[5]); wv.w = pk2(f[6], f[7]);
        *(u32x4*)(BRB + (size_t)(t0 + tok) * 512 + lane * 8) = wv; }
    __syncthreads();
}
__global__ void __launch_bounds__(512) k_conv(Args a) { extern __shared__ __attribute__((aligned(16))) unsigned char lds[]; conv_unit(a, a.layer, blockIdx.x, (LAS unsigned char*)lds, threadIdx.x); }

__device__ __forceinline__ void attn_unit(const Args& a, int l, int unit, LAS unsigned char* lds, int tid) {
    const int lane = tid & 63, w = tid >> 6, fr = lane & 15, kg = lane >> 4;
    LAS bf16* P = (LAS bf16*)(lds + w * 4352);
    const bf16* Q = (const bf16*)(a.ws + WS_Q); const bf16* K = (const bf16*)(a.ws + WS_K); const bf16* VT = (const bf16*)(a.ws + WS_VT); const bf16* VCT = (const bf16*)(a.ws + WS_VCT);
    bf16* BRC = (bf16*)(a.ws + WS_BR) + (size_t)2 * NTOK * 512;
    int b, qblk, hq, qrow0; bool isctx;
    if (unit < 2048) { b = unit >> 9; qblk = (unit >> 3) & 63; hq = unit & 7; isctx = false; qrow0 = b * SEQ + qblk * 128; }
    else { const int uu = unit - 2048; b = uu >> 4; qblk = (uu >> 3) & 1; hq = uu & 7; isctx = true; qrow0 = NLAT + b * CTXL + qblk * 128; }
    const int hkv = hq >> 2;
    const bf16* qp = Q + (size_t)(qrow0 + 16 * w + fr) * 512 + hq * 64 + kg * 8;
    const bf16x8 qf0 = *(const bf16x8*)qp, qf1 = *(const bf16x8*)(qp + 32);
    const float sinkv = a.in[I_SINK][l * 8 + hq] * LOG2E;
    float mrow[4], lp[4]; f32x4 o[4];
#pragma unroll
    for (int j = 0; j < 4; ++j) { mrow[j] = sinkv; lp[j] = (fr == 0) ? 1.f : 0.f; o[j] = (f32x4){0.f, 0.f, 0.f, 0.f}; }
    for (int t = isctx ? 3 : 0; t < 5; ++t) {
        int krow0, vpitch; const bf16* vtb;
        if (t < 3) { const int kb = qblk + t - 1; if (kb < 0 || kb > 63) continue; krow0 = b * SEQ + kb * 128; vtb = VT + (size_t)((b * 2 + hkv) * 64) * SEQ + kb * 128; vpitch = SEQ; }
        else { krow0 = NLAT + b * CTXL + (t - 3) * 128; vtb = VCT + (size_t)((b * 2 + hkv) * 64) * CTXL + (t - 3) * 128; vpitch = CTXL; }
        f32x4 s[8];
#pragma unroll
        for (int nt = 0; nt < 8; ++nt) { const bf16* kp = K + (size_t)(krow0 + nt * 16 + fr) * 128 + hkv * 64 + kg * 8;
            const bf16x8 k0 = *(const bf16x8*)kp, k1 = *(const bf16x8*)(kp + 32);
            s[nt] = MFMA16(qf0, k0, ((f32x4){0.f, 0.f, 0.f, 0.f})); s[nt] = MFMA16(qf1, k1, s[nt]); }
        if (t == 0 || t == 2) {
#pragma unroll
            for (int nt = 0; nt < 8; ++nt)
#pragma unroll
                for (int j = 0; j < 4; ++j) { const int qi = 16 * w + kg * 4 + j, ki = nt * 16 + fr; const bool ok = (t == 0) ? (qi <= ki) : (ki <= qi); if (!ok) s[nt][j] = -1e30f; } }
        float alpha[4];
#pragma unroll
        for (int j = 0; j < 4; ++j) { float mx = s[0][j];
#pragma unroll
            for (int nt = 1; nt < 8; ++nt) mx = fmaxf(mx, s[nt][j]);
            mx = fmaxf(mx, __shfl_xor(mx, 1)); mx = fmaxf(mx, __shfl_xor(mx, 2)); mx = fmaxf(mx, __shfl_xor(mx, 4)); mx = fmaxf(mx, __shfl_xor(mx, 8));
            const float mn = fmaxf(mrow[j], mx); alpha[j] = __builtin_amdgcn_exp2f(mrow[j] - mn); mrow[j] = mn; lp[j] *= alpha[j]; }
#pragma unroll
        for (int nt = 0; nt < 8; ++nt)
#pragma unroll
            for (int j = 0; j < 4; ++j) { const float p = __builtin_amdgcn_exp2f(s[nt][j] - mrow[j]); lp[j] += p; P[(kg * 4 + j) * 136 + nt * 16 + fr] = (bf16)f2bf(p); }
#pragma unroll
        for (int dt = 0; dt < 4; ++dt) { o[dt][0] *= alpha[0]; o[dt][1] *= alpha[1]; o[dt][2] *= alpha[2]; o[dt][3] *= alpha[3]; }
        WAVE_LDS_SYNC();
#pragma unroll
        for (int ks = 0; ks < 4; ++ks) { const bf16x8 pa = *(const LAS bf16x8*)(P + fr * 136 + ks * 32 + kg * 8);
#pragma unroll
            for (int dt = 0; dt < 4; ++dt) { const bf16x8 vb = *(const bf16x8*)(vtb + (size_t)(dt * 16 + fr) * vpitch + ks * 32 + kg * 8); o[dt] = MFMA16(pa, vb, o[dt]); } }
        WAVE_LDS_SYNC();
    }
#pragma unroll
    for (int j = 0; j < 4; ++j) { float s = lp[j]; s += __shfl_xor(s, 1); s += __shfl_xor(s, 2); s += __shfl_xor(s, 4); s += __shfl_xor(s, 8); const float inv = 1.f / s;
#pragma unroll
        for (int dt = 0; dt < 4; ++dt) BRC[(size_t)(qrow0 + 16 * w + kg * 4 + j) * 512 + hq * 64 + dt * 16 + fr] = (bf16)f2bf(o[dt][j] * inv); }
}
__global__ void __launch_bounds__(512) k_attn(Args a) { extern __shared__ __attribute__((aligned(16))) unsigned char lds[]; attn_unit(a, a.layer, blockIdx.x, (LAS unsigned char*)lds, threadIdx.x); }

__global__ void __launch_bounds__(64) k_s5scan(Args a) {
    __shared__ __attribute__((aligned(16))) float ul[64][16];
    const int l = a.layer, lane = threadIdx.x, id = blockIdx.x, dir = id & 1, g = (id >> 1) & 31, b = id >> 6, p = lane;
    const int pi = ((l * 2 + dir) * 32 + g) * 64 + p;
    const double are = a.in[I_ARE][pi], aim = a.in[I_AIM][pi], dt = exp((double)a.in[I_LSTEP][(l * 2 + dir) * 32 + g]);
    const double er = exp(are * dt), lrd = er * cos(aim * dt), lid = er * sin(aim * dt);
    const double den = are * are + aim * aim, cr = ((lrd - 1.0) * are + lid * aim) / den, ci = (lid * are - (lrd - 1.0) * aim) / den;
    const float lr = (float)lrd, li = (float)lid;
    float Bbr[16], Bbi[16], Cr[16], Ci[16];
#pragma unroll
    for (int c = 0; c < 16; ++c) { const double br = a.in[I_BRE][(size_t)((l * 32 + g) * 64 + p) * 16 + c], bi = a.in[I_BIM][(size_t)((l * 32 + g) * 64 + p) * 16 + c];
        Bbr[c] = (float)(cr * br - ci * bi); Bbi[c] = (float)(cr * bi + ci * br); }
#pragma unroll
    for (int o = 0; o < 16; ++o) { const size_t ix = (size_t)(((l * 2 + dir) * 32 + g) * 16 + o) * 64 + p; Cr[o] = a.in[I_CRE][ix]; Ci[o] = a.in[I_CIM][ix]; }
    const bf16* U = (const bf16*)(a.ws + WS_U);
    float* Y = (float*)(a.ws + (dir == 0 ? WS_YF : WS_YBK));
    float sr = 0.f, si = 0.f;
    const int osel = ((lane >> 5) & 1) * 8 + ((lane >> 4) & 1) * 4 + ((lane >> 3) & 1) * 2 + ((lane >> 2) & 1);
    for (int ph = 0; ph < 2; ++ph) {
        const int rowbase = ph == 0 ? NLAT + b * CTXL : b * SEQ, len = ph == 0 ? CTXL : SEQ;
        for (int blk = 0; blk < len / 64; ++blk) {
            { const int idx = blk * 64 + lane, ti = dir == 0 ? idx : len - 1 - idx;
                const u32x4 x0 = *(const u32x4*)(U + (size_t)(rowbase + ti) * 512 + g * 16), x1 = *(const u32x4*)(U + (size_t)(rowbase + ti) * 512 + g * 16 + 8);
                *(f32x4*)&ul[lane][0] = (f32x4){bflo(x0.x), bfhi(x0.x), bflo(x0.y), bfhi(x0.y)}; *(f32x4*)&ul[lane][4] = (f32x4){bflo(x0.z), bfhi(x0.z), bflo(x0.w), bfhi(x0.w)};
                *(f32x4*)&ul[lane][8] = (f32x4){bflo(x1.x), bfhi(x1.x), bflo(x1.y), bfhi(x1.y)}; *(f32x4*)&ul[lane][12] = (f32x4){bflo(x1.z), bfhi(x1.z), bflo(x1.w), bfhi(x1.w)}; }
            __syncthreads();
#pragma unroll 2
            for (int i = 0; i < 64; ++i) {
                const f32x4 u0 = *(const f32x4*)&ul[i][0], u1 = *(const f32x4*)&ul[i][4], u2 = *(const f32x4*)&ul[i][8], u3 = *(const f32x4*)&ul[i][12];
                const float uu[16] = {u0.x, u0.y, u0.z, u0.w, u1.x, u1.y, u1.z, u1.w, u2.x, u2.y, u2.z, u2.w, u3.x, u3.y, u3.z, u3.w};
                float bur = 0.f, bui = 0.f;
#pragma unroll
                for (int c = 0; c < 16; ++c) { bur += Bbr[c] * uu[c]; bui += Bbi[c] * uu[c]; }
                const float nsr = lr * sr - li * si + bur, nsi = lr * si + li * sr + bui; sr = nsr; si = nsi;
                float v[16];
#pragma unroll
                for (int o = 0; o < 16; ++o) v[o] = Cr[o] * sr - Ci[o] * si;
                float w8[8], w4[4], w2[2], w1;
                { const bool hi = lane & 32;
#pragma unroll
                    for (int k = 0; k < 8; ++k) { const float send = hi ? v[k] : v[k + 8], keep = hi ? v[k + 8] : v[k]; w8[k] = keep + __shfl_xor(send, 32); } }
                { const bool hi = lane & 16;
#pragma unroll
                    for (int k = 0; k < 4; ++k) { const float send = hi ? w8[k] : w8[k + 4], keep = hi ? w8[k + 4] : w8[k]; w4[k] = keep + __shfl_xor(send, 16); } }
                { const bool hi = lane & 8;
#pragma unroll
                    for (int k = 0; k < 2; ++k) { const float send = hi ? w4[k] : w4[k + 2], keep = hi ? w4[k + 2] : w4[k]; w2[k] = keep + __shfl_xor(send, 8); } }
                { const bool hi = lane & 4; const float send = hi ? w2[0] : w2[1], keep = hi ? w2[1] : w2[0]; w1 = keep + __shfl_xor(send, 4); }
                w1 += __shfl_xor(w1, 2); w1 += __shfl_xor(w1, 1);
                const int idx = blk * 64 + i, ti = dir == 0 ? idx : len - 1 - idx;
                if ((lane & 3) == 0) Y[(size_t)(rowbase + ti) * 512 + g * 16 + osel] = w1;
            }
            __syncthreads();
        }
    }
}
__global__ void __launch_bounds__(256) k_s5post(Args a) {
    const float* YF = (const float*)(a.ws + WS_YF); const float* YB = (const float*)(a.ws + WS_YBK); const bf16* U = (const bf16*)(a.ws + WS_U); bf16* YG = (bf16*)(a.ws + WS_YG);
    const float* dsk = a.in[I_S5D] + a.layer * 512;
    const size_t n4 = (size_t)NTOK * 512 / 4;
    for (size_t i = (size_t)blockIdx.x * 256 + threadIdx.x; i < n4; i += (size_t)gridDim.x * 256) {
        const f32x4 f = ((const f32x4*)YF)[i], bk = ((const f32x4*)YB)[i]; const u32x2 ux = ((const u32x2*)U)[i]; const int c = (int)((i * 4) & 511);
        const f32x4 d = *(const f32x4*)(dsk + c);
        const float y0 = f.x + bk.x + d.x * bflo(ux.x), y1 = f.y + bk.y + d.y * bfhi(ux.x), y2 = f.z + bk.z + d.z * bflo(ux.y), y3 = f.w + bk.w + d.w * bfhi(ux.y);
        ((u32x2*)YG)[i] = (u32x2){pk2(gelu_tanh(y0), gelu_tanh(y1)), pk2(gelu_tanh(y2), gelu_tanh(y3))};
    }
}

template <class Epi> static void launch_gemm(const bf16* A, const bf16* Bt, int M, int N, int K, const Epi& E, int grid, hipStream_t stream) {
    static bool attr_set = false;
    if (!attr_set) { (void)hipFuncSetAttribute((const void*)k_gemm<Epi>, hipFuncAttributeMaxDynamicSharedMemorySize, 131072); attr_set = true; }
    pg8::Gemm g{}; g.A = A; g.Bt = Bt; g.M = M; g.N = N; g.K = K; g.pad = 0;
    hipLaunchKernelGGL(k_gemm<Epi>, dim3(grid), dim3(512), 131072, stream, g, E);
}
extern "C" void kernel_launch(void* const* d_in, const int* in_sizes, int n_in, void* d_out, int out_size, void* d_ws, size_t ws_size, hipStream_t stream) {
    if (n_in != 34 || ws_size < WS_END) { fprintf(stderr, "kernel_launch: unexpected n_in %d or ws_size %zu (< %zu)\n", n_in, ws_size, (size_t)WS_END); return; }
    static bool once = false;
    if (!once) { once = true;
        (void)hipFuncSetAttribute((const void*)k_convert, hipFuncAttributeMaxDynamicSharedMemorySize, 8 * 64 * 33 * 4);
        (void)hipFuncSetAttribute((const void*)k_conv, hipFuncAttributeMaxDynamicSharedMemorySize, 65536);
        (void)hipFuncSetAttribute((const void*)k_gmlp, hipFuncAttributeMaxDynamicSharedMemorySize, 1024 + 34816);
        (void)hipFuncSetAttribute((const void*)k_attn, hipFuncAttributeMaxDynamicSharedMemorySize, 8 * 4352); }
    unsigned char* ws = (unsigned char*)d_ws;
    Args a{}; for (int i = 0; i < 34; ++i) a.in[i] = (const float*)d_in[i]; a.out = (float*)d_out; a.ws = ws; a.layer = 0; a.which = 0;
    const int G = 256;
    hipLaunchKernelGGL(k_prologue, dim3(193), dim3(256), 0, stream, a);
    bf16* H = (bf16*)(ws + WS_H); bf16* BR = (bf16*)(ws + WS_BR); bf16* MG = (bf16*)(ws + WS_MG); bf16* GT = (bf16*)(ws + WS_G);
    float* XC = (float*)(ws + WS_XC); const float* modv = (const float*)(ws + WS_MOD);
    for (int l = 0; l < DEPTH; ++l) {
        a.layer = l; a.which = 1;
        hipLaunchKernelGGL(k_convert, dim3(2048), dim3(512), 8 * 64 * 33 * 4, stream, a);
        hipLaunchKernelGGL(k_norm, dim3(1024), dim3(512), 0, stream, a);
        { EpiInProj E{}; E.ga = (bf16*)(ws + WS_GA); E.yb = (bf16*)(ws + WS_YB); E.q = (bf16*)(ws + WS_Q); E.k = (bf16*)(ws + WS_K); E.vT = (bf16*)(ws + WS_VT); E.vcT = (bf16*)(ws + WS_VCT); E.u = (bf16*)(ws + WS_U);
          E.rope = (const f32x2*)(ws + WS_ROPE); launch_gemm(H, (const bf16*)(ws + WS_WIN), NTOK, INC, D, E, G, stream); }
        hipLaunchKernelGGL(k_gmlp, dim3(NTOK / 128), dim3(512), 1024 + 34816, stream, a);
        hipLaunchKernelGGL(k_conv, dim3(NTOK / 32), dim3(512), 65536, stream, a);
        hipLaunchKernelGGL(k_attn, dim3(2048 + 64), dim3(512), 8 * 4352, stream, a);
        hipLaunchKernelGGL(k_s5scan, dim3(256), dim3(64), 0, stream, a);
        hipLaunchKernelGGL(k_s5post, dim3(2048), dim3(256), 0, stream, a);
        { EpiGlu E{}; E.o = BR + (size_t)3 * NTOK * 512; launch_gemm((const bf16*)(ws + WS_YG), (const bf16*)(ws + WS_WGLU), NTOK, 1024, DB, E, G, stream); }
        { EpiAct<0> E{}; E.o = GT; E.bias = (const float*)d_in[I_BGATE] + (size_t)l * 4 * D; E.ldc = DFF; E.pad = 0; launch_gemm(H, (const bf16*)(ws + WS_WG), NTOK, DFF, D, E, G, stream); }
        for (int kb = 0; kb < 4; ++kb) { EpiMerge E{}; E.gate = GT; E.mbuf = (float*)(ws + WS_MBUF); E.mg = MG; E.kb = kb; E.pad = 0;
            launch_gemm(BR + (size_t)kb * NTOK * 512, (const bf16*)(ws + WS_WBR) + (size_t)kb * D * DB, NTOK, D, DB, E, G, stream); }
        { EpiResid E{}; E.srcl = l == 0 ? (const float*)d_in[I_X] : (const float*)d_out; E.srcc = l == 0 ? (const float*)d_in[I_CTX] : (const float*)XC; E.dstl = (float*)d_out; E.dstc = XC;
          E.modg = modv + (size_t)l * 5 * 12288 + 2 * D; launch_gemm(MG, (const bf16*)(ws + WS_WOUT), NTOK, D, D, E, G, stream); }
        a.which = 2;
        hipLaunchKernelGGL(k_norm, dim3(1024), dim3(512), 0, stream, a);
        { EpiAct<1> E{}; E.o = GT; E.bias = nullptr; E.ldc = DFF; E.pad = 0; launch_gemm(H, (const bf16*)(ws + WS_WF1), NTOK, DFF, D, E, G, stream); }
        { EpiResid E{}; E.srcl = (const float*)d_out; E.srcc = XC; E.dstl = (float*)d_out; E.dstc = XC; E.modg = modv + (size_t)l * 5 * 12288 + 5 * D;
          launch_gemm(GT, (const bf16*)(ws + WS_WF2), NTOK, D, DFF, E, G, stream); }
    }
    hipLaunchKernelGGL(k_final, dim3(1024), dim3(512), 0, stream, a);
}
```

```cpp
#include <hip/hip_runtime.h>
#include <cstdio>
#include <cstdint>
#define USE_XCD_BAR 1


#define ECR 7

namespace pg8 {
#define PG8_LAS __attribute__((address_space(3)))
typedef unsigned short bf16_t;
typedef short bf16x8 __attribute__((ext_vector_type(8)));
typedef float f32x4 __attribute__((ext_vector_type(4)));
typedef unsigned u32x4 __attribute__((ext_vector_type(4)));
constexpr int BM = 256, BK = 64, HALF = 128, HTB = HALF * BK * 2  , STAGE_BYTES = 8 * HTB, NXCD = 8, WGM = 8;

__host__ __device__ __forceinline__ int lds_byte(int r, int c) { const int st = (r >> 4) * 2 + (c >> 5), rr = r & 15, cc = c & 31, ob = rr * 64 + cc * 2; return st * 1024 + (ob ^ (((ob >> 9) & 1) << 5)); }
__host__ __device__ __forceinline__ void stage_rc(int b, int& R, int& C) { const int st = b / 1024, sb = b % 1024, swz = sb ^ (((sb >> 9) & 1) << 5); R = (st >> 1) * 16 + swz / 64; C = (st & 1) * 32 + (swz % 64) / 2; }
__host__ __device__ __forceinline__ int perm32(int rho) { const int n = rho >> 4, i = rho & 15; return 8 * (i >> 2) + 4 * n + (i & 3); }

struct Unit { int pm, pn, kb; };
struct Gemm { const bf16_t* A; const bf16_t* Bt; int M, N, K, pad; size_t sA, sB; };

struct StaticOrder {
    int nM, nN, nwg, G, c;
    __host__ __device__ void init(int M, int N, int G_, int c_) { nM = M / BM; nN = N / BM; nwg = nM * nN; G = G_; c = c_; }
    __host__ __device__ bool next(int i, Unit& u) const {
        const long L = (long)i * G + c; if (L >= nwg) return false;
        int wgid = (int)L; { const int q = nwg / NXCD, r = nwg % NXCD, xcd = wgid % NXCD, off = wgid / NXCD; wgid = (xcd < r ? xcd * (q + 1) : r * (q + 1) + (xcd - r) * q) + off; }
        const int nig = WGM * nN, gid = wgid / nig, fm = gid * WGM, gsz = (nM - fm) < WGM ? (nM - fm) : WGM;
        u.pm = fm + ((wgid % nig) % gsz); u.pn = (wgid % nig) / gsz; u.kb = 0; return true;
    }
    __device__ __forceinline__ void a_ready(const Unit&) const {}
    __device__ __forceinline__ void done(const Unit&) const {}
};
struct RangeOrder {
    StaticOrder T; int base, end, Gp, cp;
    __host__ __device__ void init(int M, int N, int base_, int end_, int Gp_, int cp_) { T.init(M, N, 1, 0); base = base_; end = end_ < T.nwg ? end_ : T.nwg; Gp = Gp_; cp = cp_; }
    __host__ __device__ bool next(int i, Unit& u) const { const int L = base + i * Gp + cp; if (L >= end) return false; return T.next(L, u); }
    __device__ __forceinline__ void a_ready(const Unit&) const {}
    __device__ __forceinline__ void done(const Unit&) const {}
};
struct SliceOrder {
    int pm0, nN, n, Gp, cp;
    __host__ __device__ void init(int pm0_, int nP, int nN_, int Gp_, int cp_) { pm0 = pm0_; nN = nN_; n = nP * nN_ * 4; Gp = Gp_; cp = cp_; }
    __host__ __device__ bool next(int i, Unit& u) const { const int L = i * Gp + cp; if (cp < 0 || L >= n) return false; u.kb = L & 3; u.pn = (L >> 2) % nN; u.pm = pm0 + (L >> 2) / nN; return true; }
    __device__ __forceinline__ void a_ready(const Unit&) const {}
    __device__ __forceinline__ void done(const Unit&) const {}
};
struct QuadOrder {
    StaticOrder T;
    __host__ __device__ void init(int M, int N, int G_, int c_) { T.init(M, N, G_, c_); }
    __host__ __device__ bool next(int i, Unit& u) const { const bool ok = T.next(i >> 2, u); u.kb = i & 3; return ok; }
    __device__ __forceinline__ void a_ready(const Unit&) const {}
    __device__ __forceinline__ void done(const Unit&) const {}
};


template <class Epi, class Sched, bool ALIGN_EPI = false, bool SP2 = false>
__device__ __forceinline__ void gemm_phase(PG8_LAS unsigned char* lds, const Gemm g, const Sched& S, const Epi& E, const int tid) {
    const int wid = __builtin_amdgcn_readfirstlane(tid >> 6), lane = tid & 63, wr = wid >> 2, wc = wid & 3, fr = lane & 15, fq = lane >> 4;
    const int K = g.K, nt = K / BK, LD = g.pad > 0 ? g.pad : g.K;
    unsigned voffA[2], voffB[2];
#pragma unroll
    for (int i = 0; i < 2; ++i) { int R, C; stage_rc(tid * 16 + i * 8192, R, C); const int Rb = Epi::PERM ? ((R & ~31) + perm32(R & 31)) : R;
        voffA[i] = (unsigned)(R * LD + C) * 2u; voffB[i] = (unsigned)(Rb * LD + C) * 2u; }
    const size_t kstep = (size_t)(BK * 2);
    const size_t hstep = (size_t)HALF * LD * 2;
    const size_t tstep = 2 * hstep;
    const unsigned ldsw = (unsigned)wid * 1024u;
    const int aoff = lds_byte(wr * 64 + fr, fq * 8), boff = lds_byte(wc * 32 + fr, fq * 8);
#define PG8_SA(b, h) (((b) * 2 + (h)) * HTB)
#define PG8_SB(b, h) ((4 + (b) * 2 + (h)) * HTB)
#define PG8_STAGE(bufoff, gbase, voff) do { _Pragma("unroll") for (int _i = 0; _i < 2; ++_i) \
        __builtin_amdgcn_global_load_lds((const unsigned*)((const char*)(gbase) + (voff)[_i]), (PG8_LAS unsigned*)(lds + (bufoff) + ldsw + _i * 8192), 16, 0, 0); } while (0)
#define PG8_LDA(dst, b, h) do { _Pragma("unroll") for (int m = 0; m < 4; ++m) _Pragma("unroll") for (int k = 0; k < 2; ++k) dst[m][k] = *(const PG8_LAS bf16x8*)(lds + PG8_SA(b, h) + aoff + m * 2048 + k * 1024); } while (0)
#define PG8_LDB(dst, b, h) do { _Pragma("unroll") for (int n = 0; n < 2; ++n) _Pragma("unroll") for (int k = 0; k < 2; ++k) dst[n][k] = *(const PG8_LAS bf16x8*)(lds + PG8_SB(b, h) + boff + n * 2048 + k * 1024); } while (0)
#define PG8_MMA(ai, bj, At, Bt) do { __builtin_amdgcn_s_setprio(1); _Pragma("unroll") for (int m = 0; m < 4; ++m) _Pragma("unroll") for (int n = 0; n < 2; ++n) _Pragma("unroll") for (int k = 0; k < 2; ++k) \
        acc[ai][bj][m][n] = __builtin_amdgcn_mfma_f32_16x16x32_bf16(Bt[n][k], At[m][k], acc[ai][bj][m][n], 0, 0, 0); __builtin_amdgcn_s_setprio(0); } while (0)
#define PG8_WAIT_V(n) asm volatile("s_waitcnt vmcnt(" #n ")" ::: "memory")
#define PG8_WAIT_L(n) asm volatile("s_waitcnt lgkmcnt(" #n ")" ::: "memory")
#define PG8_BAR __builtin_amdgcn_s_barrier()
#define PG8_SCHED __builtin_amdgcn_sched_barrier(0)
    Unit cur, nxt; int ui = 0;
    if (!S.next(0, cur)) return;
    f32x4 acc[2][2][4][2];
#pragma unroll
    for (int a = 0; a < 2; ++a)
#pragma unroll
        for (int b = 0; b < 2; ++b)
#pragma unroll
            for (int m = 0; m < 4; ++m)
#pragma unroll
                for (int n = 0; n < 2; ++n) acc[a][b][m][n] = (f32x4){0.f, 0.f, 0.f, 0.f};
    bf16x8 At[4][2], B0[2][2], B1[2][2];
    const char* cA = (const char*)g.A + (size_t)cur.pm * tstep + (size_t)cur.kb * g.sA; const char* cB = (const char*)g.Bt + (size_t)cur.pn * tstep + (size_t)cur.kb * g.sB;
    S.a_ready(cur);
    if constexpr (SP2) {
        PG8_STAGE(PG8_SB(0, 0), cB, voffB); PG8_STAGE(PG8_SB(0, 1), cB + hstep, voffB); PG8_STAGE(PG8_SA(0, 0), cA, voffA); PG8_STAGE(PG8_SA(0, 1), cA + hstep, voffA);
        if (wr == 1) PG8_BAR;
        PG8_WAIT_V(2); PG8_BAR;
        PG8_STAGE(PG8_SB(1, 0), cB + kstep, voffB); PG8_STAGE(PG8_SA(1, 0), cA + kstep, voffA); PG8_STAGE(PG8_SB(1, 1), cB + hstep + kstep, voffB);
        PG8_WAIT_V(6); PG8_BAR;
    } else {
        PG8_STAGE(PG8_SB(0, 0), cB, voffB); PG8_STAGE(PG8_SA(0, 0), cA, voffA); PG8_STAGE(PG8_SB(0, 1), cB + hstep, voffB); PG8_STAGE(PG8_SA(0, 1), cA + hstep, voffA);
        if (wr == 1) PG8_BAR;
        PG8_WAIT_V(4); PG8_BAR;
        PG8_STAGE(PG8_SB(1, 0), cB + kstep, voffB); PG8_STAGE(PG8_SA(1, 0), cA + kstep, voffA); PG8_STAGE(PG8_SB(1, 1), cB + hstep + kstep, voffB);
        PG8_WAIT_V(6); PG8_BAR;
    }
    for (;;) {
        const bool has_next = S.next(ui + 1, nxt);
        const char* nA = has_next ? (const char*)g.A + (size_t)nxt.pm * tstep + (size_t)nxt.kb * g.sA : cA; const char* nB = has_next ? (const char*)g.Bt + (size_t)nxt.pn * tstep + (size_t)nxt.kb * g.sB : cB;
        for (int t = 0; t < nt; t += 2) {
            const bool last = (t == nt - 2);
            const char* a1 = cA + (size_t)(t + 1) * kstep;
            const char* a2 = last ? nA : cA + (size_t)(t + 2) * kstep; const char* b2 = last ? nB : cB + (size_t)(t + 2) * kstep;
            const char* a3 = a2 + kstep; const char* b3 = b2 + kstep;
            if (last && has_next) S.a_ready(nxt);
            if constexpr (SP2) {
            PG8_LDB(B0, 0, 0); PG8_LDB(B1, 0, 1); PG8_SCHED; PG8_LDA(At, 0, 0); PG8_STAGE(PG8_SA(1, 1), a1 + hstep, voffA);
            PG8_WAIT_V(8); PG8_WAIT_L(0); PG8_BAR; PG8_MMA(0, 0, At, B0); PG8_MMA(0, 1, At, B1); PG8_BAR; PG8_SCHED;
            PG8_LDA(At, 0, 1); PG8_STAGE(PG8_SB(0, 0), b2, voffB); PG8_STAGE(PG8_SB(0, 1), b2 + hstep, voffB); PG8_STAGE(PG8_SA(0, 0), a2, voffA);
            PG8_WAIT_V(8); PG8_WAIT_L(0); PG8_BAR; PG8_MMA(1, 0, At, B0); PG8_MMA(1, 1, At, B1); PG8_BAR; PG8_SCHED;
            PG8_LDB(B0, 1, 0); PG8_LDB(B1, 1, 1); PG8_SCHED; PG8_LDA(At, 1, 0); PG8_STAGE(PG8_SA(0, 1), a2 + hstep, voffA);
            PG8_WAIT_V(8); PG8_WAIT_L(0); PG8_BAR; PG8_MMA(0, 0, At, B0); PG8_MMA(0, 1, At, B1); PG8_BAR; PG8_SCHED;
            PG8_LDA(At, 1, 1); PG8_STAGE(PG8_SB(1, 0), b3, voffB); PG8_STAGE(PG8_SB(1, 1), b3 + hstep, voffB); PG8_STAGE(PG8_SA(1, 0), a3, voffA);
            PG8_WAIT_V(8); PG8_WAIT_L(0); PG8_BAR; PG8_MMA(1, 0, At, B0); PG8_MMA(1, 1, At, B1); PG8_BAR; PG8_SCHED;
            } else {
            PG8_LDB(B0, 0, 0); PG8_SCHED; PG8_LDA(At, 0, 0); PG8_STAGE(PG8_SA(1, 1), a1 + hstep, voffA);
            PG8_WAIT_L(8); PG8_BAR; PG8_WAIT_L(0); PG8_MMA(0, 0, At, B0); PG8_BAR; PG8_SCHED;
            PG8_LDB(B1, 0, 1); PG8_STAGE(PG8_SB(0, 0), b2, voffB);
            PG8_BAR; PG8_WAIT_L(0); PG8_MMA(0, 1, At, B1); PG8_BAR;
            PG8_LDA(At, 0, 1); PG8_STAGE(PG8_SA(0, 0), a2, voffA);
            PG8_BAR; PG8_WAIT_L(0); PG8_MMA(1, 0, At, B0); PG8_BAR; PG8_SCHED;
            PG8_STAGE(PG8_SB(0, 1), b2 + hstep, voffB);
            PG8_WAIT_V(6); PG8_BAR; PG8_MMA(1, 1, At, B1); PG8_BAR;
            PG8_LDB(B0, 1, 0); PG8_SCHED; PG8_LDA(At, 1, 0); PG8_STAGE(PG8_SA(0, 1), a2 + hstep, voffA);
            PG8_WAIT_L(8); PG8_BAR; PG8_WAIT_L(0); PG8_MMA(0, 0, At, B0); PG8_BAR; PG8_SCHED;
            PG8_LDB(B1, 1, 1); PG8_STAGE(PG8_SB(1, 0), b3, voffB);
            PG8_BAR; PG8_WAIT_L(0); PG8_MMA(0, 1, At, B1); PG8_BAR;
            PG8_LDA(At, 1, 1); PG8_STAGE(PG8_SA(1, 0), a3, voffA);
            PG8_BAR; PG8_WAIT_L(0); PG8_MMA(1, 0, At, B0); PG8_BAR; PG8_SCHED;
            PG8_STAGE(PG8_SB(1, 1), b3 + hstep, voffB);
            PG8_WAIT_V(6); PG8_BAR; PG8_MMA(1, 1, At, B1); PG8_BAR;
            }
        }
        if constexpr (ALIGN_EPI) { if (wr == 0) PG8_BAR; }
        if constexpr (!Epi::AFTER_DRAIN) { E(acc, cur, wr, wc, fr, fq); S.done(cur); }
        if (!has_next) break;
#pragma unroll
        for (int a = 0; a < 2; ++a)
#pragma unroll
            for (int b = 0; b < 2; ++b)
#pragma unroll
                for (int m = 0; m < 4; ++m)
#pragma unroll
                    for (int n = 0; n < 2; ++n) acc[a][b][m][n] = (f32x4){0.f, 0.f, 0.f, 0.f};
        cur = nxt; cA = nA; cB = nB; ++ui;
        if constexpr (ALIGN_EPI) { if (wr == 1) PG8_BAR; }
    }
    PG8_WAIT_V(0);
    if constexpr (!ALIGN_EPI) { if (wr == 0) PG8_BAR; }
    PG8_BAR;
    if constexpr (Epi::AFTER_DRAIN) { E.fused(acc, cur, wr, wc, fr, fq, lds, wid, lane); S.done(cur); }
#undef PG8_SA
#undef PG8_SB
#undef PG8_STAGE
#undef PG8_LDA
#undef PG8_LDB
#undef PG8_MMA
#undef PG8_WAIT_V
#undef PG8_WAIT_L
#undef PG8_BAR
#undef PG8_SCHED
}
}

typedef unsigned short bf16;
typedef short bf16x8 __attribute__((ext_vector_type(8)));
typedef float f32x4 __attribute__((ext_vector_type(4)));
typedef float f32x2 __attribute__((ext_vector_type(2)));
typedef unsigned u32x4 __attribute__((ext_vector_type(4)));
typedef unsigned u32x2 __attribute__((ext_vector_type(2)));
#define LAS __attribute__((address_space(3)))
constexpr int D = 2048, NB = 4, SEQ = 8192, DEPTH = 4, CTXL = 256;
constexpr int NLAT = NB * SEQ, NCTX = NB * CTXL, NTOK = NLAT + NCTX;
constexpr int DB = 512, INC = 3328, DFF = 8192, NMOD = 6;
constexpr float EPS = 1e-6f, LOG2E = 1.4426950408889634f, QSCALE = 0.125f * 1.4426950408889634f;
constexpr size_t MiB = 1u << 20;
constexpr size_t WS_CTL = 0, WS_MOD = 1 * MiB, WS_ROPE = 2 * MiB, WS_GWS = 2 * MiB + 256 * 1024;
constexpr size_t WS_WIN = 64 * MiB, WS_WG = 77 * MiB, WS_WBR = 109 * MiB, WS_WOUT = 117 * MiB, WS_WF1 = 125 * MiB, WS_WF2 = 157 * MiB, WS_WGLU = 189 * MiB;
constexpr size_t WS_XC = 190 * MiB, WS_H = 198 * MiB, WS_GA = 330 * MiB, WS_YB = 396 * MiB, WS_Q = 429 * MiB, WS_K = 462 * MiB, WS_VT = 471 * MiB, WS_U = 480 * MiB;
constexpr size_t WS_BR = 514 * MiB, WS_MG = 646 * MiB, WS_G = 778 * MiB, WS_YF = 1306 * MiB, WS_YBK = 1372 * MiB, WS_END = 1438 * MiB;
constexpr size_t WF2_BYTES = (size_t)DFF * D * 2, WS_WF2B = WS_END;
constexpr size_t WS_TOTAL = WS_END + 32 * MiB;
constexpr size_t WS_PS = 1372 * MiB, WS_RS2 = 1378 * MiB, WS_SHW = 1379 * MiB;
constexpr size_t WS_SHWIN = 1380 * MiB, WS_SHWG = 1381 * MiB, WS_RS1 = 1382 * MiB;
constexpr size_t WS_PART = 1384 * MiB;
constexpr size_t WS_YG = WS_GA, WS_MBUF = WS_H;
constexpr size_t WS_VCT = WS_VT + 8 * MiB;
constexpr size_t WS_S5DISC = 4 * MiB;

typedef __bf16 bf16x2_t __attribute__((ext_vector_type(2)));
__device__ __forceinline__ unsigned pk2(float lo, float hi) { const f32x2 v = {lo, hi}; return __builtin_bit_cast(unsigned, __builtin_convertvector(v, bf16x2_t)); }
__device__ __forceinline__ unsigned f2bf(float f) { return pk2(f, f) & 0xffffu; }
__device__ __forceinline__ float bf2f(unsigned b) { return __builtin_bit_cast(float, b << 16); }
__device__ __forceinline__ float bflo(unsigned w) { return __builtin_bit_cast(float, w << 16); }
__device__ __forceinline__ float bfhi(unsigned w) { return __builtin_bit_cast(float, w & 0xffff0000u); }
__device__ __forceinline__ float sigmoidf_(float x) { return __builtin_amdgcn_rcpf(1.f + __builtin_amdgcn_exp2f(-x * LOG2E)); }
__device__ __forceinline__ float gelu_tanh(float x) { const float y = 0.7978845608028654f * (x + 0.044715f * x * x * x); return x * sigmoidf_(2.f * y); }
__device__ __forceinline__ float siluf_(float x) { return x * sigmoidf_(x); }
__device__ __forceinline__ int lane_fresh() { int l; asm volatile("v_mbcnt_lo_u32_b32 %0, -1, 0\n\tv_mbcnt_hi_u32_b32 %0, -1, %0" : "=v"(l)); return l; }
template <int M> __device__ __forceinline__ float shx(float v) {
    if constexpr (M < 32) return __builtin_bit_cast(float, __builtin_amdgcn_ds_swizzle(__builtin_bit_cast(int, v), (M << 10) | 0x1f));
    else return __builtin_bit_cast(float, __builtin_amdgcn_ds_bpermute((lane_fresh() ^ 32) << 2, __builtin_bit_cast(int, v)));
}
__device__ __forceinline__ float wave_sum(float v) { v += shx<1>(v); v += shx<2>(v); v += shx<4>(v); v += shx<8>(v); v += shx<16>(v); v += shx<32>(v); return v; }
struct Args { const float* in[34]; float* out; unsigned char* ws; int layer, which; };
enum { I_X = 0, I_C, I_CTX, I_CCTX, I_WMOD, I_BMOD, I_N1G, I_N2G, I_WIN, I_GLNG, I_GLNB, I_GWS, I_GBS, I_CW, I_CB, I_CLNG, I_CLNB, I_SINK, I_ARE, I_AIM, I_LSTEP, I_BRE, I_BIM, I_CRE, I_CIM,
       I_S5D, I_WGLU, I_WBR, I_WGATE, I_BGATE, I_WOUT, I_WF1, I_WF2, I_FINALG };

struct PA {
    volatile LAS unsigned* tab;
    __device__ __forceinline__ unsigned long long get(int i) const { unsigned z; asm volatile("v_mov_b32 %0, 0" : "=v"(z)); volatile LAS unsigned* t = (volatile LAS unsigned*)((LAS unsigned char*)tab + z); unsigned lo = t[2 * i], hi = t[2 * i + 1]; lo = __builtin_amdgcn_readfirstlane(lo); hi = __builtin_amdgcn_readfirstlane(hi); return ((unsigned long long)hi << 32) | lo; }
    __device__ __forceinline__ const float* in(int i) const { return (const float*)(const __attribute__((address_space(1))) float*)get(i); }
    __device__ __forceinline__ float* out() const { return (float*)(__attribute__((address_space(1))) float*)get(34); }
    __device__ __forceinline__ unsigned char* ws() const { return (unsigned char*)(__attribute__((address_space(1))) unsigned char*)get(35); }
};
#define FRESH_TID() ({ int w_ = wave_s; asm volatile("" : "+s"(w_)); int t_ = (w_ << 6) | lane_fresh(); asm volatile("" : "+v"(t_)); t_; })

#define XB_TMO      128
#define XB_XCNT(j)  (256  + 64 * (j))
#define XB_XSUB(j)  (1280 + 64 * (j))
#define XB_XGEN(j)  (2304 + 64 * (j))
#define XB_TOP      3328
#define XB_TOPGEN   3392
#define XCD_BAR_WORDS 3456
#define XB_SPIN_CAP (1u << 22)

__device__ __forceinline__ unsigned xb_ld(unsigned* p)              { return __hip_atomic_load(p, __ATOMIC_RELAXED, __HIP_MEMORY_SCOPE_AGENT); }
__device__ __forceinline__ unsigned xb_add(unsigned* p, unsigned v) { return __hip_atomic_fetch_add(p, v, __ATOMIC_RELAXED, __HIP_MEMORY_SCOPE_AGENT); }
__device__ __forceinline__ unsigned xb_xcc_id() { return (unsigned)__builtin_amdgcn_s_getreg((3 << 11) | 20) & 0xFu; }
#define XB_SPIN(cond, bar) do { unsigned _sp = 0; while (cond) { __builtin_amdgcn_s_sleep(1); \
    if ((++_sp & 255u) == 0u) { if (xb_ld(&(bar)[XB_TMO])) break; if (_sp > XB_SPIN_CAP) { atomicAdd(&(bar)[XB_TMO], 1u); break; } } } } while (0)

struct XcdBarrier {
    unsigned* bar; unsigned x;
    volatile LAS unsigned* st;
};

__device__ __forceinline__ XcdBarrier xcd_barrier_post(unsigned* bar, volatile LAS unsigned* st) {
    XcdBarrier b; b.bar = bar; b.x = xb_xcc_id(); b.st = st;
    if (threadIdx.x == 0) (void)xb_add(&bar[XB_XCNT(b.x)], 1u);
    return b;
}
__device__ __forceinline__ void xcd_barrier_complete(unsigned* bar, unsigned x, unsigned& nloc, unsigned& nx) {
    const unsigned G = gridDim.x * gridDim.y * gridDim.z;
    unsigned sum, cnt, mine, sp = 0u;
    for (;;) {
        sum = 0u; cnt = 0u; mine = 0u;
#pragma unroll
        for (unsigned j = 0; j < 16; ++j) { const unsigned c = xb_ld(&bar[XB_XCNT(j)]); sum += c; cnt += (c > 0u) ? 1u : 0u; mine = (j == x) ? c : mine; }
        if (sum == G) break;
        __builtin_amdgcn_s_sleep(1);
        if ((++sp & 255u) == 0u) { if (xb_ld(&bar[XB_TMO])) break; if (sp > XB_SPIN_CAP) { atomicAdd(&bar[XB_TMO], 1u); break; } }
    }
    nloc = mine > 0u ? mine : 1u; nx = cnt > 0u ? cnt : 1u;
}

__device__ __forceinline__ void xcd_barrier(const XcdBarrier& b) {
    asm volatile("s_waitcnt vmcnt(0)" ::: "memory");
    __syncthreads();
    if (threadIdx.x == 0) {
        unsigned* bar = b.bar;
        __builtin_amdgcn_s_waitcnt(0);
        unsigned nloc = b.st[0], nx = b.st[1];
        if (nloc == 0u) { xcd_barrier_complete(bar, b.x, nloc, nx); b.st[0] = nloc; b.st[1] = nx; }
        const unsigned old = xb_add(&bar[XB_XSUB(b.x)], 1u);
        const unsigned gen = old / nloc;
        if (old + 1u == (gen + 1u) * nloc) {
            __builtin_amdgcn_fence(__ATOMIC_RELEASE, "agent");
            asm volatile("s_waitcnt vmcnt(0)" ::: "memory");
            const unsigned og = xb_add(&bar[XB_TOP], 1u);
            const unsigned tg = og / nx;
            if (og + 1u == (tg + 1u) * nx) xb_add(&bar[XB_TOPGEN], 1u);
            else XB_SPIN(xb_ld(&bar[XB_TOPGEN]) == tg, bar);
            __builtin_amdgcn_fence(__ATOMIC_ACQUIRE, "agent");
            xb_add(&bar[XB_XGEN(b.x)], 1u);
            asm volatile("s_waitcnt vmcnt(0)" ::: "memory");
        } else {
            XB_SPIN(xb_ld(&bar[XB_XGEN(b.x)]) == gen, bar);
            __builtin_amdgcn_fence(__ATOMIC_ACQUIRE, "agent");
            asm volatile("s_waitcnt vmcnt(0)" ::: "memory");
        }
    }
    __syncthreads();
}

__device__ __forceinline__ void prologue_block(const PA& a, int bid, LAS unsigned char* lds, int tid) {
    if (bid > 192) return;
    if (bid == 192) {
        f32x2* rt = (f32x2*)(a.ws() + WS_ROPE);
        for (int i = tid; i < 2048; i += 512) { const int pos = i >> 4, fi = i & 15; const double inv = pow(10000.0, -(double)fi / 16.0); const double ang = (double)pos * inv;
            rt[i] = (f32x2){(float)cos(ang), (float)sin(ang)}; }
        return;
    }
    LAS float* sc = (LAS float*)lds; LAS float* part = (LAS float*)(lds + 40960);
    const float* c = a.in(I_C); const float* cc = a.in(I_CCTX);
    for (int i = tid; i < 5 * 2048; i += 512) { const int s = i >> 11, k = i & 2047; const float v = s < 4 ? c[s * 2048 + k] : cc[k]; sc[i] = v / (1.f + expf(-v)); }
    __syncthreads();
    const int col = bid * 256 + (tid & 255), kh = tid >> 8;
    const int l = col / 12288, j = col % 12288;
    const float* w = a.in(I_WMOD) + (size_t)l * 2048 * 12288 + (size_t)kh * 1024 * 12288 + j;
    float acc[5] = {0.f, 0.f, 0.f, 0.f, 0.f};
#pragma unroll 1
    for (int k0 = 0; k0 < 1024; k0 += 32) { float wv[32];
#pragma unroll
        for (int k = 0; k < 32; ++k) wv[k] = w[(size_t)(k0 + k) * 12288];
#pragma unroll
        for (int k = 0; k < 32; ++k)
#pragma unroll
            for (int s = 0; s < 5; ++s) acc[s] += sc[s * 2048 + kh * 1024 + k0 + k] * wv[k]; }
    if (kh == 1) {
#pragma unroll
        for (int s = 0; s < 5; ++s) part[s * 256 + (tid & 255)] = acc[s]; }
    __syncthreads();
    if (kh == 0) { const float b = a.in(I_BMOD)[l * 12288 + j]; float* mv = (float*)(a.ws() + WS_MOD);
#pragma unroll
        for (int s = 0; s < 5; ++s) mv[(size_t)(l * 5 + s) * 12288 + j] = acc[s] + part[s * 256 + (tid & 255)] + b; }
}

__device__ __forceinline__ int inproj_map(int n) {
    if (n < 1024) return n;
    if (n < 2048) { const int m = n - 1024; return 1024 + (m < 512 ? 2 * m : 2 * (m - 512) + 1); }
    if (n < 2688) { const int base = n < 2560 ? 2048 : 2560; const int m = n - base, head = m >> 6, d = m & 63, half = d >> 5, i = d & 31; return base + head * 64 + half * 32 + 2 * (i & 15) + (i >> 4); }
    return n;
}
__device__ __forceinline__ int rowmap(int mode, int n) {
    if (mode == 1) return inproj_map(n);
    if (mode == 2) return n < 512 ? 2 * n : 2 * (n - 512) + 1;
    return n;
}
__device__ __forceinline__ void cvt_item(const float* W, int K, int N, bf16* WT, int mode, LAS float* scr, int item, int lane) {
    const int nblk = N / 64, kb = item / nblk, nb = item % nblk, k0 = 32 * kb, n0 = 64 * nb;
    f32x4 v[8];
#pragma unroll
    for (int i = 0; i < 8; ++i) v[i] = *(const f32x4*)(W + (size_t)(k0 + 4 * i + (lane >> 4)) * N + n0 + (lane & 15) * 4);
#pragma unroll
    for (int i = 0; i < 8; ++i) { LAS float* s = scr + (4 * i + (lane >> 4)) * 65 + (lane & 15) * 4; s[0] = v[i].x; s[1] = v[i].y; s[2] = v[i].z; s[3] = v[i].w; }
    asm volatile("s_waitcnt lgkmcnt(0)" ::: "memory");
#pragma unroll
    for (int j = 0; j < 4; ++j) { const int idx = lane + 64 * j, n = idx >> 2, c = idx & 3; const LAS float* s = scr + (8 * c) * 65 + n;
        u32x4 o; o.x = pk2(s[0 * 65], s[1 * 65]); o.y = pk2(s[2 * 65], s[3 * 65]); o.z = pk2(s[4 * 65], s[5 * 65]); o.w = pk2(s[6 * 65], s[7 * 65]);
        *(u32x4*)(WT + (size_t)rowmap(mode, n0 + n) * K + k0 + 8 * c) = o; }
    asm volatile("s_waitcnt lgkmcnt(0)" ::: "memory");
}
__device__ __forceinline__ void convert_layer(const PA& a, int l, LAS float* scr, int gw, int NGW, int lane, int gtid, int nthr, int it_lo = 0, int it_hi = 1 << 30) {
    unsigned char* ws = a.ws();
    constexpr int I_IN = 64 * 52, I_G = 64 * 32, I_B = 16 * 32, I_O = 64 * 32, I_1 = 64 * 128, I_2 = 256 * 32, I_GL = 16 * 16;
    constexpr int NITEMS = I_IN + 4 * I_G + 4 * I_B + I_O + I_1 + I_2 + I_GL;
    const int it_end = it_hi < NITEMS ? it_hi : NITEMS;
    for (int it = it_lo + gw; it < it_end; it += NGW) {
        int r = it;
        if (r < I_IN) { cvt_item(a.in(I_WIN) + (size_t)l * D * INC, D, INC, (bf16*)(ws + WS_WIN), 1, scr, r, lane); continue; } r -= I_IN;
        if (r < 4 * I_G) { const int k = r / I_G; cvt_item(a.in(I_WGATE) + (size_t)(l * 4 + k) * D * D, D, D, (bf16*)(ws + WS_WG) + (size_t)k * D * D, 0, scr, r % I_G, lane); continue; } r -= 4 * I_G;
        if (r < 4 * I_B) { const int k = r / I_B; cvt_item(a.in(I_WBR) + (size_t)(l * 4 + k) * DB * D, DB, D, (bf16*)(ws + WS_WBR) + (size_t)k * D * DB, 0, scr, r % I_B, lane); continue; } r -= 4 * I_B;
        if (r < I_O) { cvt_item(a.in(I_WOUT) + (size_t)l * D * D, D, D, (bf16*)(ws + WS_WOUT), 0, scr, r, lane); continue; } r -= I_O;
        if (r < I_1) { cvt_item(a.in(I_WF1) + (size_t)l * D * DFF, D, DFF, (bf16*)(ws + WS_WF1), 0, scr, r, lane); continue; } r -= I_1;
        if (r < I_2) { cvt_item(a.in(I_WF2) + (size_t)l * DFF * D, DFF, D, (bf16*)(ws + ((l & 1) ? WS_WF2B : WS_WF2)), 0, scr, r, lane); continue; } r -= I_2;
        cvt_item(a.in(I_WGLU) + (size_t)l * DB * 1024, DB, 1024, (bf16*)(ws + WS_WGLU), 2, scr, r, lane);
    }
    bf16* gws = (bf16*)(ws + WS_GWS); const float* gsrc = a.in(I_GWS) + (size_t)l * 65536;
    if (it_lo == 0) for (int i = gtid; i < 65536; i += nthr) gws[i] = (bf16)f2bf(gsrc[i]);
}

__device__ __forceinline__ const float* xrow_src(const PA& a, int layer, int which, int r) {
    if (layer == 0 && which == 1) return r < NLAT ? a.in(I_X) + (size_t)r * D : a.in(I_CTX) + (size_t)(r - NLAT) * D;
    return r < NLAT ? a.out() + (size_t)r * D : (const float*)(a.ws() + WS_XC) + (size_t)(r - NLAT) * D;
}
__device__ __forceinline__ void norm_rows(const PA& a, int layer, int which, int gw, int NGW, int lane, int nrows) {
    const float* ng = a.in(which == 1 ? I_N1G : I_N2G) + layer * D;
    bf16* H = (bf16*)(a.ws() + WS_H);
    const float* mvb = (const float*)(a.ws() + WS_MOD) + (size_t)(layer * 5) * 12288 + (which == 1 ? 0 : 3) * D;
    f32x4 ca[8], cb[8]; int cur = -1;
#pragma unroll 1
    for (int r0 = gw; r0 < nrows; r0 += 3 * NGW) {
        f32x4 v[3][8]; float ss[3];
#pragma unroll
        for (int q = 0; q < 3; ++q) { const int r = r0 + q * NGW; const int rr = r < nrows ? r : r0; const f32x4* xr = (const f32x4*)xrow_src(a, layer, which, rr) + lane; ss[q] = 0.f;
#pragma unroll
            for (int j = 0; j < 8; ++j) v[q][j] = xr[64 * j]; }
#pragma unroll
        for (int q = 0; q < 3; ++q) {
#pragma unroll
            for (int j = 0; j < 8; ++j) ss[q] += (v[q][j].x * v[q][j].x + v[q][j].y * v[q][j].y) + (v[q][j].z * v[q][j].z + v[q][j].w * v[q][j].w); }
#pragma unroll
        for (int q = 0; q < 3; ++q) ss[q] = wave_sum(ss[q]);
#pragma unroll
        for (int q = 0; q < 3; ++q) { const int r = r0 + q * NGW; if (r < nrows) {
            const float rs = 1.f / sqrtf(ss[q] * (1.f / D) + EPS);
            const int s = r < NLAT ? (r >> 13) : 4;
            if (s != cur) { cur = s; const float* mv = mvb + (size_t)s * 12288;
#pragma unroll
                for (int j = 0; j < 8; ++j) { const int col = (lane + 64 * j) * 4; ca[j] = *(const f32x4*)(ng + col) * (*(const f32x4*)(mv + D + col) + 1.f); cb[j] = *(const f32x4*)(mv + col); } }
            u32x2* o8 = (u32x2*)(H + (size_t)r * D) + lane;
#pragma unroll
            for (int j = 0; j < 8; ++j) { const f32x4 y = (v[q][j] * rs) * ca[j] + cb[j]; o8[64 * j] = (u32x2){pk2(y.x, y.y), pk2(y.z, y.w)}; } } }
    }
}

__device__ __forceinline__ void norm_ctx_rows(const PA& a, int layer, int gw, int NGW, int lane) {
    const float* ng = a.in(I_N1G) + layer * D; bf16* H = (bf16*)(a.ws() + WS_H);
    const float* mv = (const float*)(a.ws() + WS_MOD) + (size_t)(layer * 5 + 4) * 12288;
    const float* g2 = (const float*)(a.ws() + WS_MOD) + (size_t)((layer - 1) * 5 + 4) * 12288 + 5 * D;
    const float* part = (const float*)(a.ws() + WS_PART);
    for (int rc = gw; rc < NCTX; rc += NGW) {
        f32x4* xr = (f32x4*)(a.ws() + WS_XC + (size_t)rc * D * 4) + lane; f32x4 v[8]; float ss = 0.f;
#pragma unroll
        for (int j = 0; j < 8; ++j) { const int col = (lane + 64 * j) * 4; const float* pp = part + (size_t)rc * D + col;
            const f32x4 p = ((*(const f32x4*)pp + *(const f32x4*)(pp + (size_t)NCTX * D)) + *(const f32x4*)(pp + (size_t)2 * NCTX * D)) + *(const f32x4*)(pp + (size_t)3 * NCTX * D);
            v[j] = xr[64 * j] + *(const f32x4*)(g2 + col) * p; xr[64 * j] = v[j];
            ss += (v[j].x * v[j].x + v[j].y * v[j].y) + (v[j].z * v[j].z + v[j].w * v[j].w); }
        const float sm = wave_sum(ss); if (lane == 0) ((float*)(a.ws() + WS_RS1))[NLAT + rc] = 1.f / sqrtf(sm * (1.f / D) + EPS);
        u32x2* o8 = (u32x2*)(H + (size_t)(NLAT + rc) * D) + lane;
#pragma unroll
        for (int j = 0; j < 8; ++j) { const int col = (lane + 64 * j) * 4;
            const f32x4 y = v[j] * *(const f32x4*)(ng + col) * (*(const f32x4*)(mv + D + col) + 1.f);
            o8[64 * j] = (u32x2){pk2(y.x, y.y), pk2(y.z, y.w)}; }
    }
}

__device__ __forceinline__ void merge_ctx_rows(const PA& a, int gw, int NGW, int lane) {
    const float* part = (const float*)(a.ws() + WS_PART); bf16* MGp = (bf16*)(a.ws() + WS_MG);
    for (int rc = gw; rc < NCTX; rc += NGW) {
        u32x2* o8 = (u32x2*)(MGp + (size_t)(NLAT + rc) * D) + lane; f32x4 v[8];
#pragma unroll
        for (int j = 0; j < 8; ++j) { const int col = (lane + 64 * j) * 4; const float* pp = part + (size_t)rc * D + col;
            v[j] = ((*(const f32x4*)pp + *(const f32x4*)(pp + (size_t)NCTX * D)) + *(const f32x4*)(pp + (size_t)2 * NCTX * D)) + *(const f32x4*)(pp + (size_t)3 * NCTX * D); }
#pragma unroll
        for (int j = 0; j < 8; ++j) o8[64 * j] = (u32x2){pk2(v[j].x, v[j].y), pk2(v[j].z, v[j].w)};
    }
}
__device__ __forceinline__ void outproj_ctx_rows(const PA& a, int layer, int gw, int NGW, int lane) {
    const float* ng = a.in(I_N2G) + layer * D; bf16* H = (bf16*)(a.ws() + WS_H);
    const float* mv = (const float*)(a.ws() + WS_MOD) + (size_t)(layer * 5 + 4) * 12288;
    const float* part = (const float*)(a.ws() + WS_PART);
    const float* srcb = layer == 0 ? a.in(I_CTX) : (const float*)(a.ws() + WS_XC);
    for (int rc = gw; rc < NCTX; rc += NGW) {
        const f32x4* xs = (const f32x4*)(srcb + (size_t)rc * D) + lane; f32x4* xr = (f32x4*)(a.ws() + WS_XC + (size_t)rc * D * 4) + lane; f32x4 v[8]; float ss = 0.f;
#pragma unroll
        for (int j = 0; j < 8; ++j) { const int col = (lane + 64 * j) * 4; const float* pp = part + (size_t)rc * D + col;
            const f32x4 p = ((*(const f32x4*)pp + *(const f32x4*)(pp + (size_t)NCTX * D)) + *(const f32x4*)(pp + (size_t)2 * NCTX * D)) + *(const f32x4*)(pp + (size_t)3 * NCTX * D);
            v[j] = xs[64 * j] + *(const f32x4*)(mv + 2 * D + col) * p; }
#pragma unroll
        for (int j = 0; j < 8; ++j) { xr[64 * j] = v[j]; ss += (v[j].x * v[j].x + v[j].y * v[j].y) + (v[j].z * v[j].z + v[j].w * v[j].w); }
        const float sm = wave_sum(ss); if (lane == 0) ((float*)(a.ws() + WS_RS2))[NLAT + rc] = 1.f / sqrtf(sm * (1.f / D) + EPS);
        u32x2* o8 = (u32x2*)(H + (size_t)(NLAT + rc) * D) + lane;
#pragma unroll
        for (int j = 0; j < 8; ++j) { const int col = (lane + 64 * j) * 4;
            const f32x4 y = v[j] * *(const f32x4*)(ng + col) * (*(const f32x4*)(mv + 4 * D + col) + 1.f);
            o8[64 * j] = (u32x2){pk2(y.x, y.y), pk2(y.z, y.w)}; }
    }
}

__device__ __forceinline__ void final_rows(const PA& a, int gw, int NGW, int lane) {
    const float* fg = a.in(I_FINALG);
#pragma unroll 1
    for (int r0 = gw; r0 < NLAT; r0 += 2 * NGW) {
        f32x4 v[2][8]; float ss[2];
#pragma unroll
        for (int q = 0; q < 2; ++q) { const int r = r0 + q * NGW; const int rr = r < NLAT ? r : r0; const f32x4* xr = (const f32x4*)(a.out() + (size_t)rr * D) + lane; ss[q] = 0.f;
#pragma unroll
            for (int j = 0; j < 8; ++j) v[q][j] = xr[64 * j]; }
#pragma unroll
        for (int q = 0; q < 2; ++q) {
#pragma unroll
            for (int j = 0; j < 8; ++j) ss[q] += (v[q][j].x * v[q][j].x + v[q][j].y * v[q][j].y) + (v[q][j].z * v[q][j].z + v[q][j].w * v[q][j].w); }
#pragma unroll
        for (int q = 0; q < 2; ++q) ss[q] = wave_sum(ss[q]);
#pragma unroll
        for (int q = 0; q < 2; ++q) { const int r = r0 + q * NGW; if (r < NLAT) { const float rs = 1.f / sqrtf(ss[q] * (1.f / D) + EPS); f32x4* xw = (f32x4*)(a.out() + (size_t)r * D) + lane;
#pragma unroll
            for (int j = 0; j < 8; ++j) { const int col = (lane + 64 * j) * 4; xw[64 * j] = v[q][j] * rs * *(const f32x4*)(fg + col); } } }
    }
}

__device__ __forceinline__ void rs2_rows(const PA& a, int gtid, int nthr, int nrows, size_t rs_off = WS_RS2) {
    const f32x4* ps = (const f32x4*)(a.ws() + WS_PS); float* rs = (float*)(a.ws() + rs_off);
    for (int r = gtid; r < nrows; r += nthr) { float s = 0.f;
#pragma unroll
        for (int j = 0; j < 8; ++j) { const f32x4 p = ps[(size_t)r * 8 + j]; s += (p.x + p.y) + (p.z + p.w); }
        rs[r] = 1.f / sqrtf(s * (1.f / D) + EPS); }
}
__device__ __forceinline__ void shw_rows(const PA& a, int l, int shidx, const bf16* W, int N, float* out, const float* bias, LAS unsigned char* lds, int tid, int gw, int NGW) {
    LAS float* sh = (LAS float*)lds; const int lane = tid & 63;
    const float* mv = (const float*)(a.ws() + WS_MOD) + (size_t)l * 5 * 12288 + shidx * D;
    __syncthreads();
    { float t20[20];
#pragma unroll
      for (int j = 0; j < 20; ++j) { const int i = tid + 512 * j; t20[j] = mv[(size_t)(i >> 11) * 12288 + (i & 2047)]; }
#pragma unroll
      for (int j = 0; j < 20; ++j) sh[tid + 512 * j] = t20[j]; }
    __syncthreads();
    for (int n = gw; n < N; n += NGW) { float acc[5] = {0.f, 0.f, 0.f, 0.f, 0.f};
#pragma unroll
        for (int j = 0; j < 4; ++j) { const int k0 = j * 512 + lane * 8; const u32x4 x = *(const u32x4*)(W + (size_t)n * D + k0);
            const float wv[8] = {bflo(x.x), bfhi(x.x), bflo(x.y), bfhi(x.y), bflo(x.z), bfhi(x.z), bflo(x.w), bfhi(x.w)};
#pragma unroll
            for (int s = 0; s < 5; ++s) { const f32x4 h0 = *(const LAS f32x4*)(sh + s * 2048 + k0), h1 = *(const LAS f32x4*)(sh + s * 2048 + k0 + 4);
                acc[s] += (wv[0] * h0.x + wv[1] * h0.y) + (wv[2] * h0.z + wv[3] * h0.w) + (wv[4] * h1.x + wv[5] * h1.y) + (wv[6] * h1.z + wv[7] * h1.w); } }
        const float bn = bias ? bias[n] : 0.f;
#pragma unroll
        for (int s = 0; s < 5; ++s) { const float t = wave_sum(acc[s]); if (lane == 0) out[(size_t)s * N + n] = t + bn; } }
    __syncthreads();
}

__device__ __forceinline__ void neutral_norm1(const PA& a, int gtid, int nthr) {
    float* rs1 = (float*)(a.ws() + WS_RS1); float* si = (float*)(a.ws() + WS_SHWIN); float* sg = (float*)(a.ws() + WS_SHWG); const float* bg = a.in(I_BGATE);
    for (int i = gtid; i < NTOK; i += nthr) rs1[i] = 1.f;
    for (int i = gtid; i < 5 * INC; i += nthr) si[i] = 0.f;
    for (int i = gtid; i < 5 * DFF; i += nthr) sg[i] = bg[i % DFF];
}

using pg8::Unit;
#define EPI_LOOP _Pragma("unroll") for (int ai = 0; ai < 2; ++ai) _Pragma("unroll") for (int m = 0; m < 4; ++m) _Pragma("unroll") for (int bj = 0; bj < 2; ++bj)

struct EpiInProj {
    static constexpr bool PERM = true, AFTER_DRAIN = false;
    bf16 *ga, *yb, *q, *k, *vT, *vcT, *u; const f32x2* rope; const float* rs; const float* shw;
    __device__ __forceinline__ void operator()(const f32x4 (&acc)[2][2][4][2], const Unit& un, int wr, int wc, int fr, int fq) const {
        const int pn = un.pn, rbase = un.pm * 256 + wr * 64 + fr, cw = wc * 32 + 8 * fq;
        const bool lat = un.pm < (NLAT / 256);
        const float* sw = shw + (size_t)(lat ? (un.pm >> 5) : 4) * INC + pn * 256 + cw;
        f32x4 s0[2], s1[2]; float rr[2][4];
#pragma unroll
        for (int bj = 0; bj < 2; ++bj) { s0[bj] = *(const f32x4*)(sw + bj * 128); s1[bj] = *(const f32x4*)(sw + bj * 128 + 4); }
#pragma unroll
        for (int ai = 0; ai < 2; ++ai)
#pragma unroll
            for (int m = 0; m < 4; ++m) rr[ai][m] = rs[rbase + ai * 128 + m * 16];
        const bool ropetile = lat && pn >= 8 && pn <= 10; const int pih_ = cw & 63, half_ = pih_ >> 5, i0_ = (pih_ & 31) >> 1;
#pragma unroll
        for (int ai = 0; ai < 2; ++ai) {
        f32x4 rp[4][2];
        if (ropetile) {
#pragma unroll
            for (int m = 0; m < 4; ++m) { const int t = (rbase + ai * 128 + m * 16) & (SEQ - 1), pos = half_ ? (t & 63) : (t >> 6); const f32x4* rq = (const f32x4*)(rope + pos * 16 + i0_); rp[m][0] = rq[0]; rp[m][1] = rq[1]; } }
#pragma unroll
        for (int m = 0; m < 4; ++m)
#pragma unroll
        for (int bj = 0; bj < 2; ++bj) {
            const int row = rbase + ai * 128 + m * 16; const int ct = bj * 128 + cw;
            const f32x4 v0 = acc[ai][bj][m][0] * rr[ai][m] + s0[bj], v1 = acc[ai][bj][m][1] * rr[ai][m] + s1[bj];
            if (pn < 4) {
                u32x4 w; w.x = pk2(gelu_tanh(v0.x), gelu_tanh(v0.y)); w.y = pk2(gelu_tanh(v0.z), gelu_tanh(v0.w)); w.z = pk2(gelu_tanh(v1.x), gelu_tanh(v1.y)); w.w = pk2(gelu_tanh(v1.z), gelu_tanh(v1.w));
                *(u32x4*)(ga + (size_t)row * 1024 + pn * 256 + ct) = w;
            } else if (pn < 8) {
                u32x2 w; w.x = pk2(v0.x * sigmoidf_(v0.y), v0.z * sigmoidf_(v0.w)); w.y = pk2(v1.x * sigmoidf_(v1.y), v1.z * sigmoidf_(v1.w));
                *(u32x2*)(yb + (size_t)row * 512 + (((pn - 4) * 256 + ct) >> 1)) = w;
            } else if (pn < 10 || (pn == 10 && bj == 0)) {
                const bool isq = pn < 10; const int cs = isq ? (pn - 8) * 256 + ct : ct;
                float x[8] = {v0.x, v0.y, v0.z, v0.w, v1.x, v1.y, v1.z, v1.w};
                if (lat) { const f32x4 ra = rp[m][0], rb = rp[m][1]; const float cc[4] = {ra.x, ra.z, rb.x, rb.z}, sn[4] = {ra.y, ra.w, rb.y, rb.w};
#pragma unroll
                    for (int jj = 0; jj < 4; ++jj) { const float x1 = x[2 * jj], x2 = x[2 * jj + 1]; x[2 * jj] = x1 * cc[jj] - x2 * sn[jj]; x[2 * jj + 1] = x1 * sn[jj] + x2 * cc[jj]; } }
                const float sc = isq ? QSCALE : 1.f;
                u32x4 w; w.x = pk2(x[0] * sc, x[1] * sc); w.y = pk2(x[2] * sc, x[3] * sc); w.z = pk2(x[4] * sc, x[5] * sc); w.w = pk2(x[6] * sc, x[7] * sc);
                if (isq) *(u32x4*)(q + (size_t)row * 512 + cs) = w; else *(u32x4*)(k + (size_t)row * 128 + cs) = w;
            } else if (pn == 10) {
                const int dc = ct - 128; const float x[8] = {v0.x, v0.y, v0.z, v0.w, v1.x, v1.y, v1.z, v1.w};
                if (lat) { const int b = row >> 13, t = row & (SEQ - 1);
#pragma unroll
                    for (int e = 0; e < 8; ++e) vT[((size_t)(b * 128 + dc + e)) * SEQ + t] = (bf16)f2bf(x[e]); }
                else { const int rc = row - NLAT, b = rc >> 8, t = rc & 255;
#pragma unroll
                    for (int e = 0; e < 8; ++e) vcT[((size_t)(b * 128 + dc + e)) * CTXL + t] = (bf16)f2bf(x[e]); }
            } else {
                u32x4 w; w.x = pk2(v0.x, v0.y); w.y = pk2(v0.z, v0.w); w.z = pk2(v1.x, v1.y); w.w = pk2(v1.z, v1.w);
                const int col = (pn - 11) * 256 + ct;
                *(u32x4*)(u + ((size_t)(col >> 4) * NTOK + row) * 16 + (col & 15)) = w;
            }
        } }
    }
};
struct EpiGlu {
    static constexpr bool PERM = true, AFTER_DRAIN = false;
    bf16* o;
    __device__ __forceinline__ void operator()(const f32x4 (&acc)[2][2][4][2], const Unit& un, int wr, int wc, int fr, int fq) const {
        const int rbase = un.pm * 256 + wr * 64 + fr, cw = un.pn * 256 + wc * 32 + 8 * fq;
        EPI_LOOP { const int row = rbase + ai * 128 + m * 16; const f32x4 v0 = acc[ai][bj][m][0], v1 = acc[ai][bj][m][1];
            u32x2 w; w.x = pk2(v0.x * sigmoidf_(v0.y), v0.z * sigmoidf_(v0.w)); w.y = pk2(v1.x * sigmoidf_(v1.y), v1.z * sigmoidf_(v1.w));
            *(u32x2*)(o + (size_t)row * 512 + ((cw + bj * 128) >> 1)) = w; }
    }
};
template <int ACT  > struct EpiAct {
    static constexpr bool PERM = true, AFTER_DRAIN = false;
    bf16* o; const float* bias; int ldc, pad;
    __device__ __forceinline__ void operator()(const f32x4 (&acc)[2][2][4][2], const Unit& un, int wr, int wc, int fr, int fq) const {
        const int rbase = un.pm * 256 + wr * 64 + fr, cw = un.pn * 256 + wc * 32 + 8 * fq;
        f32x4 b0[2], b1[2];
#pragma unroll
        for (int bj = 0; bj < 2; ++bj) { b0[bj] = ACT == 0 ? *(const f32x4*)(bias + cw + bj * 128) : (f32x4){0.f, 0.f, 0.f, 0.f}; b1[bj] = ACT == 0 ? *(const f32x4*)(bias + cw + bj * 128 + 4) : (f32x4){0.f, 0.f, 0.f, 0.f}; }
        EPI_LOOP { const int row = rbase + ai * 128 + m * 16, col = cw + bj * 128; f32x4 v0 = acc[ai][bj][m][0], v1 = acc[ai][bj][m][1];
            if (ACT == 0) { v0 += b0[bj]; v1 += b1[bj];
                v0 = (f32x4){sigmoidf_(v0.x), sigmoidf_(v0.y), sigmoidf_(v0.z), sigmoidf_(v0.w)}; v1 = (f32x4){sigmoidf_(v1.x), sigmoidf_(v1.y), sigmoidf_(v1.z), sigmoidf_(v1.w)}; }
            else { v0 = __builtin_elementwise_max(v0, (f32x4){0.f, 0.f, 0.f, 0.f}); v1 = __builtin_elementwise_max(v1, (f32x4){0.f, 0.f, 0.f, 0.f}); v0 = v0 * v0; v1 = v1 * v1; }
            u32x4 w; w.x = pk2(v0.x, v0.y); w.y = pk2(v0.z, v0.w); w.z = pk2(v1.x, v1.y); w.w = pk2(v1.z, v1.w);
            *(u32x4*)(o + (size_t)row * ldc + col) = w; }
    }
};
struct EpiGate {
    static constexpr bool PERM = true, AFTER_DRAIN = false;
    bf16* o; const float* rs; const float* shw;
    __device__ __forceinline__ void operator()(const f32x4 (&acc)[2][2][4][2], const Unit& un, int wr, int wc, int fr, int fq) const {
        const int rbase = un.pm * 256 + wr * 64 + fr, cw = un.pn * 256 + wc * 32 + 8 * fq;
        const int slot = un.pm < (NLAT / 256) ? (un.pm >> 5) : 4; const float* sw = shw + (size_t)slot * DFF;
        f32x4 s0[2], s1[2]; float rr[2][4];
#pragma unroll
        for (int bj = 0; bj < 2; ++bj) { s0[bj] = *(const f32x4*)(sw + cw + bj * 128); s1[bj] = *(const f32x4*)(sw + cw + bj * 128 + 4); }
#pragma unroll
        for (int ai = 0; ai < 2; ++ai)
#pragma unroll
            for (int m = 0; m < 4; ++m) rr[ai][m] = rs[rbase + ai * 128 + m * 16];
        EPI_LOOP { const int row = rbase + ai * 128 + m * 16, col = cw + bj * 128; const float r = rr[ai][m];
            f32x4 v0 = acc[ai][bj][m][0] * r + s0[bj], v1 = acc[ai][bj][m][1] * r + s1[bj];
            v0 = (f32x4){sigmoidf_(v0.x), sigmoidf_(v0.y), sigmoidf_(v0.z), sigmoidf_(v0.w)}; v1 = (f32x4){sigmoidf_(v1.x), sigmoidf_(v1.y), sigmoidf_(v1.z), sigmoidf_(v1.w)};
            u32x4 w; w.x = pk2(v0.x, v0.y); w.y = pk2(v0.z, v0.w); w.z = pk2(v1.x, v1.y); w.w = pk2(v1.z, v1.w);
            *(u32x4*)(o + (size_t)row * DFF + col) = w; }
    }
};
struct EpiMerge {
    static constexpr bool PERM = true, AFTER_DRAIN = false;
    const bf16* gate; bf16* mg;
    __device__ __forceinline__ void operator()(const f32x4 (&acc)[2][2][4][2], const Unit& un, int wr, int wc, int fr, int fq) const {
        const int rbase = un.pm * 256 + wr * 64 + fr, cw = un.pn * 256 + wc * 32 + 8 * fq, kb = un.kb;
#pragma unroll
        for (int ai = 0; ai < 2; ++ai) {
            u32x4 ga_[4][2], pa_[4][2];
#pragma unroll
            for (int m = 0; m < 4; ++m)
#pragma unroll
                for (int bj = 0; bj < 2; ++bj) { const int row = rbase + ai * 128 + m * 16, col = cw + bj * 128; ga_[m][bj] = *(const u32x4*)(gate + (size_t)row * DFF + kb * D + col);
                    pa_[m][bj] = kb > 0 ? *(const u32x4*)(mg + (size_t)row * D + col) : (u32x4){0u, 0u, 0u, 0u}; }
#pragma unroll
            for (int m = 0; m < 4; ++m)
#pragma unroll
                for (int bj = 0; bj < 2; ++bj) { const int row = rbase + ai * 128 + m * 16, col = cw + bj * 128; const f32x4 v0 = acc[ai][bj][m][0], v1 = acc[ai][bj][m][1]; const u32x4 gw = ga_[m][bj], pm = pa_[m][bj];
                    const f32x4 r0 = (f32x4){bflo(gw.x) * v0.x, bfhi(gw.x) * v0.y, bflo(gw.y) * v0.z, bfhi(gw.y) * v0.w} + (f32x4){bflo(pm.x), bfhi(pm.x), bflo(pm.y), bfhi(pm.y)};
                    const f32x4 r1 = (f32x4){bflo(gw.z) * v1.x, bfhi(gw.z) * v1.y, bflo(gw.w) * v1.z, bfhi(gw.w) * v1.w} + (f32x4){bflo(pm.z), bfhi(pm.z), bflo(pm.w), bfhi(pm.w)};
                    u32x4 w; w.x = pk2(r0.x, r0.y); w.y = pk2(r0.z, r0.w); w.z = pk2(r1.x, r1.y); w.w = pk2(r1.z, r1.w); *(u32x4*)(mg + (size_t)row * D + col) = w; } }
    }
};
struct EpiMergePart {
    static constexpr bool PERM = true, AFTER_DRAIN = false;
    const bf16* gate; float* part;
    __device__ __forceinline__ void operator()(const f32x4 (&acc)[2][2][4][2], const Unit& un, int wr, int wc, int fr, int fq) const {
        const int rbase = un.pm * 256 + wr * 64 + fr, cw = un.pn * 256 + wc * 32 + 8 * fq, kb = un.kb;
        float* pb = part + (size_t)kb * NCTX * D;
#pragma unroll
        for (int ai = 0; ai < 2; ++ai) {
            u32x4 ga_[4][2];
#pragma unroll
            for (int m = 0; m < 4; ++m)
#pragma unroll
                for (int bj = 0; bj < 2; ++bj) ga_[m][bj] = *(const u32x4*)(gate + (size_t)(rbase + ai * 128 + m * 16) * DFF + kb * D + cw + bj * 128);
#pragma unroll
            for (int m = 0; m < 4; ++m)
#pragma unroll
                for (int bj = 0; bj < 2; ++bj) { const int row = rbase + ai * 128 + m * 16 - NLAT, col = cw + bj * 128; const f32x4 v0 = acc[ai][bj][m][0], v1 = acc[ai][bj][m][1]; const u32x4 gw = ga_[m][bj];
                    float* dp = pb + (size_t)row * D + col;
                    *(f32x4*)dp = (f32x4){bflo(gw.x) * v0.x, bfhi(gw.x) * v0.y, bflo(gw.y) * v0.z, bfhi(gw.y) * v0.w};
                    *(f32x4*)(dp + 4) = (f32x4){bflo(gw.z) * v1.x, bfhi(gw.z) * v1.y, bflo(gw.w) * v1.z, bfhi(gw.w) * v1.w}; } }
    }
};
struct EpiResidN {
    static constexpr bool PERM = true, AFTER_DRAIN = false;
    const float *srcl, *srcc; float *dstl, *dstc; const float* modg; bf16* xg; const float* ng2; const float* sc2; float* ps;
    __device__ __forceinline__ void operator()(const f32x4 (&acc)[2][2][4][2], const Unit& un, int wr, int wc, int fr_, int fq_) const {
        const int ln_ = lane_fresh(), fr = ln_ & 15, fq = ln_ >> 4; (void)fr_; (void)fq_;
        const int rbase = un.pm * 256 + wr * 64 + fr, cw = un.pn * 256 + wc * 32 + 8 * fq;
        const bool lat = un.pm < (NLAT / 256);
        const int slot = lat ? (un.pm >> 5) : 4;
        const float* src = lat ? srcl : srcc; float* dst = lat ? dstl : dstc; const int radj = lat ? 0 : NLAT;
        const float* gp = modg + (size_t)slot * 12288; const float* sp2 = sc2 + (size_t)slot * 12288;
        float ssq[2][4];
#pragma unroll
        for (int ai = 0; ai < 2; ++ai)
#pragma unroll
            for (int m = 0; m < 4; ++m) ssq[ai][m] = 0.f;
        f32x4 g0[2], g1[2], y0s[2], y1s[2];
#pragma unroll
        for (int bj = 0; bj < 2; ++bj) { const int col = cw + bj * 128; g0[bj] = *(const f32x4*)(gp + col); g1[bj] = *(const f32x4*)(gp + col + 4);
            y0s[bj] = *(const f32x4*)(ng2 + col) * (*(const f32x4*)(sp2 + col) + 1.f); y1s[bj] = *(const f32x4*)(ng2 + col + 4) * (*(const f32x4*)(sp2 + col + 4) + 1.f); }
#pragma unroll
        for (int ai = 0; ai < 2; ++ai) {
            f32x4 xa[4][2][2];
#pragma unroll
            for (int m = 0; m < 4; ++m)
#pragma unroll
                for (int bj = 0; bj < 2; ++bj) { const float* sp = src + (size_t)(rbase + ai * 128 + m * 16 - radj) * D + cw + bj * 128; xa[m][bj][0] = *(const f32x4*)sp; xa[m][bj][1] = *(const f32x4*)(sp + 4); }
#pragma unroll
            for (int m = 0; m < 4; ++m)
#pragma unroll
                for (int bj = 0; bj < 2; ++bj) { const int row = rbase + ai * 128 + m * 16, col = cw + bj * 128; const f32x4 v0 = acc[ai][bj][m][0], v1 = acc[ai][bj][m][1];
                    float* dp = dst + (size_t)(row - radj) * D + col;
                    const f32x4 x0 = xa[m][bj][0] + g0[bj] * v0, x1 = xa[m][bj][1] + g1[bj] * v1;
                    *(f32x4*)dp = x0; *(f32x4*)(dp + 4) = x1;
                    ssq[ai][m] += (x0.x * x0.x + x0.y * x0.y) + (x0.z * x0.z + x0.w * x0.w) + (x1.x * x1.x + x1.y * x1.y) + (x1.z * x1.z + x1.w * x1.w);
                    const f32x4 y0 = x0 * y0s[bj], y1 = x1 * y1s[bj];
                    u32x4 w; w.x = pk2(y0.x, y0.y); w.y = pk2(y0.z, y0.w); w.z = pk2(y1.x, y1.y); w.w = pk2(y1.z, y1.w); *(u32x4*)(xg + (size_t)row * D + col) = w; } }
#pragma unroll
        for (int ai = 0; ai < 2; ++ai)
#pragma unroll
            for (int m = 0; m < 4; ++m) { float s = ssq[ai][m]; s += shx<16>(s); s += shx<32>(s);
                if (fq == 0) ps[((size_t)(rbase + ai * 128 + m * 16) * 8 + un.pn) * 4 + wc] = s; }
    }
};
struct EpiFfn1 {
    static constexpr bool PERM = true, AFTER_DRAIN = false;
    bf16* o; const float* rs; const float* shw;
    __device__ __forceinline__ void operator()(const f32x4 (&acc)[2][2][4][2], const Unit& un, int wr, int wc, int fr, int fq) const {
        const int rbase = un.pm * 256 + wr * 64 + fr, cw = un.pn * 256 + wc * 32 + 8 * fq;
        const int slot = un.pm < (NLAT / 256) ? (un.pm >> 5) : 4; const float* sw = shw + (size_t)slot * DFF;
        f32x4 s0[2], s1[2]; float rr[2][4];
#pragma unroll
        for (int bj = 0; bj < 2; ++bj) { s0[bj] = *(const f32x4*)(sw + cw + bj * 128); s1[bj] = *(const f32x4*)(sw + cw + bj * 128 + 4); }
#pragma unroll
        for (int ai = 0; ai < 2; ++ai)
#pragma unroll
            for (int m = 0; m < 4; ++m) rr[ai][m] = rs[rbase + ai * 128 + m * 16];
        EPI_LOOP { const int row = rbase + ai * 128 + m * 16, col = cw + bj * 128; const float r = rr[ai][m];
            f32x4 v0 = acc[ai][bj][m][0] * r + s0[bj], v1 = acc[ai][bj][m][1] * r + s1[bj];
            v0 = __builtin_elementwise_max(v0, (f32x4){0.f, 0.f, 0.f, 0.f}); v1 = __builtin_elementwise_max(v1, (f32x4){0.f, 0.f, 0.f, 0.f}); v0 = v0 * v0; v1 = v1 * v1;
            u32x4 w; w.x = pk2(v0.x, v0.y); w.y = pk2(v0.z, v0.w); w.z = pk2(v1.x, v1.y); w.w = pk2(v1.z, v1.w);
            *(u32x4*)(o + (size_t)row * DFF + col) = w; }
    }
};
struct EpiPart {
    static constexpr bool PERM = true, AFTER_DRAIN = false;
    float* part;
    __device__ __forceinline__ void operator()(const f32x4 (&acc)[2][2][4][2], const Unit& un, int wr, int wc, int fr, int fq) const {
        const int rbase = un.pm * 256 + wr * 64 + fr - NLAT, cw = un.pn * 256 + wc * 32 + 8 * fq;
        float* pb = part + (size_t)un.kb * NCTX * D;
        EPI_LOOP { const int row = rbase + ai * 128 + m * 16, col = cw + bj * 128; float* dp = pb + (size_t)row * D + col; *(f32x4*)dp = acc[ai][bj][m][0]; *(f32x4*)(dp + 4) = acc[ai][bj][m][1]; }
    }
};
struct EpiResid {
    static constexpr bool PERM = true, AFTER_DRAIN = false;
    const float *srcl, *srcc; float *dstl, *dstc; const float* modg;
    __device__ __forceinline__ void operator()(const f32x4 (&acc)[2][2][4][2], const Unit& un, int wr, int wc, int fr, int fq) const {
        const int rbase = un.pm * 256 + wr * 64 + fr, cw = un.pn * 256 + wc * 32 + 8 * fq;
        const bool lat = un.pm < (NLAT / 256);
        const int slot = lat ? (un.pm >> 5) : 4;
        const float* src = lat ? srcl : srcc; float* dst = lat ? dstl : dstc; const int radj = lat ? 0 : NLAT;
        const float* gp = modg + (size_t)slot * 12288;
        f32x4 g0[2], g1[2];
#pragma unroll
        for (int bj = 0; bj < 2; ++bj) { g0[bj] = *(const f32x4*)(gp + cw + bj * 128); g1[bj] = *(const f32x4*)(gp + cw + bj * 128 + 4); }
#pragma unroll
        for (int ai = 0; ai < 2; ++ai) {
            f32x4 xa[4][2][2];
#pragma unroll
            for (int m = 0; m < 4; ++m)
#pragma unroll
                for (int bj = 0; bj < 2; ++bj) { const float* sp = src + (size_t)(rbase + ai * 128 + m * 16 - radj) * D + cw + bj * 128; xa[m][bj][0] = *(const f32x4*)sp; xa[m][bj][1] = *(const f32x4*)(sp + 4); }
#pragma unroll
            for (int m = 0; m < 4; ++m)
#pragma unroll
                for (int bj = 0; bj < 2; ++bj) { float* dp = dst + (size_t)(rbase + ai * 128 + m * 16 - radj) * D + cw + bj * 128;
                    *(f32x4*)dp = xa[m][bj][0] + g0[bj] * acc[ai][bj][m][0]; *(f32x4*)(dp + 4) = xa[m][bj][1] + g1[bj] * acc[ai][bj][m][1]; } }
    }
};

#define MFMA16(a, b, c) __builtin_amdgcn_mfma_f32_16x16x32_bf16((a), (b), (c), 0, 0, 0)
#define WAVE_LDS_SYNC() asm volatile("s_waitcnt lgkmcnt(0)" ::: "memory")
__device__ __forceinline__ void gmlp_unit(const PA& a, int l, int ch, LAS unsigned char* lds, int tid) {
    const int lane = tid & 63, w = tid >> 6, fr = lane & 15, kg = lane >> 4;
    LAS f32x2* st = (LAS f32x2*)lds; LAS bf16* vt = (LAS bf16*)(lds + 1024); LAS bf16* wsl = (LAS bf16*)(lds + 35840);
    const bf16* GA = (const bf16*)(a.ws() + WS_GA); bf16* BRA = (bf16*)(a.ws() + WS_BR); const bf16* GWS = (const bf16*)(a.ws() + WS_GWS);
    const float* lng = a.in(I_GLNG) + l * DB; const float* lnb = a.in(I_GLNB) + l * DB; const float* bs = a.in(I_GBS) + l * 512;
    const int row0 = ch * 128;
#pragma unroll 1
    for (int rr0 = 0; rr0 < 16; rr0 += 4) {
        float f[4][8], mean[4], rstd[4];
#pragma unroll
        for (int k = 0; k < 4; ++k) { const u32x4 x = *(const u32x4*)(GA + (size_t)(row0 + w * 16 + rr0 + k) * 1024 + 512 + lane * 8);
            f[k][0] = bflo(x.x); f[k][1] = bfhi(x.x); f[k][2] = bflo(x.y); f[k][3] = bfhi(x.y); f[k][4] = bflo(x.z); f[k][5] = bfhi(x.z); f[k][6] = bflo(x.w); f[k][7] = bfhi(x.w); }
#pragma unroll
        for (int k = 0; k < 4; ++k) { float s = 0.f;
#pragma unroll
            for (int e = 0; e < 8; ++e) s += f[k][e];
            mean[k] = wave_sum(s) * (1.f / 512.f); }
#pragma unroll
        for (int k = 0; k < 4; ++k) { float s2 = 0.f;
#pragma unroll
            for (int e = 0; e < 8; ++e) { const float d = f[k][e] - mean[k]; s2 += d * d; }
            rstd[k] = 1.f / sqrtf(wave_sum(s2) * (1.f / 512.f) + EPS); }
        if (lane == 0) {
#pragma unroll
            for (int k = 0; k < 4; ++k) st[w * 16 + rr0 + k] = (f32x2){mean[k], rstd[k]}; } }
    __syncthreads();
    for (int g = 0; g < 4; ++g) {
        { const int q = tid >> 2, cs = (tid & 3) * 32; const f32x2 ms = st[q];
#pragma unroll
            for (int k4 = 0; k4 < 4; ++k4) { const int c0 = cs + k4 * 8; const u32x4 x = *(const u32x4*)(GA + (size_t)(row0 + q) * 1024 + 512 + g * 128 + c0);
                const float f[8] = {bflo(x.x), bfhi(x.x), bflo(x.y), bfhi(x.y), bflo(x.z), bfhi(x.z), bflo(x.w), bfhi(x.w)};
                const f32x4 g0 = *(const f32x4*)(lng + g * 128 + c0), g1 = *(const f32x4*)(lng + g * 128 + c0 + 4), b0 = *(const f32x4*)(lnb + g * 128 + c0), b1 = *(const f32x4*)(lnb + g * 128 + c0 + 4);
                const float gg[8] = {g0.x, g0.y, g0.z, g0.w, g1.x, g1.y, g1.z, g1.w}, bb[8] = {b0.x, b0.y, b0.z, b0.w, b1.x, b1.y, b1.z, b1.w};
#pragma unroll
                for (int e = 0; e < 8; ++e) vt[(c0 + e) * 136 + q] = (bf16)f2bf((f[e] - ms.x) * ms.y * gg[e] + bb[e]); }
#pragma unroll
            for (int i = 0; i < 4; ++i) { const int c = tid + 512 * i, p = c >> 4, q8 = (c & 15) * 8;
                *(LAS u32x4*)(wsl + p * 136 + q8) = *(const u32x4*)(GWS + (size_t)(g * 128 + p) * 128 + q8); } }
        __syncthreads();
        f32x4 acc[8];
#pragma unroll
        for (int pt = 0; pt < 8; ++pt) acc[pt] = (f32x4){0.f, 0.f, 0.f, 0.f};
#pragma unroll
        for (int ks = 0; ks < 4; ++ks) { const bf16x8 afr = *(const LAS bf16x8*)(vt + (16 * w + fr) * 136 + ks * 32 + kg * 8);
#pragma unroll
            for (int pt = 0; pt < 8; ++pt) { const bf16x8 bfr = *(const LAS bf16x8*)(wsl + (pt * 16 + fr) * 136 + ks * 32 + kg * 8); acc[pt] = MFMA16(afr, bfr, acc[pt]); } }
        const int c0 = g * 128 + 16 * w + kg * 4;
        u32x2 uxs[8]; float bsps[8];
#pragma unroll
        for (int pt = 0; pt < 8; ++pt) { const int p = pt * 16 + fr; uxs[pt] = *(const u32x2*)(GA + (size_t)(row0 + p) * 1024 + c0); bsps[pt] = bs[g * 128 + p]; }
#pragma unroll
        for (int pt = 0; pt < 8; ++pt) { const int p = pt * 16 + fr; const u32x2 ux = uxs[pt]; const float bsp = bsps[pt];
            *(u32x2*)(BRA + (size_t)(row0 + p) * 512 + c0) = (u32x2){pk2(bflo(ux.x) * (acc[pt].x + bsp), bfhi(ux.x) * (acc[pt].y + bsp)), pk2(bflo(ux.y) * (acc[pt].z + bsp), bfhi(ux.y) * (acc[pt].w + bsp))}; }
        __syncthreads();
    }
}
__device__ __forceinline__ void conv_unit(const PA& a, int l, int un, LAS unsigned char* lds, int tid) {
    LAS float* ybuf = (LAS float*)lds;
    const bf16* YB = (const bf16*)(a.ws() + WS_YB); bf16* BRB = (bf16*)(a.ws() + WS_BR) + (size_t)NTOK * 512;
    const int lane = tid & 63, w = tid >> 6;
    const int t0 = un * 32; int s0, s1;
    if (t0 < NLAT) { s0 = t0 & ~(SEQ - 1); s1 = s0 + SEQ; } else { s0 = NLAT + ((t0 - NLAT) & ~(CTXL - 1)); s1 = s0 + CTXL; }
    const int cp = tid & 255, half = tid >> 8, rb = t0 + half * 16 - 15;
    const float* cw = a.in(I_CW) + (size_t)l * 31 * 512 + 2 * cp;
    f32x2 wt[31];
#pragma unroll
    for (int i = 0; i < 31; ++i) wt[i] = *(const f32x2*)(cw + i * 512);
    f32x2 o[16];
#pragma unroll
    for (int j = 0; j < 16; ++j) o[j] = (f32x2){0.f, 0.f};
    unsigned xin[46];
#pragma unroll
    for (int r = 0; r < 46; ++r) { const int row = rb + r, rc = row < s0 ? s0 : (row >= s1 ? s1 - 1 : row); xin[r] = *(const unsigned*)(YB + (size_t)rc * 512 + 2 * cp); }
#pragma unroll
    for (int r = 0; r < 46; ++r) { const int row = rb + r; const unsigned x = (row >= s0 && row < s1) ? xin[r] : 0u; const f32x2 v = (f32x2){bflo(x), bfhi(x)};
#pragma unroll
        for (int j = 0; j < 16; ++j) if (r - j >= 0 && r - j <= 30) o[j] += wt[r - j] * v; }
    const f32x2 cb = *(const f32x2*)(a.in(I_CB) + l * 512 + 2 * cp);
#pragma unroll
    for (int j = 0; j < 16; ++j) *(LAS f32x2*)(ybuf + (half * 16 + j) * 512 + 2 * cp) = o[j] + cb;
    __syncthreads();
    const float* lg = a.in(I_CLNG) + l * 512 + lane * 8; const float* lb = a.in(I_CLNB) + l * 512 + lane * 8;
    { float f[4][8], mean[4], rstd[4];
#pragma unroll
        for (int tt = 0; tt < 4; ++tt) { const int tok = 4 * w + tt; const f32x4 p0 = *(const LAS f32x4*)(ybuf + tok * 512 + lane * 8), p1 = *(const LAS f32x4*)(ybuf + tok * 512 + lane * 8 + 4);
            f[tt][0] = p0.x; f[tt][1] = p0.y; f[tt][2] = p0.z; f[tt][3] = p0.w; f[tt][4] = p1.x; f[tt][5] = p1.y; f[tt][6] = p1.z; f[tt][7] = p1.w; }
#pragma unroll
        for (int tt = 0; tt < 4; ++tt) { float s = 0.f;
#pragma unroll
            for (int e = 0; e < 8; ++e) s += f[tt][e];
            mean[tt] = wave_sum(s) * (1.f / 512.f); }
#pragma unroll
        for (int tt = 0; tt < 4; ++tt) { float s2 = 0.f;
#pragma unroll
            for (int e = 0; e < 8; ++e) { f[tt][e] -= mean[tt]; s2 += f[tt][e] * f[tt][e]; }
            rstd[tt] = 1.f / sqrtf(wave_sum(s2) * (1.f / 512.f) + EPS); }
        float lgv[8], lbv[8];
#pragma unroll
        for (int e = 0; e < 8; ++e) { lgv[e] = lg[e]; lbv[e] = lb[e]; }
#pragma unroll
        for (int tt = 0; tt < 4; ++tt) { float y[8];
#pragma unroll
            for (int e = 0; e < 8; ++e) y[e] = siluf_(f[tt][e] * rstd[tt] * lgv[e] + lbv[e]);
            u32x4 wv; wv.x = pk2(y[0], y[1]); wv.y = pk2(y[2], y[3]); wv.z = pk2(y[4], y[5]); wv.w = pk2(y[6], y[7]);
            *(u32x4*)(BRB + (size_t)(t0 + 4 * w + tt) * 512 + lane * 8) = wv; } }
    __syncthreads();
}

__device__ __forceinline__ void attn_unit(const PA& a, int l, int unit, LAS unsigned char* lds, int tid) {
    const int lane = tid & 63, w = tid >> 6, fr = lane & 15, kg = lane >> 4;
    LAS bf16* Kt = (LAS bf16*)lds; LAS bf16* Vt = (LAS bf16*)(lds + 18432); LAS bf16* P = (LAS bf16*)(lds + 35840 + w * 8704);
    const bf16* Q = (const bf16*)(a.ws() + WS_Q); const bf16* K = (const bf16*)(a.ws() + WS_K); const bf16* VT = (const bf16*)(a.ws() + WS_VT); const bf16* VCT = (const bf16*)(a.ws() + WS_VCT);
    bf16* BRC = (bf16*)(a.ws() + WS_BR) + (size_t)2 * NTOK * 512;
    int b, qblk, hkv, hp, qrow0; bool isctx;
    if (unit < 1024) { b = unit >> 8; qblk = (unit >> 2) & 63; hkv = (unit >> 1) & 1; hp = unit & 1; isctx = false; qrow0 = b * SEQ + qblk * 128; }
    else { const int uu = unit - 1024; b = uu >> 3; qblk = (uu >> 2) & 1; hkv = (uu >> 1) & 1; hp = uu & 1; isctx = true; qrow0 = NLAT + b * CTXL + qblk * 128; }
    const int hq0 = hkv * 4 + hp * 2;
    const bf16* qp = Q + (size_t)(qrow0 + 16 * w + fr) * 512 + hq0 * 64 + kg * 8;
    bf16x8 qf[2][2]; float mrow[2][4], lp[2][4]; f32x4 o[2][4];
#pragma unroll
    for (int h = 0; h < 2; ++h) { qf[h][0] = *(const bf16x8*)(qp + h * 64); qf[h][1] = *(const bf16x8*)(qp + h * 64 + 32); const float sinkv = a.in(I_SINK)[l * 8 + hq0 + h] * LOG2E;
#pragma unroll
        for (int j = 0; j < 4; ++j) { mrow[h][j] = sinkv; lp[h][j] = (fr == 0) ? 1.f : 0.f; o[h][j] = (f32x4){0.f, 0.f, 0.f, 0.f}; } }
    const int tfirst = isctx ? 3 : (qblk > 0 ? 0 : 1);
    u32x4 kq[2], vq[2];
#define ATT_TILE_PTRS(t, kbase, vbase, vp) do { if ((t) < 3) { const int kb_ = qblk + (t) - 1; kbase = K + (size_t)(b * SEQ + kb_ * 128) * 128 + hkv * 64; vbase = VT + (size_t)((b * 2 + hkv) * 64) * SEQ + kb_ * 128; vp = SEQ; } \
        else { kbase = K + (size_t)(NLAT + b * CTXL + ((t) - 3) * 128) * 128 + hkv * 64; vbase = VCT + (size_t)((b * 2 + hkv) * 64) * CTXL + ((t) - 3) * 128; vp = CTXL; } } while (0)
#define ATT_TILE_LOAD(t) do { const bf16* kb0_; const bf16* vb0_; int vp_; ATT_TILE_PTRS(t, kb0_, vb0_, vp_); \
        _Pragma("unroll") for (int i_ = 0; i_ < 2; ++i_) { const int c_ = tid + 512 * i_; kq[i_] = *(const u32x4*)(kb0_ + (size_t)(c_ >> 3) * 128 + (c_ & 7) * 8); vq[i_] = *(const u32x4*)(vb0_ + (size_t)(c_ >> 4) * vp_ + (c_ & 15) * 8); } } while (0)
    ATT_TILE_LOAD(tfirst);
    for (int t = tfirst; t < 5; ++t) {
        if (t == 2 && !isctx && qblk == 63) continue;
        __syncthreads();
#pragma unroll
        for (int i = 0; i < 2; ++i) { const int c = tid + 512 * i; *(LAS u32x4*)(Kt + (c >> 3) * 72 + (c & 7) * 8) = kq[i]; *(LAS u32x4*)(Vt + (c >> 4) * 136 + (c & 15) * 8) = vq[i]; }
        __syncthreads();
        { int tn = t + 1; if (tn == 2 && !isctx && qblk == 63) tn = 3; if (tn < 5) ATT_TILE_LOAD(tn); }
        {
            f32x4 s[2][8];
#pragma unroll
            for (int nt = 0; nt < 8; ++nt) { const LAS bf16* kp = Kt + (nt * 16 + fr) * 72 + kg * 8;
                const bf16x8 k0 = *(const LAS bf16x8*)kp, k1 = *(const LAS bf16x8*)(kp + 32);
#pragma unroll
                for (int h = 0; h < 2; ++h) { s[h][nt] = MFMA16(qf[h][0], k0, ((f32x4){0.f, 0.f, 0.f, 0.f})); s[h][nt] = MFMA16(qf[h][1], k1, s[h][nt]); } }
#pragma unroll
            for (int h = 0; h < 2; ++h) {
                LAS bf16* Ph = P + h * 2176;
                if (t == 0 || t == 2) {
#pragma unroll
                    for (int nt = 0; nt < 8; ++nt)
#pragma unroll
                        for (int j = 0; j < 4; ++j) { const int qi = 16 * w + kg * 4 + j, ki = nt * 16 + fr; const bool ok = (t == 0) ? (qi <= ki) : (ki <= qi); if (!ok) s[h][nt][j] = -1e30f; } }
                float alpha[4];
#pragma unroll
                for (int j = 0; j < 4; ++j) { float mx = s[h][0][j];
#pragma unroll
                    for (int nt = 1; nt < 8; ++nt) mx = fmaxf(mx, s[h][nt][j]);
                    mx = fmaxf(mx, shx<1>(mx)); mx = fmaxf(mx, shx<2>(mx)); mx = fmaxf(mx, shx<4>(mx)); mx = fmaxf(mx, shx<8>(mx));
                    const float mn = fmaxf(mrow[h][j], mx); alpha[j] = __builtin_amdgcn_exp2f(mrow[h][j] - mn); mrow[h][j] = mn; lp[h][j] *= alpha[j]; }
#pragma unroll
                for (int nt = 0; nt < 8; ++nt)
#pragma unroll
                    for (int j = 0; j < 4; ++j) { const float p = __builtin_amdgcn_exp2f(s[h][nt][j] - mrow[h][j]); lp[h][j] += p; Ph[(kg * 4 + j) * 136 + nt * 16 + fr] = (bf16)f2bf(p); }
#pragma unroll
                for (int dt = 0; dt < 4; ++dt) { o[h][dt][0] *= alpha[0]; o[h][dt][1] *= alpha[1]; o[h][dt][2] *= alpha[2]; o[h][dt][3] *= alpha[3]; }
            }
            WAVE_LDS_SYNC();
#pragma unroll
            for (int ks = 0; ks < 4; ++ks) { const bf16x8 pa0 = *(const LAS bf16x8*)(P + fr * 136 + ks * 32 + kg * 8), pa1 = *(const LAS bf16x8*)(P + 2176 + fr * 136 + ks * 32 + kg * 8);
#pragma unroll
                for (int dt = 0; dt < 4; ++dt) { const bf16x8 vb = *(const LAS bf16x8*)(Vt + (dt * 16 + fr) * 136 + ks * 32 + kg * 8); o[0][dt] = MFMA16(pa0, vb, o[0][dt]); o[1][dt] = MFMA16(pa1, vb, o[1][dt]); } }
            WAVE_LDS_SYNC();
        }
    }
#undef ATT_TILE_LOAD
#undef ATT_TILE_PTRS
#pragma unroll
    for (int h = 0; h < 2; ++h)
#pragma unroll
        for (int j = 0; j < 4; ++j) { float s = lp[h][j]; s += shx<1>(s); s += shx<2>(s); s += shx<4>(s); s += shx<8>(s); const float inv = 1.f / s;
#pragma unroll
            for (int dt = 0; dt < 4; ++dt) BRC[(size_t)(qrow0 + 16 * w + kg * 4 + j) * 512 + (hq0 + h) * 64 + dt * 16 + fr] = (bf16)f2bf(o[h][dt][j] * inv); }
}

__device__ __forceinline__ void s5disc_thread(const PA& a, int idx) {
    const int p = idx & 63, g = (idx >> 6) & 31, dir = (idx >> 11) & 1, l = idx >> 12;
    const double are = a.in(I_ARE)[idx], aim = a.in(I_AIM)[idx], dt = exp((double)a.in(I_LSTEP)[(l * 2 + dir) * 32 + g]);
    const double er = exp(are * dt), lrd = er * cos(aim * dt), lid = er * sin(aim * dt);
    const double den = are * are + aim * aim, cr = ((lrd - 1.0) * are + lid * aim) / den, ci = (lid * are - (lrd - 1.0) * aim) / den;
    float* dsc = (float*)(a.ws() + WS_S5DISC) + (size_t)idx * 34;
    dsc[0] = (float)lrd; dsc[1] = (float)lid;
    const float* bre = a.in(I_BRE) + (size_t)((l * 32 + g) * 64 + p) * 16; const float* bim = a.in(I_BIM) + (size_t)((l * 32 + g) * 64 + p) * 16;
    for (int c = 0; c < 16; ++c) { const double br = bre[c], bi = bim[c]; dsc[2 + c] = (float)(cr * br - ci * bi); dsc[18 + c] = (float)(cr * bi + ci * br); }
}
constexpr int NCHUNK = NTOK / 64;
constexpr size_t S5T_KT = 0, S5T_AS = 65536, S5T_AC = 65536 + 524288, S5T_BYTES = 65536 + 2 * 524288;
constexpr size_t WS_S5T = WS_YF;
constexpr size_t WS_SLOC = WS_S5T + 36 * MiB;
constexpr size_t WS_SIN = WS_SLOC + 18 * MiB;
constexpr size_t WS_LT = WS_SIN + 10 * MiB;
static_assert(WS_LT + 65536 <= WS_END, "S5 scratch inside the map");

__device__ __forceinline__ void s5_tables_unit(const PA& a, int l, int g, LAS unsigned char* lds, int tid) {
    LAS f32x2* pw = (LAS f32x2*)lds; LAS f32x2* Bb = (LAS f32x2*)(lds + 66560); LAS f32x2* Cc = (LAS f32x2*)(lds + 82944); LAS float* K0 = (LAS float*)(lds + 99328);
    unsigned char* tb = a.ws() + WS_S5T + (size_t)g * S5T_BYTES;
    bf16* KT = (bf16*)(tb + S5T_KT); bf16* AS = (bf16*)(tb + S5T_AS); bf16* AC = (bf16*)(tb + S5T_AC);
    if (tid < 128) {
        const int dir = tid >> 6, p = tid & 63, pi = ((l * 2 + dir) * 32 + g) * 64 + p;
        const float* dsc = (const float*)(a.ws() + WS_S5DISC) + (size_t)pi * 34;
        const double lr = dsc[0], li = dsc[1];
        float one_ = 1.f; asm volatile("" : "+v"(one_));
        double pr = (double)one_, pim = 0.0;
        for (int d = 0; d <= 64; ++d) { pw[(dir * 65 + d) * 64 + p] = (f32x2){(float)pr, (float)pim}; const double nr = pr * lr - pim * li, ni = pr * li + pim * lr; pr = nr; pim = ni; }
        ((f32x2*)(a.ws() + WS_LT))[(g * 2 + dir) * 64 + p] = pw[(dir * 65 + 64) * 64 + p];
        for (int c = 0; c < 16; ++c) Bb[(dir * 64 + p) * 16 + c] = (f32x2){dsc[2 + c], dsc[18 + c]};
    } else {
        for (int i = tid - 128; i < 2048; i += 384) { const int dir = i >> 10, o = (i >> 6) & 15, p = i & 63; const size_t ix = (size_t)(((l * 2 + dir) * 32 + g) * 16 + o) * 64 + p;
            Cc[i] = (f32x2){a.in(I_CRE)[ix], a.in(I_CIM)[ix]}; }
    }
    __syncthreads();
    {
        const int dir = tid >> 8, oc = tid & 255, o = oc >> 4, c = oc & 15;
        float K[64];
#pragma unroll
        for (int d = 0; d < 64; ++d) K[d] = 0.f;
        for (int p = 0; p < 64; ++p) { const f32x2 cc = Cc[(dir * 16 + o) * 64 + p], bb = Bb[(dir * 64 + p) * 16 + c]; const float cbr = cc.x * bb.x - cc.y * bb.y, cbi = cc.x * bb.y + cc.y * bb.x;
#pragma unroll
            for (int d = 0; d < 64; ++d) { const f32x2 w = pw[(dir * 65 + d) * 64 + p]; K[d] += cbr * w.x - cbi * w.y; } }
        K0[dir * 256 + oc] = K[0];
#pragma unroll
        for (int d = 1; d < 64; ++d) KT[(size_t)(dir == 0 ? 63 + d : 63 - d) * 256 + oc] = (bf16)f2bf(K[d]);
        __syncthreads();
        if (dir == 0) KT[(size_t)63 * 256 + oc] = (bf16)f2bf(K0[oc] + K0[256 + oc] + (o == c ? a.in(I_S5D)[l * 512 + g * 16 + o] : 0.f));
    }
    for (int it = tid; it < 32768; it += 512) {
        const int ch = it & 1, tau = (it >> 1) & 63, m = (it >> 7) & 127, dir = it >> 14, ri = m >> 6, p = m & 63, e = dir == 0 ? 63 - tau : tau;
        const f32x2 w = pw[(dir * 65 + e) * 64 + p]; float v[8];
#pragma unroll
        for (int j = 0; j < 8; ++j) { const f32x2 bb = Bb[(dir * 64 + p) * 16 + ch * 8 + j]; v[j] = ri ? (w.x * bb.y + w.y * bb.x) : (w.x * bb.x - w.y * bb.y); }
        u32x4 o4; o4.x = pk2(v[0], v[1]); o4.y = pk2(v[2], v[3]); o4.z = pk2(v[4], v[5]); o4.w = pk2(v[6], v[7]);
        *(u32x4*)(AS + (size_t)(dir * 128 + m) * 1024 + tau * 16 + ch * 8) = o4; }
    for (int it = tid; it < 32768; it += 512) {
        const int p8 = it & 7, ri = (it >> 3) & 1, o = (it >> 4) & 15, tau = (it >> 8) & 63, dir = it >> 14, e = dir == 0 ? tau + 1 : 64 - tau; float v[8];
#pragma unroll
        for (int j = 0; j < 8; ++j) { const int p = p8 * 8 + j; const f32x2 cc = Cc[(dir * 16 + o) * 64 + p], w = pw[(dir * 65 + e) * 64 + p]; v[j] = ri ? -(cc.x * w.y + cc.y * w.x) : (cc.x * w.x - cc.y * w.y); }
        u32x4 o4; o4.x = pk2(v[0], v[1]); o4.y = pk2(v[2], v[3]); o4.z = pk2(v[4], v[5]); o4.w = pk2(v[6], v[7]);
        *(u32x4*)(AC + (size_t)(dir * 1024 + tau * 16 + o) * 128 + ri * 64 + p8 * 8) = o4; }
    __syncthreads();
}
constexpr int S5U_PITCH = 2064;
__device__ __forceinline__ void s5_stage_u(const PA& a, int g, int nb, LAS unsigned char* lds, int tid) {
    const unsigned char* src = a.ws() + WS_U + ((size_t)g * NTOK + (size_t)nb * 48 * 64) * 32;
    __syncthreads();
    u32x4 tmp[12];
#pragma unroll
    for (int j = 0; j < 12; ++j) { const unsigned i = (unsigned)tid + 512u * j; tmp[j] = *(const u32x4*)(src + i * 16u); }
#pragma unroll
    for (int j = 0; j < 12; ++j) { const unsigned i = (unsigned)tid + 512u * j; *(LAS u32x4*)(lds + (i >> 7) * S5U_PITCH + (i & 127u) * 16u) = tmp[j]; }
    __syncthreads();
}
__device__ __forceinline__ void s5_state_unit(const PA& a, int unit, LAS unsigned char* lds, int tid) {
    const int lane = tid & 63, w = tid >> 6, fr = lane & 15, kg = lane >> 4;
    const int nb = unit % 11, g = unit / 11;
    s5_stage_u(a, g, nb, lds, tid);
    const bf16* AS = (const bf16*)(a.ws() + WS_S5T + (size_t)g * S5T_BYTES + S5T_AS) + (size_t)(16 * w + fr) * 1024 + kg * 8;
    const LAS unsigned char* ub = lds + fr * S5U_PITCH + (kg >> 1) * 32 + (kg & 1) * 16;
    f32x4 acc[2][3];
#pragma unroll
    for (int d = 0; d < 2; ++d)
#pragma unroll
        for (int nt = 0; nt < 3; ++nt) acc[d][nt] = (f32x4){0.f, 0.f, 0.f, 0.f};
#pragma unroll 4
    for (int ks = 0; ks < 32; ++ks) { const bf16x8 af0 = *(const bf16x8*)(AS + ks * 32), af1 = *(const bf16x8*)(AS + (size_t)128 * 1024 + ks * 32);
#pragma unroll
        for (int nt = 0; nt < 3; ++nt) { const bf16x8 bfr = *(const LAS bf16x8*)(ub + nt * 16 * S5U_PITCH + ks * 64); acc[0][nt] = MFMA16(af0, bfr, acc[0][nt]); acc[1][nt] = MFMA16(af1, bfr, acc[1][nt]); } }
    float* SL = (float*)(a.ws() + WS_SLOC);
#pragma unroll
    for (int d = 0; d < 2; ++d)
#pragma unroll
        for (int nt = 0; nt < 3; ++nt) { const int chunk = nb * 48 + nt * 16 + fr; *(f32x4*)(SL + (size_t)((chunk * 32 + g) * 2 + d) * 128 + 16 * w + kg * 4) = acc[d][nt]; }
}
#define S5C_CHUNK(i) ((i) < 4 ? 512 + b * 4 + (dir == 0 ? (i) : 3 - (i)) : b * 128 + (dir == 0 ? (i) - 4 : 131 - (i)))
#define S5C_LOAD(LR, LI, OFF, I0) _Pragma("unroll") for (int k = 0; k < 12; ++k) { OFF[k] = (size_t)((S5C_CHUNK((I0) + k) * 32 + g) * 2 + dir) * 128; LR[k] = SL[OFF[k] + p]; LI[k] = SL[OFF[k] + 64 + p]; }
#define S5C_FOLD(LR, LI, OFF) _Pragma("unroll") for (int k = 0; k < 12; ++k) { SI[OFF[k] + p] = (bf16)f2bf(sr); SI[OFF[k] + 64 + p] = (bf16)f2bf(si); \
        const float nr = lt.x * sr - lt.y * si + LR[k], ni = lt.x * si + lt.y * sr + LI[k]; sr = nr; si = ni; }
__device__ __forceinline__ void s5_carry_seq(const PA& a, int seq, int lane) {
    const int dir = seq & 1, g = (seq >> 1) & 31, b = seq >> 6, p = lane;
    const f32x2 lt = ((const f32x2*)(a.ws() + WS_LT))[(g * 2 + dir) * 64 + p];
    const float* SL = (const float*)(a.ws() + WS_SLOC); bf16* SI = (bf16*)(a.ws() + WS_SIN);
    float sr = 0.f, si = 0.f;
    float lrA[12], liA[12], lrB[12], liB[12]; size_t offA[12], offB[12];
    S5C_LOAD(lrA, liA, offA, 0)
#pragma unroll 1
    for (int i0 = 0; i0 < 120; i0 += 24) {
        S5C_LOAD(lrB, liB, offB, i0 + 12)
        S5C_FOLD(lrA, liA, offA)
        S5C_LOAD(lrA, liA, offA, i0 + 24)
        S5C_FOLD(lrB, liB, offB)
    }
    S5C_FOLD(lrA, liA, offA)
}
#undef S5C_CHUNK
#undef S5C_LOAD
#undef S5C_FOLD
__device__ __forceinline__ void s5_out_unit(const PA& a, int unit, LAS unsigned char* lds, int tid_) {
    int tid = tid_; asm volatile("" : "+v"(tid));
    const int lane = tid & 63, w = tid >> 6, fr = lane & 15, kg = lane >> 4;
    const int nb = unit % 11, g = unit / 11;
    s5_stage_u(a, g, nb, lds, tid);
    const unsigned char* tb = a.ws() + WS_S5T + (size_t)g * S5T_BYTES;
    const bf16* KT = (const bf16*)(tb + S5T_KT) + (size_t)(8 * w + 63 - (kg >> 1)) * 256 + fr * 16 + (kg & 1) * 8;
    const bf16* AC = (const bf16*)(tb + S5T_AC) + (size_t)(8 * w * 16 + fr) * 128 + kg * 8;
    const LAS unsigned char* ub = lds + fr * S5U_PITCH + (kg >> 1) * 32 + (kg & 1) * 16;
    const bf16* SI = (const bf16*)(a.ws() + WS_SIN) + (size_t)(((nb * 48 + fr) * 32 + g) * 2) * 128 + kg * 8;
    f32x4 acc[8][3];
#pragma unroll
    for (int i = 0; i < 8; ++i)
#pragma unroll
        for (int nt = 0; nt < 3; ++nt) acc[i][nt] = (f32x4){0.f, 0.f, 0.f, 0.f};
    bf16x8 W[8];
#pragma unroll
    for (int j = 0; j < 8; ++j) W[j] = *(const bf16x8*)(KT + j * 256);
#pragma unroll 1
    for (int kk = 0; kk < 8; ++kk) {
#pragma unroll
        for (int u = 0; u < 4; ++u) { const int ks = 4 * kk + u;
            if (ks > 0) { W[(16 - 2 * u) & 7] = *(const bf16x8*)(KT + (-2 * ks) * 256); W[(17 - 2 * u) & 7] = *(const bf16x8*)(KT + (-2 * ks + 1) * 256); }
            bf16x8 bfr[3];
#pragma unroll
            for (int nt = 0; nt < 3; ++nt) bfr[nt] = *(const LAS bf16x8*)(ub + nt * 16 * S5U_PITCH + ks * 64);
#pragma unroll
            for (int i = 0; i < 8; ++i)
#pragma unroll
                for (int nt = 0; nt < 3; ++nt) acc[i][nt] = MFMA16(W[(i + 16 - 2 * u) & 7], bfr[nt], acc[i][nt]); } }
#pragma unroll
    for (int dir = 0; dir < 2; ++dir)
#pragma unroll
        for (int ks = 0; ks < 4; ++ks) { bf16x8 bfr[3];
#pragma unroll
            for (int nt = 0; nt < 3; ++nt) bfr[nt] = *(const bf16x8*)(SI + (size_t)(nt * 16 * 32 * 2 + dir) * 128 + ks * 32);
#pragma unroll
            for (int i = 0; i < 8; ++i) { const bf16x8 af = *(const bf16x8*)(AC + (size_t)(dir * 1024 + i * 16) * 128 + ks * 32);
#pragma unroll
                for (int nt = 0; nt < 3; ++nt) acc[i][nt] = MFMA16(af, bfr[nt], acc[i][nt]); } }
    bf16* YG = (bf16*)(a.ws() + WS_YG);
#pragma unroll
    for (int i = 0; i < 8; ++i)
#pragma unroll
        for (int nt = 0; nt < 3; ++nt) { const int chunk = nb * 48 + nt * 16 + fr; const size_t row = (size_t)chunk * 64 + 8 * w + i; const f32x4 v = acc[i][nt];
            *(u32x2*)(YG + row * 512 + g * 16 + kg * 4) = (u32x2){pk2(gelu_tanh(v.x), gelu_tanh(v.y)), pk2(gelu_tanh(v.z), gelu_tanh(v.w))}; }
}

constexpr int RING_BYTES = 131072, MISC_OFF = RING_BYTES, LDS_BYTES = RING_BYTES + 1024;
#ifndef THIN_GRID
#define THIN_GRID 192
#endif
__device__ unsigned g_bar[64];
__device__ __forceinline__ void grid_barrier_counter(unsigned G) {
    asm volatile("s_waitcnt vmcnt(0)" ::: "memory");
    __syncthreads();
    if (threadIdx.x == 0) {
        __builtin_amdgcn_fence(__ATOMIC_RELEASE, "agent");
        asm volatile("s_waitcnt vmcnt(0)" ::: "memory");
        unsigned* ctr = &g_bar[0]; asm volatile("" : "+s"(ctr));
        const unsigned old = __hip_atomic_fetch_add(ctr, 1u, __ATOMIC_RELAXED, __HIP_MEMORY_SCOPE_AGENT);
        const unsigned target = (old / G + 1u) * G;
        unsigned sp = 0u;
        while ((int)(__hip_atomic_load(ctr, __ATOMIC_RELAXED, __HIP_MEMORY_SCOPE_AGENT) - target) < 0) { __builtin_amdgcn_s_sleep(2); if (++sp > (1u << 24)) break; }
        __builtin_amdgcn_fence(__ATOMIC_ACQUIRE, "agent");
        asm volatile("s_waitcnt vmcnt(0)" ::: "memory");
    }
    __syncthreads();
}
#ifdef USE_XCD_BAR
constexpr int CW_BAR = 4096; constexpr size_t CTL_ZERO_BYTES = 64 * 1024;
static_assert((CW_BAR + XCD_BAR_WORDS) * 4 <= (int)CTL_ZERO_BYTES, "barrier words inside the memset region");
#define GRID_BAR() do { XcdBarrier b_; b_.bar = (unsigned*)(a.ws() + WS_CTL) + CW_BAR; b_.x = xb_xcc_id(); b_.st = MISC + 8; xcd_barrier(b_); } while (0)
#else
#define GRID_BAR() do { int g_ = G0; asm volatile("" : "+s"(g_)); grid_barrier_counter((unsigned)g_); } while (0)
#endif
#define GEMM_PHASE(EpiT, Aptr, Bptr, M_, N_, K_, Eobj) do { pg8::Gemm g_{}; g_.A = (Aptr); g_.Bt = (Bptr); g_.M = (M_); g_.N = (N_); g_.K = (K_); g_.pad = 0; g_.sA = 0; g_.sB = 0; \
    pg8::StaticOrder S_; S_.init((M_), (N_), G, bid); pg8::gemm_phase<EpiT, pg8::StaticOrder, true, true>(ldsL, g_, S_, (Eobj), tid); } while (0)
#define PH_BEGIN int bid = bid0, G = Gsel; asm volatile("" : "+s"(bid), "+s"(G)); const int tid = FRESH_TID(), lane = tid & 63, wave = __builtin_amdgcn_readfirstlane(tid >> 6), gw = bid * 8 + wave, NGW = G * 8; unsigned char* ws = a.ws(); (void)lane; (void)gw; (void)NGW; (void)ws;
#define WSP(T, off) ((T*)(ws + (off)))
#define RUN(REPS, GSEL, ...) _Pragma("unroll 1") for (int rep_ = 0; rep_ < (REPS); ++rep_) { { const int Gsel = (GSEL); if (bid0 < Gsel) { __VA_ARGS__ } } GRID_BAR(); }
#define RUN2(REPS, GT, THINBODY, OTHERBODY) _Pragma("unroll 1") for (int rep_ = 0; rep_ < (REPS); ++rep_) { const int Gt_ = (GT); if (bid0 < Gt_) { const int Gsel = Gt_; THINBODY } else { const int Gsel = Ggemm; const int Gthin_ = Gt_; OTHERBODY } GRID_BAR(); }
#define GATES_EARLY(lo, hi) { PH_BEGIN EpiGate E; E.o = WSP(bf16, WS_G); E.rs = WSP(const float, WS_RS1); E.shw = WSP(const float, WS_SHWG); \
    pg8::Gemm g_{}; g_.A = WSP(const bf16, WS_H); g_.Bt = WSP(const bf16, WS_WG); g_.M = Mrows; g_.N = DFF; g_.K = D; g_.pad = 0; g_.sA = 0; g_.sB = 0; \
    pg8::RangeOrder S_; S_.init(Mrows, DFF, (lo), (hi), G - Gthin_, bid - Gthin_); pg8::gemm_phase<EpiGate, pg8::RangeOrder, true, true>(ldsL, g_, S_, E, tid); }
#ifndef GRID_C
#define GRID_C Gthin
#endif
#ifndef GRID_C2
#define GRID_C2 Gthin
#endif
#if defined(USE_XCD_BAR) && !defined(NO_CARRY_IN_C)
#define CARRY_IN_C 1
constexpr int CW_S5CNT = 8192;
#define CARRY_BLOCK(CB) __syncthreads(); \
    if (tid == 0) { unsigned* bar_ = (unsigned*)(ws + WS_CTL) + CW_BAR; unsigned* c_ = (unsigned*)(ws + WS_CTL) + CW_S5CNT + 64 * l; \
                    XB_SPIN(xb_ld(c_) < 352u, bar_); __builtin_amdgcn_fence(__ATOMIC_ACQUIRE, "agent"); asm volatile("s_waitcnt vmcnt(0)" ::: "memory"); } \
    __syncthreads(); \
    for (int s = (CB) * 8 + wave; s < 256; s += 32 * 8) s5_carry_seq(a, s, lane);
#endif
#ifndef GRID_D
#define GRID_D Gthin
#endif
#ifndef GRID_A
#define GRID_A Gthin
#endif
#ifndef ECR
#define ECR 5
#endif
#ifndef REP_GMLP
#define REP_GMLP 1
#endif
#ifndef REP_CONV
#define REP_CONV 1
#endif
#ifndef REP_ATTN
#define REP_ATTN 1
#endif
#ifndef REP_S5S
#define REP_S5S 1
#endif
#ifndef REP_A
#define REP_A 1
#endif
#ifndef REP_B
#define REP_B 1
#endif
#ifndef REP_C
#define REP_C 1
#endif
#ifndef REP_C2
#define REP_C2 1
#endif
#ifndef REP_D
#define REP_D 1
#endif
#ifndef REP_E
#define REP_E 1
#endif
#ifndef REP_F
#define REP_F 1
#endif
#ifndef REP_H
#define REP_H 1
#endif
#ifndef REP_I
#define REP_I 1
#endif

__global__ void __launch_bounds__(512, 2) mega_fwd(Args args) {
    extern __shared__ __attribute__((aligned(16))) unsigned char lds[];
    LAS unsigned char* ldsL = (LAS unsigned char*)lds;
    const int Ggemm = (int)gridDim.x, Gthin = Ggemm < THIN_GRID ? Ggemm : THIN_GRID;
    const int bid0 = blockIdx.x, G0 = gridDim.x, wave_s = __builtin_amdgcn_readfirstlane((int)threadIdx.x >> 6);
    volatile LAS unsigned* MISC = (volatile LAS unsigned*)(ldsL + MISC_OFF);
    PA a; a.tab = MISC + 64;
#ifdef USE_XCD_BAR
    if (threadIdx.x < 64) MISC[threadIdx.x] = 0u;
#endif
    if (threadIdx.x == 64) {
#pragma unroll
        for (int i = 0; i < 34; ++i) { const unsigned long long v = (unsigned long long)args.in[i]; a.tab[2 * i] = (unsigned)v; a.tab[2 * i + 1] = (unsigned)(v >> 32); }
        { const unsigned long long v = (unsigned long long)args.out; a.tab[68] = (unsigned)v; a.tab[69] = (unsigned)(v >> 32); }
        { const unsigned long long v = (unsigned long long)args.ws; a.tab[70] = (unsigned)v; a.tab[71] = (unsigned)(v >> 32); }
    }
    __syncthreads();
#ifdef USE_XCD_BAR
    { XcdBarrier bar0 = xcd_barrier_post((unsigned*)(a.ws() + WS_CTL) + CW_BAR, MISC + 8); (void)bar0; }
#endif

    RUN(1, Ggemm, { PH_BEGIN prologue_block(a, bid, ldsL, tid); if (bid >= 193 && bid < 193 + 32) s5disc_thread(a, (bid - 193) * 512 + tid); __syncthreads(); }
        { PH_BEGIN convert_layer(a, 0, (LAS float*)ldsL + wave * 32 * 65, gw, NGW, lane, bid * 512 + tid, G * 512); } )
    for (int l = 0; l < DEPTH; ++l) {
        const int Mrows = (l == DEPTH - 1) ? NLAT : NTOK;
        const int cb_ = (Ggemm - GRID_C >= 32) ? GRID_C : 0;
        const int eC = ECR * (Ggemm - GRID_C), eC2 = eC, eD = eC2 + 1 * (Ggemm - GRID_D);
        RUN(1, (l == 0 ? Ggemm : Gthin),
            if (l == 0) {
            { PH_BEGIN for (int u = bid; u < 32; u += G) s5_tables_unit(a, l, u, ldsL, tid); }
            { PH_BEGIN norm_rows(a, l, 1, gw, NGW, lane, NTOK); neutral_norm1(a, bid * 512 + tid, G * 512); } }
            else {
            { PH_BEGIN rs2_rows(a, bid * 512 + tid, G * 512, NLAT, WS_RS1); norm_ctx_rows(a, l, gw, NGW, lane); }
            { PH_BEGIN shw_rows(a, l, 0, WSP(const bf16, WS_WIN), INC, WSP(float, WS_SHWIN), nullptr, ldsL, tid, gw, NGW); }
            { PH_BEGIN shw_rows(a, l, 0, WSP(const bf16, WS_WG), DFF, WSP(float, WS_SHWG), a.in(I_BGATE) + (size_t)l * 4 * D, ldsL, tid, gw, NGW); } } )
        RUN(REP_B, Ggemm,
            { PH_BEGIN EpiInProj E; E.ga = WSP(bf16, WS_GA); E.yb = WSP(bf16, WS_YB); E.q = WSP(bf16, WS_Q); E.k = WSP(bf16, WS_K); E.vT = WSP(bf16, WS_VT); E.vcT = WSP(bf16, WS_VCT); E.u = WSP(bf16, WS_U);
              E.rope = WSP(const f32x2, WS_ROPE); E.rs = WSP(const float, WS_RS1); E.shw = WSP(const float, WS_SHWIN); GEMM_PHASE(EpiInProj, WSP(const bf16, WS_H), WSP(const bf16, WS_WIN), NTOK, INC, D, E); } )
        RUN2(REP_C, GRID_C,
#ifdef CARRY_IN_C
            { PH_BEGIN unsigned n_ = 0u; for (int u = G - 1 - bid; u < 352; u += G) { s5_state_unit(a, u, ldsL, tid); ++n_; }
              asm volatile("s_waitcnt vmcnt(0)" ::: "memory"); __syncthreads();
              if (tid == 0) { __builtin_amdgcn_fence(__ATOMIC_RELEASE, "agent"); asm volatile("s_waitcnt vmcnt(0)" ::: "memory");
                              xb_add((unsigned*)(ws + WS_CTL) + CW_S5CNT + 64 * l, n_); } }
            { PH_BEGIN for (int u = G - 1 - bid; u < NTOK / 128; u += G) gmlp_unit(a, l, u, ldsL, tid); }
            { PH_BEGIN for (int u = bid; u < NTOK / 32; u += G) conv_unit(a, l, u, ldsL, tid); }
            { PH_BEGIN for (int u = bid; u < 1024 + 32; u += G) attn_unit(a, l, u, ldsL, tid); }
            { PH_BEGIN shw_rows(a, l, 3, WSP(const bf16, WS_WF1), DFF, WSP(float, WS_SHW), nullptr, ldsL, tid, gw, NGW); }
            { PH_BEGIN if (cb_ == 0 && bid < 32) { CARRY_BLOCK(bid) } },
#else
            { PH_BEGIN for (int r_ = 0; r_ < REP_GMLP; ++r_) for (int u = G - 1 - bid; u < NTOK / 128; u += G) gmlp_unit(a, l, u, ldsL, tid); }
            { PH_BEGIN for (int r_ = 0; r_ < REP_CONV; ++r_) for (int u = bid; u < NTOK / 32; u += G) conv_unit(a, l, u, ldsL, tid); }
            { PH_BEGIN for (int r_ = 0; r_ < REP_ATTN; ++r_) for (int u = bid; u < 1024 + 32; u += G) attn_unit(a, l, u, ldsL, tid); }
            { PH_BEGIN for (int r_ = 0; r_ < REP_S5S; ++r_) for (int u = G - 1 - bid; u < 352; u += G) s5_state_unit(a, u, ldsL, tid); }
            { PH_BEGIN shw_rows(a, l, 3, WSP(const bf16, WS_WF1), DFF, WSP(float, WS_SHW), nullptr, ldsL, tid, gw, NGW); },
#endif
#ifdef CARRY_IN_C
            GATES_EARLY(0, eC) { PH_BEGIN if (cb_ != 0 && bid - cb_ < 32) { CARRY_BLOCK(bid - cb_) } } )
#else
            GATES_EARLY(0, eC) )
#endif
#ifndef CARRY_IN_C
        RUN2(REP_C2, GRID_C2, { PH_BEGIN if ((wave & 3) == 0) for (int s = bid * 2 + (wave >> 2); s < 256; s += G * 2) s5_carry_seq(a, s, lane); }, GATES_EARLY(eC, eC2) )
#endif
        RUN2(REP_D, GRID_D, { PH_BEGIN for (int u = bid; u < 352; u += G) s5_out_unit(a, u, ldsL, tid); __syncthreads(); }, GATES_EARLY(eC2, eD) )
        RUN(REP_E, Ggemm,
            { PH_BEGIN EpiGlu E; E.o = WSP(bf16, WS_BR) + (size_t)3 * NTOK * 512; GEMM_PHASE(EpiGlu, WSP(const bf16, WS_YG), WSP(const bf16, WS_WGLU), Mrows, 1024, DB, E); }
            { PH_BEGIN EpiGate E; E.o = WSP(bf16, WS_G); E.rs = WSP(const float, WS_RS1); E.shw = WSP(const float, WS_SHWG);
              pg8::Gemm g_{}; g_.A = WSP(const bf16, WS_H); g_.Bt = WSP(const bf16, WS_WG); g_.M = Mrows; g_.N = DFF; g_.K = D; g_.pad = 0; g_.sA = 0; g_.sB = 0;
              pg8::RangeOrder S_; S_.init(Mrows, DFF, eD, 1 << 30, G, (bid + (G >> 1)) % G);
              pg8::gemm_phase<EpiGate, pg8::RangeOrder, true, true>(ldsL, g_, S_, E, tid); } )
        RUN(REP_F, Ggemm,
            { PH_BEGIN EpiMerge E; E.gate = WSP(const bf16, WS_G); E.mg = WSP(bf16, WS_MG);
              pg8::Gemm g_{}; g_.A = WSP(const bf16, WS_BR); g_.Bt = WSP(const bf16, WS_WBR); g_.M = NLAT; g_.N = D; g_.K = DB; g_.pad = 0; g_.sA = (size_t)NTOK * 512 * 2; g_.sB = (size_t)D * DB * 2;
              pg8::QuadOrder S_; S_.init(NLAT, D, G, bid); pg8::gemm_phase<EpiMerge, pg8::QuadOrder, true, true>(ldsL, g_, S_, E, tid); }
            if (l + 1 < DEPTH) {
            { PH_BEGIN EpiMergePart E; E.gate = WSP(const bf16, WS_G); E.part = WSP(float, WS_PART);
              pg8::Gemm g_{}; g_.A = WSP(const bf16, WS_BR); g_.Bt = WSP(const bf16, WS_WBR); g_.M = NTOK; g_.N = D; g_.K = DB; g_.pad = 0; g_.sA = (size_t)NTOK * 512 * 2; g_.sB = (size_t)D * DB * 2;
              pg8::SliceOrder S_; S_.init(NLAT / 256, NCTX / 256, D / 256, 128, bid >= G - 128 ? bid - (G - 128) : -1); pg8::gemm_phase<EpiMergePart, pg8::SliceOrder, true, true>(ldsL, g_, S_, E, tid); } } )
        if (l + 1 < DEPTH) { RUN(1, Gthin, { PH_BEGIN merge_ctx_rows(a, gw, NGW, lane); } ) }
        RUN(1, Ggemm,
            { PH_BEGIN EpiResidN E; E.srcl = l == 0 ? a.in(I_X) : (const float*)a.out(); E.srcc = l == 0 ? a.in(I_CTX) : WSP(const float, WS_XC); E.dstl = a.out(); E.dstc = WSP(float, WS_XC);
              E.modg = WSP(const float, WS_MOD) + (size_t)l * 5 * 12288 + 2 * D; E.xg = WSP(bf16, WS_H); E.ng2 = a.in(I_N2G) + l * D; E.sc2 = WSP(const float, WS_MOD) + (size_t)l * 5 * 12288 + 4 * D; E.ps = WSP(float, WS_PS);
              GEMM_PHASE(EpiResidN, WSP(const bf16, WS_MG), WSP(const bf16, WS_WOUT), NLAT, D, D, E); }
            if (l + 1 < DEPTH) {
            { PH_BEGIN EpiPart E; E.part = WSP(float, WS_PART);
              pg8::Gemm g_{}; g_.A = WSP(const bf16, WS_MG); g_.Bt = WSP(const bf16, WS_WOUT); g_.M = NTOK; g_.N = D; g_.K = D / 4; g_.pad = D; g_.sA = (size_t)(D / 4) * 2; g_.sB = (size_t)(D / 4) * 2;
              pg8::SliceOrder S_; S_.init(NLAT / 256, NCTX / 256, D / 256, 128, bid < 128 ? bid : -1); pg8::gemm_phase<EpiPart, pg8::SliceOrder, true, true>(ldsL, g_, S_, E, tid); } } )
        RUN(REP_H, Gthin, { PH_BEGIN rs2_rows(a, bid * 512 + tid, G * 512, NLAT); if (l + 1 < DEPTH) outproj_ctx_rows(a, l, gw, NGW, lane); } )
        RUN(REP_I, Ggemm,
            { PH_BEGIN EpiFfn1 E; E.o = WSP(bf16, WS_G); E.rs = WSP(const float, WS_RS2); E.shw = WSP(const float, WS_SHW); GEMM_PHASE(EpiFfn1, WSP(const bf16, WS_H), WSP(const bf16, WS_WF1), Mrows, DFF, D, E); } )
        RUN(1, Ggemm,
            if (l + 1 < DEPTH) {
            { PH_BEGIN EpiResidN E; E.srcl = a.out(); E.srcc = WSP(const float, WS_XC); E.dstl = a.out(); E.dstc = WSP(float, WS_XC); E.modg = WSP(const float, WS_MOD) + (size_t)l * 5 * 12288 + 5 * D;
              E.xg = WSP(bf16, WS_H); E.ng2 = a.in(I_N1G) + (l + 1) * D; E.sc2 = WSP(const float, WS_MOD) + (size_t)(l + 1) * 5 * 12288 + 1 * D; E.ps = WSP(float, WS_PS);
              GEMM_PHASE(EpiResidN, WSP(const bf16, WS_G), WSP(const bf16, (l & 1) ? WS_WF2B : WS_WF2), NLAT, D, DFF, E); } }
            else {
            { PH_BEGIN EpiResid E; E.srcl = a.out(); E.srcc = WSP(const float, WS_XC); E.dstl = a.out(); E.dstc = WSP(float, WS_XC); E.modg = WSP(const float, WS_MOD) + (size_t)l * 5 * 12288 + 5 * D;
              GEMM_PHASE(EpiResid, WSP(const bf16, WS_G), WSP(const bf16, (l & 1) ? WS_WF2B : WS_WF2), NLAT, D, DFF, E); } }
            if (l + 1 < DEPTH) {
            { PH_BEGIN EpiPart E; E.part = WSP(float, WS_PART);
              pg8::Gemm g_{}; g_.A = WSP(const bf16, WS_G); g_.Bt = WSP(const bf16, (l & 1) ? WS_WF2B : WS_WF2); g_.M = NTOK; g_.N = D; g_.K = DFF / 4; g_.pad = DFF; g_.sA = (size_t)(DFF / 4) * 2; g_.sB = (size_t)(DFF / 4) * 2;
              pg8::SliceOrder S_; S_.init(NLAT / 256, NCTX / 256, D / 256, 128, bid < 128 ? bid : -1); pg8::gemm_phase<EpiPart, pg8::SliceOrder, true, true>(ldsL, g_, S_, E, tid); }
            { PH_BEGIN constexpr int ISPLIT = 23000;
              if (bid >= 128 && bid < G - 32) convert_layer(a, l + 1, (LAS float*)ldsL + wave * 32 * 65, (bid - 128) * 8 + wave, (G - 160) * 8, lane, (bid - 128) * 512 + tid, (G - 160) * 512, 0, ISPLIT);
              else if (bid < 128) convert_layer(a, l + 1, (LAS float*)ldsL + wave * 32 * 65, bid * 8 + wave, 128 * 8, lane, bid * 512 + tid, 128 * 512, ISPLIT, 1 << 30); }
            { PH_BEGIN if (bid >= G - 32) s5_tables_unit(a, l + 1, bid - (G - 32), ldsL, tid); } } )
    }
    { const int Gsel = Ggemm; PH_BEGIN final_rows(a, gw, NGW, lane); }
}

extern "C" void kernel_launch(void* const* d_in, const int* in_sizes, int n_in, void* d_out, int out_size, void* d_ws, size_t ws_size, hipStream_t stream) {
    static int grid = 0;
    if (grid == 0) {
        if (n_in != 34 || ws_size < WS_TOTAL) { fprintf(stderr, "kernel_launch: unexpected n_in %d or ws_size %zu (< %zu)\n", n_in, ws_size, (size_t)WS_TOTAL); grid = -1; return; }
        int dev = 0, cus = 0, per_cu = 0;
        if (hipGetDevice(&dev) != hipSuccess || hipDeviceGetAttribute(&cus, hipDeviceAttributeMultiprocessorCount, dev) != hipSuccess) { grid = -1; return; }
        if (hipFuncSetAttribute((const void*)mega_fwd, hipFuncAttributeMaxDynamicSharedMemorySize, LDS_BYTES) != hipSuccess) { fprintf(stderr, "kernel_launch: hipFuncSetAttribute failed\n"); grid = -1; return; }
        if (hipOccupancyMaxActiveBlocksPerMultiprocessor(&per_cu, (const void*)mega_fwd, 512, LDS_BYTES) != hipSuccess || per_cu < 1) { fprintf(stderr, "kernel_launch: occupancy query says %d\n", per_cu); }
        (void)hipGetLastError();
        grid = cus;
        if (grid < 225) { fprintf(stderr, "kernel_launch: %d CUs: the prologue needs >= 225 workgroups\n", grid); grid = -1; return; }
    }
    if (grid < 0) return;
#ifdef USE_XCD_BAR
    (void)hipMemsetAsync((char*)d_ws + WS_CTL, 0, CTL_ZERO_BYTES, stream);
#endif
    Args a{}; for (int i = 0; i < 34; ++i) a.in[i] = (const float*)d_in[i]; a.out = (float*)d_out; a.ws = (unsigned char*)d_ws; a.layer = 0; a.which = 0;
    hipLaunchKernelGGL(mega_fwd, dim3(grid), dim3(512), LDS_BYTES, stream, a);
}
```

```cpp
#include <hip/hip_runtime.h>
#include <cstdio>
#include <cstdint>
#define USE_XCD_BAR 1


#define ECR 7

namespace pg8 {
#define PG8_LAS __attribute__((address_space(3)))
typedef unsigned short bf16_t;
typedef short bf16x8 __attribute__((ext_vector_type(8)));
typedef float f32x4 __attribute__((ext_vector_type(4)));
typedef unsigned u32x4 __attribute__((ext_vector_type(4)));
constexpr int BM = 256, BK = 64, HALF = 128, HTB = HALF * BK * 2  , STAGE_BYTES = 8 * HTB, NXCD = 8, WGM = 8;

__host__ __device__ __forceinline__ int lds_byte(int r, int c) { const int st = (r >> 4) * 2 + (c >> 5), rr = r & 15, cc = c & 31, ob = rr * 64 + cc * 2; return st * 1024 + (ob ^ (((ob >> 9) & 1) << 5)); }
__host__ __device__ __forceinline__ void stage_rc(int b, int& R, int& C) { const int st = b / 1024, sb = b % 1024, swz = sb ^ (((sb >> 9) & 1) << 5); R = (st >> 1) * 16 + swz / 64; C = (st & 1) * 32 + (swz % 64) / 2; }
__host__ __device__ __forceinline__ int perm32(int rho) { const int n = rho >> 4, i = rho & 15; return 8 * (i >> 2) + 4 * n + (i & 3); }

struct Unit { int pm, pn, kb; };
struct Gemm { const bf16_t* A; const bf16_t* Bt; int M, N, K, pad; size_t sA, sB; };

struct StaticOrder {
    int nM, nN, nwg, G, c;
    __host__ __device__ void init(int M, int N, int G_, int c_) { nM = M / BM; nN = N / BM; nwg = nM * nN; G = G_; c = c_; }
    __host__ __device__ bool next(int i, Unit& u) const {
        const long L = (long)i * G + c; if (L >= nwg) return false;
        int wgid = (int)L; { const int q = nwg / NXCD, r = nwg % NXCD, xcd = wgid % NXCD, off = wgid / NXCD; wgid = (xcd < r ? xcd * (q + 1) : r * (q + 1) + (xcd - r) * q) + off; }
        const int nig = WGM * nN, gid = wgid / nig, fm = gid * WGM, gsz = (nM - fm) < WGM ? (nM - fm) : WGM;
        u.pm = fm + ((wgid % nig) % gsz); u.pn = (wgid % nig) / gsz; u.kb = 0; return true;
    }
    __device__ __forceinline__ void a_ready(const Unit&) const {}
    __device__ __forceinline__ void done(const Unit&) const {}
};
struct RangeOrder {
    StaticOrder T; int base, end, Gp, cp;
    __host__ __device__ void init(int M, int N, int base_, int end_, int Gp_, int cp_) { T.init(M, N, 1, 0); base = base_; end = end_ < T.nwg ? end_ : T.nwg; Gp = Gp_; cp = cp_; }
    __host__ __device__ bool next(int i, Unit& u) const { const int L = base + i * Gp + cp; if (L >= end) return false; return T.next(L, u); }
    __device__ __forceinline__ void a_ready(const Unit&) const {}
    __device__ __forceinline__ void done(const Unit&) const {}
};
struct SliceOrder {
    int pm0, nN, n, Gp, cp;
    __host__ __device__ void init(int pm0_, int nP, int nN_, int Gp_, int cp_) { pm0 = pm0_; nN = nN_; n = nP * nN_ * 4; Gp = Gp_; cp = cp_; }
    __host__ __device__ bool next(int i, Unit& u) const { const int L = i * Gp + cp; if (cp < 0 || L >= n) return false; u.kb = L & 3; u.pn = (L >> 2) % nN; u.pm = pm0 + (L >> 2) / nN; return true; }
    __device__ __forceinline__ void a_ready(const Unit&) const {}
    __device__ __forceinline__ void done(const Unit&) const {}
};
struct QuadOrder {
    StaticOrder T;
    __host__ __device__ void init(int M, int N, int G_, int c_) { T.init(M, N, G_, c_); }
    __host__ __device__ bool next(int i, Unit& u) const { const bool ok = T.next(i >> 2, u); u.kb = i & 3; return ok; }
    __device__ __forceinline__ void a_ready(const Unit&) const {}
    __device__ __forceinline__ void done(const Unit&) const {}
};


template <class Epi, class Sched, bool ALIGN_EPI = false, bool SP2 = false>
__device__ __forceinline__ void gemm_phase(PG8_LAS unsigned char* lds, const Gemm g, const Sched& S, const Epi& E, const int tid) {
    const int wid = __builtin_amdgcn_readfirstlane(tid >> 6), lane = tid & 63, wr = wid >> 2, wc = wid & 3, fr = lane & 15, fq = lane >> 4;
    const int K = g.K, nt = K / BK, LD = g.pad > 0 ? g.pad : g.K;
    unsigned voffA[2], voffB[2];
#pragma unroll
    for (int i = 0; i < 2; ++i) { int R, C; stage_rc(tid * 16 + i * 8192, R, C); const int Rb = Epi::PERM ? ((R & ~31) + perm32(R & 31)) : R;
        voffA[i] = (unsigned)(R * LD + C) * 2u; voffB[i] = (unsigned)(Rb * LD + C) * 2u; }
    const size_t kstep = (size_t)(BK * 2);
    const size_t hstep = (size_t)HALF * LD * 2;
    const size_t tstep = 2 * hstep;
    const unsigned ldsw = (unsigned)wid * 1024u;
    const int aoff = lds_byte(wr * 64 + fr, fq * 8), boff = lds_byte(wc * 32 + fr, fq * 8);
#define PG8_SA(b, h) (((b) * 2 + (h)) * HTB)
#define PG8_SB(b, h) ((4 + (b) * 2 + (h)) * HTB)
#define PG8_STAGE(bufoff, gbase, voff) do { _Pragma("unroll") for (int _i = 0; _i < 2; ++_i) \
        __builtin_amdgcn_global_load_lds((const unsigned*)((const char*)(gbase) + (voff)[_i]), (PG8_LAS unsigned*)(lds + (bufoff) + ldsw + _i * 8192), 16, 0, 0); } while (0)
#define PG8_LDA(dst, b, h) do { _Pragma("unroll") for (int m = 0; m < 4; ++m) _Pragma("unroll") for (int k = 0; k < 2; ++k) dst[m][k] = *(const PG8_LAS bf16x8*)(lds + PG8_SA(b, h) + aoff + m * 2048 + k * 1024); } while (0)
#define PG8_LDB(dst, b, h) do { _Pragma("unroll") for (int n = 0; n < 2; ++n) _Pragma("unroll") for (int k = 0; k < 2; ++k) dst[n][k] = *(const PG8_LAS bf16x8*)(lds + PG8_SB(b, h) + boff + n * 2048 + k * 1024); } while (0)
#define PG8_MMA(ai, bj, At, Bt) do { __builtin_amdgcn_s_setprio(1); _Pragma("unroll") for (int m = 0; m < 4; ++m) _Pragma("unroll") for (int n = 0; n < 2; ++n) _Pragma("unroll") for (int k = 0; k < 2; ++k) \
        acc[ai][bj][m][n] = __builtin_amdgcn_mfma_f32_16x16x32_bf16(Bt[n][k], At[m][k], acc[ai][bj][m][n], 0, 0, 0); __builtin_amdgcn_s_setprio(0); } while (0)
#define PG8_WAIT_V(n) asm volatile("s_waitcnt vmcnt(" #n ")" ::: "memory")
#define PG8_WAIT_L(n) asm volatile("s_waitcnt lgkmcnt(" #n ")" ::: "memory")
#define PG8_BAR __builtin_amdgcn_s_barrier()
#define PG8_SCHED __builtin_amdgcn_sched_barrier(0)
    Unit cur, nxt; int ui = 0;
    if (!S.next(0, cur)) return;
    f32x4 acc[2][2][4][2];
#pragma unroll
    for (int a = 0; a < 2; ++a)
#pragma unroll
        for (int b = 0; b < 2; ++b)
#pragma unroll
            for (int m = 0; m < 4; ++m)
#pragma unroll
                for (int n = 0; n < 2; ++n) acc[a][b][m][n] = (f32x4){0.f, 0.f, 0.f, 0.f};
    bf16x8 At[4][2], B0[2][2], B1[2][2];
    const char* cA = (const char*)g.A + (size_t)cur.pm * tstep + (size_t)cur.kb * g.sA; const char* cB = (const char*)g.Bt + (size_t)cur.pn * tstep + (size_t)cur.kb * g.sB;
    S.a_ready(cur);
    if constexpr (SP2) {
        PG8_STAGE(PG8_SB(0, 0), cB, voffB); PG8_STAGE(PG8_SB(0, 1), cB + hstep, voffB); PG8_STAGE(PG8_SA(0, 0), cA, voffA); PG8_STAGE(PG8_SA(0, 1), cA + hstep, voffA);
        if (wr == 1) PG8_BAR;
        PG8_WAIT_V(2); PG8_BAR;
        PG8_STAGE(PG8_SB(1, 0), cB + kstep, voffB); PG8_STAGE(PG8_SA(1, 0), cA + kstep, voffA); PG8_STAGE(PG8_SB(1, 1), cB + hstep + kstep, voffB);
        PG8_WAIT_V(6); PG8_BAR;
    } else {
        PG8_STAGE(PG8_SB(0, 0), cB, voffB); PG8_STAGE(PG8_SA(0, 0), cA, voffA); PG8_STAGE(PG8_SB(0, 1), cB + hstep, voffB); PG8_STAGE(PG8_SA(0, 1), cA + hstep, voffA);
        if (wr == 1) PG8_BAR;
        PG8_WAIT_V(4); PG8_BAR;
        PG8_STAGE(PG8_SB(1, 0), cB + kstep, voffB); PG8_STAGE(PG8_SA(1, 0), cA + kstep, voffA); PG8_STAGE(PG8_SB(1, 1), cB + hstep + kstep, voffB);
        PG8_WAIT_V(6); PG8_BAR;
    }
    for (;;) {
        const bool has_next = S.next(ui + 1, nxt);
        const char* nA = has_next ? (const char*)g.A + (size_t)nxt.pm * tstep + (size_t)nxt.kb * g.sA : cA; const char* nB = has_next ? (const char*)g.Bt + (size_t)nxt.pn * tstep + (size_t)nxt.kb * g.sB : cB;
        for (int t = 0; t < nt; t += 2) {
            const bool last = (t == nt - 2);
            const char* a1 = cA + (size_t)(t + 1) * kstep;
            const char* a2 = last ? nA : cA + (size_t)(t + 2) * kstep; const char* b2 = last ? nB : cB + (size_t)(t + 2) * kstep;
            const char* a3 = a2 + kstep; const char* b3 = b2 + kstep;
            if (last && has_next) S.a_ready(nxt);
            if constexpr (SP2) {
            PG8_LDB(B0, 0, 0); PG8_LDB(B1, 0, 1); PG8_SCHED; PG8_LDA(At, 0, 0); PG8_STAGE(PG8_SA(1, 1), a1 + hstep, voffA);
            PG8_WAIT_V(8); PG8_WAIT_L(0); PG8_BAR; PG8_MMA(0, 0, At, B0); PG8_MMA(0, 1, At, B1); PG8_BAR; PG8_SCHED;
            PG8_LDA(At, 0, 1); PG8_STAGE(PG8_SB(0, 0), b2, voffB); PG8_STAGE(PG8_SB(0, 1), b2 + hstep, voffB); PG8_STAGE(PG8_SA(0, 0), a2, voffA);
            PG8_WAIT_V(8); PG8_WAIT_L(0); PG8_BAR; PG8_MMA(1, 0, At, B0); PG8_MMA(1, 1, At, B1); PG8_BAR; PG8_SCHED;
            PG8_LDB(B0, 1, 0); PG8_LDB(B1, 1, 1); PG8_SCHED; PG8_LDA(At, 1, 0); PG8_STAGE(PG8_SA(0, 1), a2 + hstep, voffA);
            PG8_WAIT_V(8); PG8_WAIT_L(0); PG8_BAR; PG8_MMA(0, 0, At, B0); PG8_MMA(0, 1, At, B1); PG8_BAR; PG8_SCHED;
            PG8_LDA(At, 1, 1); PG8_STAGE(PG8_SB(1, 0), b3, voffB); PG8_STAGE(PG8_SB(1, 1), b3 + hstep, voffB); PG8_STAGE(PG8_SA(1, 0), a3, voffA);
            PG8_WAIT_V(8); PG8_WAIT_L(0); PG8_BAR; PG8_MMA(1, 0, At, B0); PG8_MMA(1, 1, At, B1); PG8_BAR; PG8_SCHED;
            } else {
            PG8_LDB(B0, 0, 0); PG8_SCHED; PG8_LDA(At, 0, 0); PG8_STAGE(PG8_SA(1, 1), a1 + hstep, voffA);
            PG8_WAIT_L(8); PG8_BAR; PG8_WAIT_L(0); PG8_MMA(0, 0, At, B0); PG8_BAR; PG8_SCHED;
            PG8_LDB(B1, 0, 1); PG8_STAGE(PG8_SB(0, 0), b2, voffB);
            PG8_BAR; PG8_WAIT_L(0); PG8_MMA(0, 1, At, B1); PG8_BAR;
            PG8_LDA(At, 0, 1); PG8_STAGE(PG8_SA(0, 0), a2, voffA);
            PG8_BAR; PG8_WAIT_L(0); PG8_MMA(1, 0, At, B0); PG8_BAR; PG8_SCHED;
            PG8_STAGE(PG8_SB(0, 1), b2 + hstep, voffB);
            PG8_WAIT_V(6); PG8_BAR; PG8_MMA(1, 1, At, B1); PG8_BAR;
            PG8_LDB(B0, 1, 0); PG8_SCHED; PG8_LDA(At, 1, 0); PG8_STAGE(PG8_SA(0, 1), a2 + hstep, voffA);
            PG8_WAIT_L(8); PG8_BAR; PG8_WAIT_L(0); PG8_MMA(0, 0, At, B0); PG8_BAR; PG8_SCHED;
            PG8_LDB(B1, 1, 1); PG8_STAGE(PG8_SB(1, 0), b3, voffB);
            PG8_BAR; PG8_WAIT_L(0); PG8_MMA(0, 1, At, B1); PG8_BAR;
            PG8_LDA(At, 1, 1); PG8_STAGE(PG8_SA(1, 0), a3, voffA);
            PG8_BAR; PG8_WAIT_L(0); PG8_MMA(1, 0, At, B0); PG8_BAR; PG8_SCHED;
            PG8_STAGE(PG8_SB(1, 1), b3 + hstep, voffB);
            PG8_WAIT_V(6); PG8_BAR; PG8_MMA(1, 1, At, B1); PG8_BAR;
            }
        }
        if constexpr (ALIGN_EPI) { if (wr == 0) PG8_BAR; }
        if constexpr (!Epi::AFTER_DRAIN) { E(acc, cur, wr, wc, fr, fq); S.done(cur); }
        if (!has_next) break;
#pragma unroll
        for (int a = 0; a < 2; ++a)
#pragma unroll
            for (int b = 0; b < 2; ++b)
#pragma unroll
                for (int m = 0; m < 4; ++m)
#pragma unroll
                    for (int n = 0; n < 2; ++n) acc[a][b][m][n] = (f32x4){0.f, 0.f, 0.f, 0.f};
        cur = nxt; cA = nA; cB = nB; ++ui;
        if constexpr (ALIGN_EPI) { if (wr == 1) PG8_BAR; }
    }
    PG8_WAIT_V(0);
    if constexpr (!ALIGN_EPI) { if (wr == 0) PG8_BAR; }
    PG8_BAR;
    if constexpr (Epi::AFTER_DRAIN) { E.fused(acc, cur, wr, wc, fr, fq, lds, wid, lane); S.done(cur); }
#undef PG8_SA
#undef PG8_SB
#undef PG8_STAGE
#undef PG8_LDA
#undef PG8_LDB
#undef PG8_MMA
#undef PG8_WAIT_V
#undef PG8_WAIT_L
#undef PG8_BAR
#undef PG8_SCHED
}
}

typedef unsigned short bf16;
typedef short bf16x8 __attribute__((ext_vector_type(8)));
typedef float f32x4 __attribute__((ext_vector_type(4)));
typedef float f32x2 __attribute__((ext_vector_type(2)));
typedef unsigned u32x4 __attribute__((ext_vector_type(4)));
typedef unsigned u32x2 __attribute__((ext_vector_type(2)));
#define LAS __attribute__((address_space(3)))
constexpr int D = 2048, NB = 4, SEQ = 8192, DEPTH = 4, CTXL = 256;
constexpr int NLAT = NB * SEQ, NCTX = NB * CTXL, NTOK = NLAT + NCTX;
constexpr int DB = 512, INC = 3328, DFF = 8192, NMOD = 6;
constexpr float EPS = 1e-6f, LOG2E = 1.4426950408889634f, QSCALE = 0.125f * 1.4426950408889634f;
constexpr size_t MiB = 1u << 20;
constexpr size_t WS_CTL = 0, WS_MOD = 1 * MiB, WS_ROPE = 2 * MiB, WS_GWS = 2 * MiB + 256 * 1024;
constexpr size_t WS_WIN = 64 * MiB, WS_WG = 77 * MiB, WS_WBR = 109 * MiB, WS_WOUT = 117 * MiB, WS_WF1 = 125 * MiB, WS_WF2 = 157 * MiB, WS_WGLU = 189 * MiB;
constexpr size_t WS_XC = 190 * MiB, WS_H = 198 * MiB, WS_GA = 330 * MiB, WS_YB = 396 * MiB, WS_Q = 429 * MiB, WS_K = 462 * MiB, WS_VT = 471 * MiB, WS_U = 480 * MiB;
constexpr size_t WS_BR = 514 * MiB, WS_MG = 646 * MiB, WS_G = 778 * MiB, WS_YF = 1306 * MiB, WS_YBK = 1372 * MiB, WS_END = 1438 * MiB;
constexpr size_t WF2_BYTES = (size_t)DFF * D * 2, WS_WF2B = WS_END;
constexpr size_t WS_TOTAL = WS_END + 32 * MiB;
constexpr size_t WS_PS = 1372 * MiB, WS_RS2 = 1378 * MiB, WS_SHW = 1379 * MiB;
constexpr size_t WS_SHWIN = 1380 * MiB, WS_SHWG = 1381 * MiB, WS_RS1 = 1382 * MiB;
constexpr size_t WS_PART = 1384 * MiB;
constexpr size_t WS_YG = WS_GA, WS_MBUF = WS_H;
constexpr size_t WS_VCT = WS_VT + 8 * MiB;
constexpr size_t WS_S5DISC = 4 * MiB;

typedef __bf16 bf16x2_t __attribute__((ext_vector_type(2)));
__device__ __forceinline__ unsigned pk2(float lo, float hi) { const f32x2 v = {lo, hi}; return __builtin_bit_cast(unsigned, __builtin_convertvector(v, bf16x2_t)); }
__device__ __forceinline__ unsigned f2bf(float f) { return pk2(f, f) & 0xffffu; }
__device__ __forceinline__ float bf2f(unsigned b) { return __builtin_bit_cast(float, b << 16); }
__device__ __forceinline__ float bflo(unsigned w) { return __builtin_bit_cast(float, w << 16); }
__device__ __forceinline__ float bfhi(unsigned w) { return __builtin_bit_cast(float, w & 0xffff0000u); }
__device__ __forceinline__ float sigmoidf_(float x) { return __builtin_amdgcn_rcpf(1.f + __builtin_amdgcn_exp2f(-x * LOG2E)); }
__device__ __forceinline__ float gelu_tanh(float x) { const float y = 0.7978845608028654f * (x + 0.044715f * x * x * x); return x * sigmoidf_(2.f * y); }
__device__ __forceinline__ float siluf_(float x) { return x * sigmoidf_(x); }
__device__ __forceinline__ int lane_fresh() { int l; asm volatile("v_mbcnt_lo_u32_b32 %0, -1, 0\n\tv_mbcnt_hi_u32_b32 %0, -1, %0" : "=v"(l)); return l; }
template <int M> __device__ __forceinline__ float shx(float v) {
    if constexpr (M < 32) return __builtin_bit_cast(float, __builtin_amdgcn_ds_swizzle(__builtin_bit_cast(int, v), (M << 10) | 0x1f));
    else return __builtin_bit_cast(float, __builtin_amdgcn_ds_bpermute((lane_fresh() ^ 32) << 2, __builtin_bit_cast(int, v)));
}
__device__ __forceinline__ float wave_sum(float v) { v += shx<1>(v); v += shx<2>(v); v += shx<4>(v); v += shx<8>(v); v += shx<16>(v); v += shx<32>(v); return v; }
struct Args { const float* in[34]; float* out; unsigned char* ws; int layer, which; };
enum { I_X = 0, I_C, I_CTX, I_CCTX, I_WMOD, I_BMOD, I_N1G, I_N2G, I_WIN, I_GLNG, I_GLNB, I_GWS, I_GBS, I_CW, I_CB, I_CLNG, I_CLNB, I_SINK, I_ARE, I_AIM, I_LSTEP, I_BRE, I_BIM, I_CRE, I_CIM,
       I_S5D, I_WGLU, I_WBR, I_WGATE, I_BGATE, I_WOUT, I_WF1, I_WF2, I_FINALG };

struct PA {
    volatile LAS unsigned* tab;
    __device__ __forceinline__ unsigned long long get(int i) const { unsigned z; asm volatile("v_mov_b32 %0, 0" : "=v"(z)); volatile LAS unsigned* t = (volatile LAS unsigned*)((LAS unsigned char*)tab + z); unsigned lo = t[2 * i], hi = t[2 * i + 1]; lo = __builtin_amdgcn_readfirstlane(lo); hi = __builtin_amdgcn_readfirstlane(hi); return ((unsigned long long)hi << 32) | lo; }
    __device__ __forceinline__ const float* in(int i) const { return (const float*)(const __attribute__((address_space(1))) float*)get(i); }
    __device__ __forceinline__ float* out() const { return (float*)(__attribute__((address_space(1))) float*)get(34); }
    __device__ __forceinline__ unsigned char* ws() const { return (unsigned char*)(__attribute__((address_space(1))) unsigned char*)get(35); }
};
#define FRESH_TID() ({ int w_ = wave_s; asm volatile("" : "+s"(w_)); int t_ = (w_ << 6) | lane_fresh(); asm volatile("" : "+v"(t_)); t_; })

#define XB_TMO      128
#define XB_XCNT(j)  (256  + 64 * (j))
#define XB_XSUB(j)  (1280 + 64 * (j))
#define XB_XGEN(j)  (2304 + 64 * (j))
#define XB_TOP      3328
#define XB_TOPGEN   3392
#define XCD_BAR_WORDS 3456
#define XB_SPIN_CAP (1u << 22)

__device__ __forceinline__ unsigned xb_ld(unsigned* p)              { return __hip_atomic_load(p, __ATOMIC_RELAXED, __HIP_MEMORY_SCOPE_AGENT); }
__device__ __forceinline__ unsigned xb_add(unsigned* p, unsigned v) { return __hip_atomic_fetch_add(p, v, __ATOMIC_RELAXED, __HIP_MEMORY_SCOPE_AGENT); }
__device__ __forceinline__ unsigned xb_xcc_id() { return (unsigned)__builtin_amdgcn_s_getreg((3 << 11) | 20) & 0xFu; }
#define XB_SPIN(cond, bar) do { unsigned _sp = 0; while (cond) { __builtin_amdgcn_s_sleep(1); \
    if ((++_sp & 255u) == 0u) { if (xb_ld(&(bar)[XB_TMO])) break; if (_sp > XB_SPIN_CAP) { atomicAdd(&(bar)[XB_TMO], 1u); break; } } } } while (0)

struct XcdBarrier {
    unsigned* bar; unsigned x;
    volatile LAS unsigned* st;
};

__device__ __forceinline__ XcdBarrier xcd_barrier_post(unsigned* bar, volatile LAS unsigned* st) {
    XcdBarrier b; b.bar = bar; b.x = xb_xcc_id(); b.st = st;
    if (threadIdx.x == 0) (void)xb_add(&bar[XB_XCNT(b.x)], 1u);
    return b;
}
__device__ __forceinline__ void xcd_barrier_complete(unsigned* bar, unsigned x, unsigned& nloc, unsigned& nx) {
    const unsigned G = gridDim.x * gridDim.y * gridDim.z;
    unsigned sum, cnt, mine, sp = 0u;
    for (;;) {
        sum = 0u; cnt = 0u; mine = 0u;
#pragma unroll
        for (unsigned j = 0; j < 16; ++j) { const unsigned c = xb_ld(&bar[XB_XCNT(j)]); sum += c; cnt += (c > 0u) ? 1u : 0u; mine = (j == x) ? c : mine; }
        if (sum == G) break;
        __builtin_amdgcn_s_sleep(1);
        if ((++sp & 255u) == 0u) { if (xb_ld(&bar[XB_TMO])) break; if (sp > XB_SPIN_CAP) { atomicAdd(&bar[XB_TMO], 1u); break; } }
    }
    nloc = mine > 0u ? mine : 1u; nx = cnt > 0u ? cnt : 1u;
}

__device__ __forceinline__ void xcd_barrier(const XcdBarrier& b) {
    asm volatile("s_waitcnt vmcnt(0)" ::: "memory");
    __syncthreads();
    if (threadIdx.x == 0) {
        unsigned* bar = b.bar;
        __builtin_amdgcn_s_waitcnt(0);
        unsigned nloc = b.st[0], nx = b.st[1];
        if (nloc == 0u) { xcd_barrier_complete(bar, b.x, nloc, nx); b.st[0] = nloc; b.st[1] = nx; }
        const unsigned old = xb_add(&bar[XB_XSUB(b.x)], 1u);
        const unsigned gen = old / nloc;
        if (old + 1u == (gen + 1u) * nloc) {
            __builtin_amdgcn_fence(__ATOMIC_RELEASE, "agent");
            asm volatile("s_waitcnt vmcnt(0)" ::: "memory");
            const unsigned og = xb_add(&bar[XB_TOP], 1u);
            const unsigned tg = og / nx;
            if (og + 1u == (tg + 1u) * nx) xb_add(&bar[XB_TOPGEN], 1u);
            else XB_SPIN(xb_ld(&bar[XB_TOPGEN]) == tg, bar);
            __builtin_amdgcn_fence(__ATOMIC_ACQUIRE, "agent");
            xb_add(&bar[XB_XGEN(b.x)], 1u);
            asm volatile("s_waitcnt vmcnt(0)" ::: "memory");
        } else {
            XB_SPIN(xb_ld(&bar[XB_XGEN(b.x)]) == gen, bar);
            __builtin_amdgcn_fence(__ATOMIC_ACQUIRE, "agent");
            asm volatile("s_waitcnt vmcnt(0)" ::: "memory");
        }
    }
    __syncthreads();
}

__device__ __forceinline__ void prologue_block(const PA& a, int bid, LAS unsigned char* lds, int tid) {
    if (bid > 192) return;
    if (bid == 192) {
        f32x2* rt = (f32x2*)(a.ws() + WS_ROPE);
        for (int i = tid; i < 2048; i += 512) { const int pos = i >> 4, fi = i & 15; const double inv = pow(10000.0, -(double)fi / 16.0); const double ang = (double)pos * inv;
            rt[i] = (f32x2){(float)cos(ang), (float)sin(ang)}; }
        return;
    }
    LAS float* sc = (LAS float*)lds; LAS float* part = (LAS float*)(lds + 40960);
    const float* c = a.in(I_C); const float* cc = a.in(I_CCTX);
    for (int i = tid; i < 5 * 2048; i += 512) { const int s = i >> 11, k = i & 2047; const float v = s < 4 ? c[s * 2048 + k] : cc[k]; sc[i] = v / (1.f + expf(-v)); }
    __syncthreads();
    const int col = bid * 256 + (tid & 255), kh = tid >> 8;
    const int l = col / 12288, j = col % 12288;
    const float* w = a.in(I_WMOD) + (size_t)l * 2048 * 12288 + (size_t)kh * 1024 * 12288 + j;
    float acc[5] = {0.f, 0.f, 0.f, 0.f, 0.f};
#pragma unroll 1
    for (int k0 = 0; k0 < 1024; k0 += 32) { float wv[32];
#pragma unroll
        for (int k = 0; k < 32; ++k) wv[k] = w[(size_t)(k0 + k) * 12288];
#pragma unroll
        for (int k = 0; k < 32; ++k)
#pragma unroll
            for (int s = 0; s < 5; ++s) acc[s] += sc[s * 2048 + kh * 1024 + k0 + k] * wv[k]; }
    if (kh == 1) {
#pragma unroll
        for (int s = 0; s < 5; ++s) part[s * 256 + (tid & 255)] = acc[s]; }
    __syncthreads();
    if (kh == 0) { const float b = a.in(I_BMOD)[l * 12288 + j]; float* mv = (float*)(a.ws() + WS_MOD);
#pragma unroll
        for (int s = 0; s < 5; ++s) mv[(size_t)(l * 5 + s) * 12288 + j] = acc[s] + part[s * 256 + (tid & 255)] + b; }
}

__device__ __forceinline__ int inproj_map(int n) {
    if (n < 1024) return n;
    if (n < 2048) { const int m = n - 1024; return 1024 + (m < 512 ? 2 * m : 2 * (m - 512) + 1); }
    if (n < 2688) { const int base = n < 2560 ? 2048 : 2560; const int m = n - base, head = m >> 6, d = m & 63, half = d >> 5, i = d & 31; return base + head * 64 + half * 32 + 2 * (i & 15) + (i >> 4); }
    return n;
}
__device__ __forceinline__ int rowmap(int mode, int n) {
    if (mode == 1) return inproj_map(n);
    if (mode == 2) return n < 512 ? 2 * n : 2 * (n - 512) + 1;
    return n;
}
__device__ __forceinline__ void cvt_item(const float* W, int K, int N, bf16* WT, int mode, LAS float* scr, int item, int lane) {
    const int nblk = N / 64, kb = item / nblk, nb = item % nblk, k0 = 32 * kb, n0 = 64 * nb;
    f32x4 v[8];
#pragma unroll
    for (int i = 0; i < 8; ++i) v[i] = *(const f32x4*)(W + (size_t)(k0 + 4 * i + (lane >> 4)) * N + n0 + (lane & 15) * 4);
#pragma unroll
    for (int i = 0; i < 8; ++i) { LAS float* s = scr + (4 * i + (lane >> 4)) * 65 + (lane & 15) * 4; s[0] = v[i].x; s[1] = v[i].y; s[2] = v[i].z; s[3] = v[i].w; }
    asm volatile("s_waitcnt lgkmcnt(0)" ::: "memory");
#pragma unroll
    for (int j = 0; j < 4; ++j) { const int idx = lane + 64 * j, n = idx >> 2, c = idx & 3; const LAS float* s = scr + (8 * c) * 65 + n;
        u32x4 o; o.x = pk2(s[0 * 65], s[1 * 65]); o.y = pk2(s[2 * 65], s[3 * 65]); o.z = pk2(s[4 * 65], s[5 * 65]); o.w = pk2(s[6 * 65], s[7 * 65]);
        *(u32x4*)(WT + (size_t)rowmap(mode, n0 + n) * K + k0 + 8 * c) = o; }
    asm volatile("s_waitcnt lgkmcnt(0)" ::: "memory");
}
__device__ __forceinline__ void convert_layer(const PA& a, int l, LAS float* scr, int gw, int NGW, int lane, int gtid, int nthr, int it_lo = 0, int it_hi = 1 << 30) {
    unsigned char* ws = a.ws();
    constexpr int I_IN = 64 * 52, I_G = 64 * 32, I_B = 16 * 32, I_O = 64 * 32, I_1 = 64 * 128, I_2 = 256 * 32, I_GL = 16 * 16;
    constexpr int NITEMS = I_IN + 4 * I_G + 4 * I_B + I_O + I_1 + I_2 + I_GL;
    const int it_end = it_hi < NITEMS ? it_hi : NITEMS;
    for (int it = it_lo + gw; it < it_end; it += NGW) {
        int r = it;
        if (r < I_IN) { cvt_item(a.in(I_WIN) + (size_t)l * D * INC, D, INC, (bf16*)(ws + WS_WIN), 1, scr, r, lane); continue; } r -= I_IN;
        if (r < 4 * I_G) { const int k = r / I_G; cvt_item(a.in(I_WGATE) + (size_t)(l * 4 + k) * D * D, D, D, (bf16*)(ws + WS_WG) + (size_t)k * D * D, 0, scr, r % I_G, lane); continue; } r -= 4 * I_G;
        if (r < 4 * I_B) { const int k = r / I_B; cvt_item(a.in(I_WBR) + (size_t)(l * 4 + k) * DB * D, DB, D, (bf16*)(ws + WS_WBR) + (size_t)k * D * DB, 0, scr, r % I_B, lane); continue; } r -= 4 * I_B;
        if (r < I_O) { cvt_item(a.in(I_WOUT) + (size_t)l * D * D, D, D, (bf16*)(ws + WS_WOUT), 0, scr, r, lane); continue; } r -= I_O;
        if (r < I_1) { cvt_item(a.in(I_WF1) + (size_t)l * D * DFF, D, DFF, (bf16*)(ws + WS_WF1), 0, scr, r, lane); continue; } r -= I_1;
        if (r < I_2) { cvt_item(a.in(I_WF2) + (size_t)l * DFF * D, DFF, D, (bf16*)(ws + ((l & 1) ? WS_WF2B : WS_WF2)), 0, scr, r, lane); continue; } r -= I_2;
        cvt_item(a.in(I_WGLU) + (size_t)l * DB * 1024, DB, 1024, (bf16*)(ws + WS_WGLU), 2, scr, r, lane);
    }
    bf16* gws = (bf16*)(ws + WS_GWS); const float* gsrc = a.in(I_GWS) + (size_t)l * 65536;
    if (it_lo == 0) for (int i = gtid; i < 65536; i += nthr) gws[i] = (bf16)f2bf(gsrc[i]);
}

__device__ __forceinline__ const float* xrow_src(const PA& a, int layer, int which, int r) {
    if (layer == 0 && which == 1) return r < NLAT ? a.in(I_X) + (size_t)r * D : a.in(I_CTX) + (size_t)(r - NLAT) * D;
    return r < NLAT ? a.out() + (size_t)r * D : (const float*)(a.ws() + WS_XC) + (size_t)(r - NLAT) * D;
}
__device__ __forceinline__ void norm_rows(const PA& a, int layer, int which, int gw, int NGW, int lane, int nrows) {
    const float* ng = a.in(which == 1 ? I_N1G : I_N2G) + layer * D;
    bf16* H = (bf16*)(a.ws() + WS_H);
    const float* mvb = (const float*)(a.ws() + WS_MOD) + (size_t)(layer * 5) * 12288 + (which == 1 ? 0 : 3) * D;
    f32x4 ca[8], cb[8]; int cur = -1;
#pragma unroll 1
    for (int r0 = gw; r0 < nrows; r0 += 3 * NGW) {
        f32x4 v[3][8]; float ss[3];
#pragma unroll
        for (int q = 0; q < 3; ++q) { const int r = r0 + q * NGW; const int rr = r < nrows ? r : r0; const f32x4* xr = (const f32x4*)xrow_src(a, layer, which, rr) + lane; ss[q] = 0.f;
#pragma unroll
            for (int j = 0; j < 8; ++j) v[q][j] = xr[64 * j]; }
#pragma unroll
        for (int q = 0; q < 3; ++q) {
#pragma unroll
            for (int j = 0; j < 8; ++j) ss[q] += (v[q][j].x * v[q][j].x + v[q][j].y * v[q][j].y) + (v[q][j].z * v[q][j].z + v[q][j].w * v[q][j].w); }
#pragma unroll
        for (int q = 0; q < 3; ++q) ss[q] = wave_sum(ss[q]);
#pragma unroll
        for (int q = 0; q < 3; ++q) { const int r = r0 + q * NGW; if (r < nrows) {
            const float rs = 1.f / sqrtf(ss[q] * (1.f / D) + EPS);
            const int s = r < NLAT ? (r >> 13) : 4;
            if (s != cur) { cur = s; const float* mv = mvb + (size_t)s * 12288;
#pragma unroll
                for (int j = 0; j < 8; ++j) { const int col = (lane + 64 * j) * 4; ca[j] = *(const f32x4*)(ng + col) * (*(const f32x4*)(mv + D + col) + 1.f); cb[j] = *(const f32x4*)(mv + col); } }
            u32x2* o8 = (u32x2*)(H + (size_t)r * D) + lane;
#pragma unroll
            for (int j = 0; j < 8; ++j) { const f32x4 y = (v[q][j] * rs) * ca[j] + cb[j]; o8[64 * j] = (u32x2){pk2(y.x, y.y), pk2(y.z, y.w)}; } } }
    }
}

__device__ __forceinline__ void norm_ctx_rows(const PA& a, int layer, int gw, int NGW, int lane) {
    const float* ng = a.in(I_N1G) + layer * D; bf16* H = (bf16*)(a.ws() + WS_H);
    const float* mv = (const float*)(a.ws() + WS_MOD) + (size_t)(layer * 5 + 4) * 12288;
    const float* g2 = (const float*)(a.ws() + WS_MOD) + (size_t)((layer - 1) * 5 + 4) * 12288 + 5 * D;
    const float* part = (const float*)(a.ws() + WS_PART);
    for (int rc = gw; rc < NCTX; rc += NGW) {
        f32x4* xr = (f32x4*)(a.ws() + WS_XC + (size_t)rc * D * 4) + lane; f32x4 v[8]; float ss = 0.f;
#pragma unroll
        for (int j = 0; j < 8; ++j) { const int col = (lane + 64 * j) * 4; const float* pp = part + (size_t)rc * D + col;
            const f32x4 p = ((*(const f32x4*)pp + *(const f32x4*)(pp + (size_t)NCTX * D)) + *(const f32x4*)(pp + (size_t)2 * NCTX * D)) + *(const f32x4*)(pp + (size_t)3 * NCTX * D);
            v[j] = xr[64 * j] + *(const f32x4*)(g2 + col) * p; xr[64 * j] = v[j];
            ss += (v[j].x * v[j].x + v[j].y * v[j].y) + (v[j].z * v[j].z + v[j].w * v[j].w); }
        const float sm = wave_sum(ss); if (lane == 0) ((float*)(a.ws() + WS_RS1))[NLAT + rc] = 1.f / sqrtf(sm * (1.f / D) + EPS);
        u32x2* o8 = (u32x2*)(H + (size_t)(NLAT + rc) * D) + lane;
#pragma unroll
        for (int j = 0; j < 8; ++j) { const int col = (lane + 64 * j) * 4;
            const f32x4 y = v[j] * *(const f32x4*)(ng + col) * (*(const f32x4*)(mv + D + col) + 1.f);
            o8[64 * j] = (u32x2){pk2(y.x, y.y), pk2(y.z, y.w)}; }
    }
}

__device__ __forceinline__ void outproj_ctx_rows(const PA& a, int layer, int gw, int NGW, int lane) {
    const float* ng = a.in(I_N2G) + layer * D; bf16* H = (bf16*)(a.ws() + WS_H);
    const float* mv = (const float*)(a.ws() + WS_MOD) + (size_t)(layer * 5 + 4) * 12288;
    const float* part = (const float*)(a.ws() + WS_PART);
    const float* srcb = layer == 0 ? a.in(I_CTX) : (const float*)(a.ws() + WS_XC);
    for (int rc = gw; rc < NCTX; rc += NGW) {
        const f32x4* xs = (const f32x4*)(srcb + (size_t)rc * D) + lane; f32x4* xr = (f32x4*)(a.ws() + WS_XC + (size_t)rc * D * 4) + lane; f32x4 v[8]; float ss = 0.f;
#pragma unroll
        for (int j = 0; j < 8; ++j) { const int col = (lane + 64 * j) * 4; const float* pp = part + (size_t)rc * D + col;
            const f32x4 p = ((*(const f32x4*)pp + *(const f32x4*)(pp + (size_t)NCTX * D)) + *(const f32x4*)(pp + (size_t)2 * NCTX * D)) + *(const f32x4*)(pp + (size_t)3 * NCTX * D);
            v[j] = xs[64 * j] + *(const f32x4*)(mv + 2 * D + col) * p; }
#pragma unroll
        for (int j = 0; j < 8; ++j) { xr[64 * j] = v[j]; ss += (v[j].x * v[j].x + v[j].y * v[j].y) + (v[j].z * v[j].z + v[j].w * v[j].w); }
        const float sm = wave_sum(ss); if (lane == 0) ((float*)(a.ws() + WS_RS2))[NLAT + rc] = 1.f / sqrtf(sm * (1.f / D) + EPS);
        u32x2* o8 = (u32x2*)(H + (size_t)(NLAT + rc) * D) + lane;
#pragma unroll
        for (int j = 0; j < 8; ++j) { const int col = (lane + 64 * j) * 4;
            const f32x4 y = v[j] * *(const f32x4*)(ng + col) * (*(const f32x4*)(mv + 4 * D + col) + 1.f);
            o8[64 * j] = (u32x2){pk2(y.x, y.y), pk2(y.z, y.w)}; }
    }
}

__device__ __forceinline__ void final_rows(const PA& a, int gw, int NGW, int lane) {
    const float* fg = a.in(I_FINALG);
#pragma unroll 1
    for (int r0 = gw; r0 < NLAT; r0 += 2 * NGW) {
        f32x4 v[2][8]; float ss[2];
#pragma unroll
        for (int q = 0; q < 2; ++q) { const int r = r0 + q * NGW; const int rr = r < NLAT ? r : r0; const f32x4* xr = (const f32x4*)(a.out() + (size_t)rr * D) + lane; ss[q] = 0.f;
#pragma unroll
            for (int j = 0; j < 8; ++j) v[q][j] = xr[64 * j]; }
#pragma unroll
        for (int q = 0; q < 2; ++q) {
#pragma unroll
            for (int j = 0; j < 8; ++j) ss[q] += (v[q][j].x * v[q][j].x + v[q][j].y * v[q][j].y) + (v[q][j].z * v[q][j].z + v[q][j].w * v[q][j].w); }
#pragma unroll
        for (int q = 0; q < 2; ++q) ss[q] = wave_sum(ss[q]);
#pragma unroll
        for (int q = 0; q < 2; ++q) { const int r = r0 + q * NGW; if (r < NLAT) { const float rs = 1.f / sqrtf(ss[q] * (1.f / D) + EPS); f32x4* xw = (f32x4*)(a.out() + (size_t)r * D) + lane;
#pragma unroll
            for (int j = 0; j < 8; ++j) { const int col = (lane + 64 * j) * 4; xw[64 * j] = v[q][j] * rs * *(const f32x4*)(fg + col); } } }
    }
}

__device__ __forceinline__ void rs2_rows(const PA& a, int gtid, int nthr, int nrows, size_t rs_off = WS_RS2) {
    const f32x4* ps = (const f32x4*)(a.ws() + WS_PS); float* rs = (float*)(a.ws() + rs_off);
    for (int r = gtid; r < nrows; r += nthr) { float s = 0.f;
#pragma unroll
        for (int j = 0; j < 8; ++j) { const f32x4 p = ps[(size_t)r * 8 + j]; s += (p.x + p.y) + (p.z + p.w); }
        rs[r] = 1.f / sqrtf(s * (1.f / D) + EPS); }
}
__device__ __forceinline__ void shw_rows(const PA& a, int l, int shidx, const bf16* W, int N, float* out, const float* bias, LAS unsigned char* lds, int tid, int gw, int NGW) {
    LAS float* sh = (LAS float*)lds; const int lane = tid & 63;
    const float* mv = (const float*)(a.ws() + WS_MOD) + (size_t)l * 5 * 12288 + shidx * D;
    __syncthreads();
    { float t20[20];
#pragma unroll
      for (int j = 0; j < 20; ++j) { const int i = tid + 512 * j; t20[j] = mv[(size_t)(i >> 11) * 12288 + (i & 2047)]; }
#pragma unroll
      for (int j = 0; j < 20; ++j) sh[tid + 512 * j] = t20[j]; }
    __syncthreads();
    for (int n = gw; n < N; n += NGW) { float acc[5] = {0.f, 0.f, 0.f, 0.f, 0.f};
#pragma unroll
        for (int j = 0; j < 4; ++j) { const int k0 = j * 512 + lane * 8; const u32x4 x = *(const u32x4*)(W + (size_t)n * D + k0);
            const float wv[8] = {bflo(x.x), bfhi(x.x), bflo(x.y), bfhi(x.y), bflo(x.z), bfhi(x.z), bflo(x.w), bfhi(x.w)};
#pragma unroll
            for (int s = 0; s < 5; ++s) { const f32x4 h0 = *(const LAS f32x4*)(sh + s * 2048 + k0), h1 = *(const LAS f32x4*)(sh + s * 2048 + k0 + 4);
                acc[s] += (wv[0] * h0.x + wv[1] * h0.y) + (wv[2] * h0.z + wv[3] * h0.w) + (wv[4] * h1.x + wv[5] * h1.y) + (wv[6] * h1.z + wv[7] * h1.w); } }
        const float bn = bias ? bias[n] : 0.f;
#pragma unroll
        for (int s = 0; s < 5; ++s) { const float t = wave_sum(acc[s]); if (lane == 0) out[(size_t)s * N + n] = t + bn; } }
    __syncthreads();
}

__device__ __forceinline__ void neutral_norm1(const PA& a, int gtid, int nthr) {
    float* rs1 = (float*)(a.ws() + WS_RS1); float* si = (float*)(a.ws() + WS_SHWIN); float* sg = (float*)(a.ws() + WS_SHWG); const float* bg = a.in(I_BGATE);
    for (int i = gtid; i < NTOK; i += nthr) rs1[i] = 1.f;
    for (int i = gtid; i < 5 * INC; i += nthr) si[i] = 0.f;
    for (int i = gtid; i < 5 * DFF; i += nthr) sg[i] = bg[i % DFF];
}

using pg8::Unit;
#define EPI_LOOP _Pragma("unroll") for (int ai = 0; ai < 2; ++ai) _Pragma("unroll") for (int m = 0; m < 4; ++m) _Pragma("unroll") for (int bj = 0; bj < 2; ++bj)

struct EpiInProj {
    static constexpr bool PERM = true, AFTER_DRAIN = false;
    bf16 *ga, *yb, *q, *k, *vT, *vcT, *u; const f32x2* rope; const float* rs; const float* shw;
    __device__ __forceinline__ void operator()(const f32x4 (&acc)[2][2][4][2], const Unit& un, int wr, int wc, int fr, int fq) const {
        const int pn = un.pn, rbase = un.pm * 256 + wr * 64 + fr, cw = wc * 32 + 8 * fq;
        const bool lat = un.pm < (NLAT / 256);
        const float* sw = shw + (size_t)(lat ? (un.pm >> 5) : 4) * INC + pn * 256 + cw;
        f32x4 s0[2], s1[2]; float rr[2][4];
#pragma unroll
        for (int bj = 0; bj < 2; ++bj) { s0[bj] = *(const f32x4*)(sw + bj * 128); s1[bj] = *(const f32x4*)(sw + bj * 128 + 4); }
#pragma unroll
        for (int ai = 0; ai < 2; ++ai)
#pragma unroll
            for (int m = 0; m < 4; ++m) rr[ai][m] = rs[rbase + ai * 128 + m * 16];
        const bool ropetile = lat && pn >= 8 && pn <= 10; const int pih_ = cw & 63, half_ = pih_ >> 5, i0_ = (pih_ & 31) >> 1;
#pragma unroll
        for (int ai = 0; ai < 2; ++ai) {
        f32x4 rp[4][2];
        if (ropetile) {
#pragma unroll
            for (int m = 0; m < 4; ++m) { const int t = (rbase + ai * 128 + m * 16) & (SEQ - 1), pos = half_ ? (t & 63) : (t >> 6); const f32x4* rq = (const f32x4*)(rope + pos * 16 + i0_); rp[m][0] = rq[0]; rp[m][1] = rq[1]; } }
#pragma unroll
        for (int m = 0; m < 4; ++m)
#pragma unroll
        for (int bj = 0; bj < 2; ++bj) {
            const int row = rbase + ai * 128 + m * 16; const int ct = bj * 128 + cw;
            const f32x4 v0 = acc[ai][bj][m][0] * rr[ai][m] + s0[bj], v1 = acc[ai][bj][m][1] * rr[ai][m] + s1[bj];
            if (pn < 4) {
                u32x4 w; w.x = pk2(gelu_tanh(v0.x), gelu_tanh(v0.y)); w.y = pk2(gelu_tanh(v0.z), gelu_tanh(v0.w)); w.z = pk2(gelu_tanh(v1.x), gelu_tanh(v1.y)); w.w = pk2(gelu_tanh(v1.z), gelu_tanh(v1.w));
                *(u32x4*)(ga + (size_t)row * 1024 + pn * 256 + ct) = w;
            } else if (pn < 8) {
                u32x2 w; w.x = pk2(v0.x * sigmoidf_(v0.y), v0.z * sigmoidf_(v0.w)); w.y = pk2(v1.x * sigmoidf_(v1.y), v1.z * sigmoidf_(v1.w));
                *(u32x2*)(yb + (size_t)row * 512 + (((pn - 4) * 256 + ct) >> 1)) = w;
            } else if (pn < 10 || (pn == 10 && bj == 0)) {
                const bool isq = pn < 10; const int cs = isq ? (pn - 8) * 256 + ct : ct;
                float x[8] = {v0.x, v0.y, v0.z, v0.w, v1.x, v1.y, v1.z, v1.w};
                if (lat) { const f32x4 ra = rp[m][0], rb = rp[m][1]; const float cc[4] = {ra.x, ra.z, rb.x, rb.z}, sn[4] = {ra.y, ra.w, rb.y, rb.w};
#pragma unroll
                    for (int jj = 0; jj < 4; ++jj) { const float x1 = x[2 * jj], x2 = x[2 * jj + 1]; x[2 * jj] = x1 * cc[jj] - x2 * sn[jj]; x[2 * jj + 1] = x1 * sn[jj] + x2 * cc[jj]; } }
                const float sc = isq ? QSCALE : 1.f;
                u32x4 w; w.x = pk2(x[0] * sc, x[1] * sc); w.y = pk2(x[2] * sc, x[3] * sc); w.z = pk2(x[4] * sc, x[5] * sc); w.w = pk2(x[6] * sc, x[7] * sc);
                if (isq) *(u32x4*)(q + (size_t)row * 512 + cs) = w; else *(u32x4*)(k + (size_t)row * 128 + cs) = w;
            } else if (pn == 10) {
                const int dc = ct - 128; const float x[8] = {v0.x, v0.y, v0.z, v0.w, v1.x, v1.y, v1.z, v1.w};
                if (lat) { const int b = row >> 13, t = row & (SEQ - 1);
#pragma unroll
                    for (int e = 0; e < 8; ++e) vT[((size_t)(b * 128 + dc + e)) * SEQ + t] = (bf16)f2bf(x[e]); }
                else { const int rc = row - NLAT, b = rc >> 8, t = rc & 255;
#pragma unroll
                    for (int e = 0; e < 8; ++e) vcT[((size_t)(b * 128 + dc + e)) * CTXL + t] = (bf16)f2bf(x[e]); }
            } else {
                u32x4 w; w.x = pk2(v0.x, v0.y); w.y = pk2(v0.z, v0.w); w.z = pk2(v1.x, v1.y); w.w = pk2(v1.z, v1.w);
                const int col = (pn - 11) * 256 + ct;
                *(u32x4*)(u + ((size_t)(col >> 4) * NTOK + row) * 16 + (col & 15)) = w;
            }
        } }
    }
};
struct EpiGlu {
    static constexpr bool PERM = true, AFTER_DRAIN = false;
    bf16* o;
    __device__ __forceinline__ void operator()(const f32x4 (&acc)[2][2][4][2], const Unit& un, int wr, int wc, int fr, int fq) const {
        const int rbase = un.pm * 256 + wr * 64 + fr, cw = un.pn * 256 + wc * 32 + 8 * fq;
        EPI_LOOP { const int row = rbase + ai * 128 + m * 16; const f32x4 v0 = acc[ai][bj][m][0], v1 = acc[ai][bj][m][1];
            u32x2 w; w.x = pk2(v0.x * sigmoidf_(v0.y), v0.z * sigmoidf_(v0.w)); w.y = pk2(v1.x * sigmoidf_(v1.y), v1.z * sigmoidf_(v1.w));
            *(u32x2*)(o + (size_t)row * 512 + ((cw + bj * 128) >> 1)) = w; }
    }
};
template <int ACT  > struct EpiAct {
    static constexpr bool PERM = true, AFTER_DRAIN = false;
    bf16* o; const float* bias; int ldc, pad;
    __device__ __forceinline__ void operator()(const f32x4 (&acc)[2][2][4][2], const Unit& un, int wr, int wc, int fr, int fq) const {
        const int rbase = un.pm * 256 + wr * 64 + fr, cw = un.pn * 256 + wc * 32 + 8 * fq;
        f32x4 b0[2], b1[2];
#pragma unroll
        for (int bj = 0; bj < 2; ++bj) { b0[bj] = ACT == 0 ? *(const f32x4*)(bias + cw + bj * 128) : (f32x4){0.f, 0.f, 0.f, 0.f}; b1[bj] = ACT == 0 ? *(const f32x4*)(bias + cw + bj * 128 + 4) : (f32x4){0.f, 0.f, 0.f, 0.f}; }
        EPI_LOOP { const int row = rbase + ai * 128 + m * 16, col = cw + bj * 128; f32x4 v0 = acc[ai][bj][m][0], v1 = acc[ai][bj][m][1];
            if (ACT == 0) { v0 += b0[bj]; v1 += b1[bj];
                v0 = (f32x4){sigmoidf_(v0.x), sigmoidf_(v0.y), sigmoidf_(v0.z), sigmoidf_(v0.w)}; v1 = (f32x4){sigmoidf_(v1.x), sigmoidf_(v1.y), sigmoidf_(v1.z), sigmoidf_(v1.w)}; }
            else { v0 = __builtin_elementwise_max(v0, (f32x4){0.f, 0.f, 0.f, 0.f}); v1 = __builtin_elementwise_max(v1, (f32x4){0.f, 0.f, 0.f, 0.f}); v0 = v0 * v0; v1 = v1 * v1; }
            u32x4 w; w.x = pk2(v0.x, v0.y); w.y = pk2(v0.z, v0.w); w.z = pk2(v1.x, v1.y); w.w = pk2(v1.z, v1.w);
            *(u32x4*)(o + (size_t)row * ldc + col) = w; }
    }
};
struct EpiGate {
    static constexpr bool PERM = true, AFTER_DRAIN = false;
    bf16* o; const float* rs; const float* shw;
    __device__ __forceinline__ void operator()(const f32x4 (&acc)[2][2][4][2], const Unit& un, int wr, int wc, int fr, int fq) const {
        const int rbase = un.pm * 256 + wr * 64 + fr, cw = un.pn * 256 + wc * 32 + 8 * fq;
        const int slot = un.pm < (NLAT / 256) ? (un.pm >> 5) : 4; const float* sw = shw + (size_t)slot * DFF;
        f32x4 s0[2], s1[2]; float rr[2][4];
#pragma unroll
        for (int bj = 0; bj < 2; ++bj) { s0[bj] = *(const f32x4*)(sw + cw + bj * 128); s1[bj] = *(const f32x4*)(sw + cw + bj * 128 + 4); }
#pragma unroll
        for (int ai = 0; ai < 2; ++ai)
#pragma unroll
            for (int m = 0; m < 4; ++m) rr[ai][m] = rs[rbase + ai * 128 + m * 16];
        EPI_LOOP { const int row = rbase + ai * 128 + m * 16, col = cw + bj * 128; const float r = rr[ai][m];
            f32x4 v0 = acc[ai][bj][m][0] * r + s0[bj], v1 = acc[ai][bj][m][1] * r + s1[bj];
            v0 = (f32x4){sigmoidf_(v0.x), sigmoidf_(v0.y), sigmoidf_(v0.z), sigmoidf_(v0.w)}; v1 = (f32x4){sigmoidf_(v1.x), sigmoidf_(v1.y), sigmoidf_(v1.z), sigmoidf_(v1.w)};
            u32x4 w; w.x = pk2(v0.x, v0.y); w.y = pk2(v0.z, v0.w); w.z = pk2(v1.x, v1.y); w.w = pk2(v1.z, v1.w);
            *(u32x4*)(o + (size_t)row * DFF + col) = w; }
    }
};
struct EpiMerge {
    static constexpr bool PERM = true, AFTER_DRAIN = false;
    const bf16* gate; bf16* mg;
    __device__ __forceinline__ void operator()(const f32x4 (&acc)[2][2][4][2], const Unit& un, int wr, int wc, int fr, int fq) const {
        const int rbase = un.pm * 256 + wr * 64 + fr, cw = un.pn * 256 + wc * 32 + 8 * fq, kb = un.kb;
#pragma unroll
        for (int ai = 0; ai < 2; ++ai) {
            u32x4 ga_[4][2], pa_[4][2];
#pragma unroll
            for (int m = 0; m < 4; ++m)
#pragma unroll
                for (int bj = 0; bj < 2; ++bj) { const int row = rbase + ai * 128 + m * 16, col = cw + bj * 128; ga_[m][bj] = *(const u32x4*)(gate + (size_t)row * DFF + kb * D + col);
                    pa_[m][bj] = kb > 0 ? *(const u32x4*)(mg + (size_t)row * D + col) : (u32x4){0u, 0u, 0u, 0u}; }
#pragma unroll
            for (int m = 0; m < 4; ++m)
#pragma unroll
                for (int bj = 0; bj < 2; ++bj) { const int row = rbase + ai * 128 + m * 16, col = cw + bj * 128; const f32x4 v0 = acc[ai][bj][m][0], v1 = acc[ai][bj][m][1]; const u32x4 gw = ga_[m][bj], pm = pa_[m][bj];
                    const f32x4 r0 = (f32x4){bflo(gw.x) * v0.x, bfhi(gw.x) * v0.y, bflo(gw.y) * v0.z, bfhi(gw.y) * v0.w} + (f32x4){bflo(pm.x), bfhi(pm.x), bflo(pm.y), bfhi(pm.y)};
                    const f32x4 r1 = (f32x4){bflo(gw.z) * v1.x, bfhi(gw.z) * v1.y, bflo(gw.w) * v1.z, bfhi(gw.w) * v1.w} + (f32x4){bflo(pm.z), bfhi(pm.z), bflo(pm.w), bfhi(pm.w)};
                    u32x4 w; w.x = pk2(r0.x, r0.y); w.y = pk2(r0.z, r0.w); w.z = pk2(r1.x, r1.y); w.w = pk2(r1.z, r1.w); *(u32x4*)(mg + (size_t)row * D + col) = w; } }
    }
};
struct EpiResidN {
    static constexpr bool PERM = true, AFTER_DRAIN = false;
    const float *srcl, *srcc; float *dstl, *dstc; const float* modg; bf16* xg; const float* ng2; const float* sc2; float* ps;
    __device__ __forceinline__ void operator()(const f32x4 (&acc)[2][2][4][2], const Unit& un, int wr, int wc, int fr_, int fq_) const {
        const int ln_ = lane_fresh(), fr = ln_ & 15, fq = ln_ >> 4; (void)fr_; (void)fq_;
        const int rbase = un.pm * 256 + wr * 64 + fr, cw = un.pn * 256 + wc * 32 + 8 * fq;
        const bool lat = un.pm < (NLAT / 256);
        const int slot = lat ? (un.pm >> 5) : 4;
        const float* src = lat ? srcl : srcc; float* dst = lat ? dstl : dstc; const int radj = lat ? 0 : NLAT;
        const float* gp = modg + (size_t)slot * 12288; const float* sp2 = sc2 + (size_t)slot * 12288;
        float ssq[2][4];
#pragma unroll
        for (int ai = 0; ai < 2; ++ai)
#pragma unroll
            for (int m = 0; m < 4; ++m) ssq[ai][m] = 0.f;
        f32x4 g0[2], g1[2], y0s[2], y1s[2];
#pragma unroll
        for (int bj = 0; bj < 2; ++bj) { const int col = cw + bj * 128; g0[bj] = *(const f32x4*)(gp + col); g1[bj] = *(const f32x4*)(gp + col + 4);
            y0s[bj] = *(const f32x4*)(ng2 + col) * (*(const f32x4*)(sp2 + col) + 1.f); y1s[bj] = *(const f32x4*)(ng2 + col + 4) * (*(const f32x4*)(sp2 + col + 4) + 1.f); }
#pragma unroll
        for (int ai = 0; ai < 2; ++ai) {
            f32x4 xa[4][2][2];
#pragma unroll
            for (int m = 0; m < 4; ++m)
#pragma unroll
                for (int bj = 0; bj < 2; ++bj) { const float* sp = src + (size_t)(rbase + ai * 128 + m * 16 - radj) * D + cw + bj * 128; xa[m][bj][0] = *(const f32x4*)sp; xa[m][bj][1] = *(const f32x4*)(sp + 4); }
#pragma unroll
            for (int m = 0; m < 4; ++m)
#pragma unroll
                for (int bj = 0; bj < 2; ++bj) { const int row = rbase + ai * 128 + m * 16, col = cw + bj * 128; const f32x4 v0 = acc[ai][bj][m][0], v1 = acc[ai][bj][m][1];
                    float* dp = dst + (size_t)(row - radj) * D + col;
                    const f32x4 x0 = xa[m][bj][0] + g0[bj] * v0, x1 = xa[m][bj][1] + g1[bj] * v1;
                    *(f32x4*)dp = x0; *(f32x4*)(dp + 4) = x1;
                    ssq[ai][m] += (x0.x * x0.x + x0.y * x0.y) + (x0.z * x0.z + x0.w * x0.w) + (x1.x * x1.x + x1.y * x1.y) + (x1.z * x1.z + x1.w * x1.w);
                    const f32x4 y0 = x0 * y0s[bj], y1 = x1 * y1s[bj];
                    u32x4 w; w.x = pk2(y0.x, y0.y); w.y = pk2(y0.z, y0.w); w.z = pk2(y1.x, y1.y); w.w = pk2(y1.z, y1.w); *(u32x4*)(xg + (size_t)row * D + col) = w; } }
#pragma unroll
        for (int ai = 0; ai < 2; ++ai)
#pragma unroll
            for (int m = 0; m < 4; ++m) { float s = ssq[ai][m]; s += shx<16>(s); s += shx<32>(s);
                if (fq == 0) ps[((size_t)(rbase + ai * 128 + m * 16) * 8 + un.pn) * 4 + wc] = s; }
    }
};
struct EpiFfn1 {
    static constexpr bool PERM = true, AFTER_DRAIN = false;
    bf16* o; const float* rs; const float* shw;
    __device__ __forceinline__ void operator()(const f32x4 (&acc)[2][2][4][2], const Unit& un, int wr, int wc, int fr, int fq) const {
        const int rbase = un.pm * 256 + wr * 64 + fr, cw = un.pn * 256 + wc * 32 + 8 * fq;
        const int slot = un.pm < (NLAT / 256) ? (un.pm >> 5) : 4; const float* sw = shw + (size_t)slot * DFF;
        f32x4 s0[2], s1[2]; float rr[2][4];
#pragma unroll
        for (int bj = 0; bj < 2; ++bj) { s0[bj] = *(const f32x4*)(sw + cw + bj * 128); s1[bj] = *(const f32x4*)(sw + cw + bj * 128 + 4); }
#pragma unroll
        for (int ai = 0; ai < 2; ++ai)
#pragma unroll
            for (int m = 0; m < 4; ++m) rr[ai][m] = rs[rbase + ai * 128 + m * 16];
        EPI_LOOP { const int row = rbase + ai * 128 + m * 16, col = cw + bj * 128; const float r = rr[ai][m];
            f32x4 v0 = acc[ai][bj][m][0] * r + s0[bj], v1 = acc[ai][bj][m][1] * r + s1[bj];
            v0 = __builtin_elementwise_max(v0, (f32x4){0.f, 0.f, 0.f, 0.f}); v1 = __builtin_elementwise_max(v1, (f32x4){0.f, 0.f, 0.f, 0.f}); v0 = v0 * v0; v1 = v1 * v1;
            u32x4 w; w.x = pk2(v0.x, v0.y); w.y = pk2(v0.z, v0.w); w.z = pk2(v1.x, v1.y); w.w = pk2(v1.z, v1.w);
            *(u32x4*)(o + (size_t)row * DFF + col) = w; }
    }
};
struct EpiPart {
    static constexpr bool PERM = true, AFTER_DRAIN = false;
    float* part;
    __device__ __forceinline__ void operator()(const f32x4 (&acc)[2][2][4][2], const Unit& un, int wr, int wc, int fr, int fq) const {
        const int rbase = un.pm * 256 + wr * 64 + fr - NLAT, cw = un.pn * 256 + wc * 32 + 8 * fq;
        float* pb = part + (size_t)un.kb * NCTX * D;
        EPI_LOOP { const int row = rbase + ai * 128 + m * 16, col = cw + bj * 128; float* dp = pb + (size_t)row * D + col; *(f32x4*)dp = acc[ai][bj][m][0]; *(f32x4*)(dp + 4) = acc[ai][bj][m][1]; }
    }
};
struct EpiResid {
    static constexpr bool PERM = true, AFTER_DRAIN = false;
    const float *srcl, *srcc; float *dstl, *dstc; const float* modg;
    __device__ __forceinline__ void operator()(const f32x4 (&acc)[2][2][4][2], const Unit& un, int wr, int wc, int fr, int fq) const {
        const int rbase = un.pm * 256 + wr * 64 + fr, cw = un.pn * 256 + wc * 32 + 8 * fq;
        const bool lat = un.pm < (NLAT / 256);
        const int slot = lat ? (un.pm >> 5) : 4;
        const float* src = lat ? srcl : srcc; float* dst = lat ? dstl : dstc; const int radj = lat ? 0 : NLAT;
        const float* gp = modg + (size_t)slot * 12288;
        f32x4 g0[2], g1[2];
#pragma unroll
        for (int bj = 0; bj < 2; ++bj) { g0[bj] = *(const f32x4*)(gp + cw + bj * 128); g1[bj] = *(const f32x4*)(gp + cw + bj * 128 + 4); }
#pragma unroll
        for (int ai = 0; ai < 2; ++ai) {
            f32x4 xa[4][2][2];
#pragma unroll
            for (int m = 0; m < 4; ++m)
#pragma unroll
                for (int bj = 0; bj < 2; ++bj) { const float* sp = src + (size_t)(rbase + ai * 128 + m * 16 - radj) * D + cw + bj * 128; xa[m][bj][0] = *(const f32x4*)sp; xa[m][bj][1] = *(const f32x4*)(sp + 4); }
#pragma unroll
            for (int m = 0; m < 4; ++m)
#pragma unroll
                for (int bj = 0; bj < 2; ++bj) { float* dp = dst + (size_t)(rbase + ai * 128 + m * 16 - radj) * D + cw + bj * 128;
                    *(f32x4*)dp = xa[m][bj][0] + g0[bj] * acc[ai][bj][m][0]; *(f32x4*)(dp + 4) = xa[m][bj][1] + g1[bj] * acc[ai][bj][m][1]; } }
    }
};

#define MFMA16(a, b, c) __builtin_amdgcn_mfma_f32_16x16x32_bf16((a), (b), (c), 0, 0, 0)
#define WAVE_LDS_SYNC() asm volatile("s_waitcnt lgkmcnt(0)" ::: "memory")
__device__ __forceinline__ void gmlp_unit(const PA& a, int l, int ch, LAS unsigned char* lds, int tid) {
    const int lane = tid & 63, w = tid >> 6, fr = lane & 15, kg = lane >> 4;
    LAS f32x2* st = (LAS f32x2*)lds; LAS bf16* vt = (LAS bf16*)(lds + 1024); LAS bf16* wsl = (LAS bf16*)(lds + 35840);
    const bf16* GA = (const bf16*)(a.ws() + WS_GA); bf16* BRA = (bf16*)(a.ws() + WS_BR); const bf16* GWS = (const bf16*)(a.ws() + WS_GWS);
    const float* lng = a.in(I_GLNG) + l * DB; const float* lnb = a.in(I_GLNB) + l * DB; const float* bs = a.in(I_GBS) + l * 512;
    const int row0 = ch * 128;
#pragma unroll 1
    for (int rr0 = 0; rr0 < 16; rr0 += 4) {
        float f[4][8], mean[4], rstd[4];
#pragma unroll
        for (int k = 0; k < 4; ++k) { const u32x4 x = *(const u32x4*)(GA + (size_t)(row0 + w * 16 + rr0 + k) * 1024 + 512 + lane * 8);
            f[k][0] = bflo(x.x); f[k][1] = bfhi(x.x); f[k][2] = bflo(x.y); f[k][3] = bfhi(x.y); f[k][4] = bflo(x.z); f[k][5] = bfhi(x.z); f[k][6] = bflo(x.w); f[k][7] = bfhi(x.w); }
#pragma unroll
        for (int k = 0; k < 4; ++k) { float s = 0.f;
#pragma unroll
            for (int e = 0; e < 8; ++e) s += f[k][e];
            mean[k] = wave_sum(s) * (1.f / 512.f); }
#pragma unroll
        for (int k = 0; k < 4; ++k) { float s2 = 0.f;
#pragma unroll
            for (int e = 0; e < 8; ++e) { const float d = f[k][e] - mean[k]; s2 += d * d; }
            rstd[k] = 1.f / sqrtf(wave_sum(s2) * (1.f / 512.f) + EPS); }
        if (lane == 0) {
#pragma unroll
            for (int k = 0; k < 4; ++k) st[w * 16 + rr0 + k] = (f32x2){mean[k], rstd[k]}; } }
    __syncthreads();
    for (int g = 0; g < 4; ++g) {
        { const int q = tid >> 2, cs = (tid & 3) * 32; const f32x2 ms = st[q];
#pragma unroll
            for (int k4 = 0; k4 < 4; ++k4) { const int c0 = cs + k4 * 8; const u32x4 x = *(const u32x4*)(GA + (size_t)(row0 + q) * 1024 + 512 + g * 128 + c0);
                const float f[8] = {bflo(x.x), bfhi(x.x), bflo(x.y), bfhi(x.y), bflo(x.z), bfhi(x.z), bflo(x.w), bfhi(x.w)};
                const f32x4 g0 = *(const f32x4*)(lng + g * 128 + c0), g1 = *(const f32x4*)(lng + g * 128 + c0 + 4), b0 = *(const f32x4*)(lnb + g * 128 + c0), b1 = *(const f32x4*)(lnb + g * 128 + c0 + 4);
                const float gg[8] = {g0.x, g0.y, g0.z, g0.w, g1.x, g1.y, g1.z, g1.w}, bb[8] = {b0.x, b0.y, b0.z, b0.w, b1.x, b1.y, b1.z, b1.w};
#pragma unroll
                for (int e = 0; e < 8; ++e) vt[(c0 + e) * 136 + q] = (bf16)f2bf((f[e] - ms.x) * ms.y * gg[e] + bb[e]); }
#pragma unroll
            for (int i = 0; i < 4; ++i) { const int c = tid + 512 * i, p = c >> 4, q8 = (c & 15) * 8;
                *(LAS u32x4*)(wsl + p * 136 + q8) = *(const u32x4*)(GWS + (size_t)(g * 128 + p) * 128 + q8); } }
        __syncthreads();
        f32x4 acc[8];
#pragma unroll
        for (int pt = 0; pt < 8; ++pt) acc[pt] = (f32x4){0.f, 0.f, 0.f, 0.f};
#pragma unroll
        for (int ks = 0; ks < 4; ++ks) { const bf16x8 afr = *(const LAS bf16x8*)(vt + (16 * w + fr) * 136 + ks * 32 + kg * 8);
#pragma unroll
            for (int pt = 0; pt < 8; ++pt) { const bf16x8 bfr = *(const LAS bf16x8*)(wsl + (pt * 16 + fr) * 136 + ks * 32 + kg * 8); acc[pt] = MFMA16(afr, bfr, acc[pt]); } }
        const int c0 = g * 128 + 16 * w + kg * 4;
        u32x2 uxs[8]; float bsps[8];
#pragma unroll
        for (int pt = 0; pt < 8; ++pt) { const int p = pt * 16 + fr; uxs[pt] = *(const u32x2*)(GA + (size_t)(row0 + p) * 1024 + c0); bsps[pt] = bs[g * 128 + p]; }
#pragma unroll
        for (int pt = 0; pt < 8; ++pt) { const int p = pt * 16 + fr; const u32x2 ux = uxs[pt]; const float bsp = bsps[pt];
            *(u32x2*)(BRA + (size_t)(row0 + p) * 512 + c0) = (u32x2){pk2(bflo(ux.x) * (acc[pt].x + bsp), bfhi(ux.x) * (acc[pt].y + bsp)), pk2(bflo(ux.y) * (acc[pt].z + bsp), bfhi(ux.y) * (acc[pt].w + bsp))}; }
        __syncthreads();
    }
}
__device__ __forceinline__ void conv_unit(const PA& a, int l, int un, LAS unsigned char* lds, int tid) {
    LAS float* ybuf = (LAS float*)lds;
    const bf16* YB = (const bf16*)(a.ws() + WS_YB); bf16* BRB = (bf16*)(a.ws() + WS_BR) + (size_t)NTOK * 512;
    const int lane = tid & 63, w = tid >> 6;
    const int t0 = un * 32; int s0, s1;
    if (t0 < NLAT) { s0 = t0 & ~(SEQ - 1); s1 = s0 + SEQ; } else { s0 = NLAT + ((t0 - NLAT) & ~(CTXL - 1)); s1 = s0 + CTXL; }
    const int cp = tid & 255, half = tid >> 8, rb = t0 + half * 16 - 15;
    const float* cw = a.in(I_CW) + (size_t)l * 31 * 512 + 2 * cp;
    f32x2 wt[31];
#pragma unroll
    for (int i = 0; i < 31; ++i) wt[i] = *(const f32x2*)(cw + i * 512);
    f32x2 o[16];
#pragma unroll
    for (int j = 0; j < 16; ++j) o[j] = (f32x2){0.f, 0.f};
    unsigned xin[46];
#pragma unroll
    for (int r = 0; r < 46; ++r) { const int row = rb + r, rc = row < s0 ? s0 : (row >= s1 ? s1 - 1 : row); xin[r] = *(const unsigned*)(YB + (size_t)rc * 512 + 2 * cp); }
#pragma unroll
    for (int r = 0; r < 46; ++r) { const int row = rb + r; const unsigned x = (row >= s0 && row < s1) ? xin[r] : 0u; const f32x2 v = (f32x2){bflo(x), bfhi(x)};
#pragma unroll
        for (int j = 0; j < 16; ++j) if (r - j >= 0 && r - j <= 30) o[j] += wt[r - j] * v; }
    const f32x2 cb = *(const f32x2*)(a.in(I_CB) + l * 512 + 2 * cp);
#pragma unroll
    for (int j = 0; j < 16; ++j) *(LAS f32x2*)(ybuf + (half * 16 + j) * 512 + 2 * cp) = o[j] + cb;
    __syncthreads();
    const float* lg = a.in(I_CLNG) + l * 512 + lane * 8; const float* lb = a.in(I_CLNB) + l * 512 + lane * 8;
    { float f[4][8], mean[4], rstd[4];
#pragma unroll
        for (int tt = 0; tt < 4; ++tt) { const int tok = 4 * w + tt; const f32x4 p0 = *(const LAS f32x4*)(ybuf + tok * 512 + lane * 8), p1 = *(const LAS f32x4*)(ybuf + tok * 512 + lane * 8 + 4);
            f[tt][0] = p0.x; f[tt][1] = p0.y; f[tt][2] = p0.z; f[tt][3] = p0.w; f[tt][4] = p1.x; f[tt][5] = p1.y; f[tt][6] = p1.z; f[tt][7] = p1.w; }
#pragma unroll
        for (int tt = 0; tt < 4; ++tt) { float s = 0.f;
#pragma unroll
            for (int e = 0; e < 8; ++e) s += f[tt][e];
            mean[tt] = wave_sum(s) * (1.f / 512.f); }
#pragma unroll
        for (int tt = 0; tt < 4; ++tt) { float s2 = 0.f;
#pragma unroll
            for (int e = 0; e < 8; ++e) { f[tt][e] -= mean[tt]; s2 += f[tt][e] * f[tt][e]; }
            rstd[tt] = 1.f / sqrtf(wave_sum(s2) * (1.f / 512.f) + EPS); }
        float lgv[8], lbv[8];
#pragma unroll
        for (int e = 0; e < 8; ++e) { lgv[e] = lg[e]; lbv[e] = lb[e]; }
#pragma unroll
        for (int tt = 0; tt < 4; ++tt) { float y[8];
#pragma unroll
            for (int e = 0; e < 8; ++e) y[e] = siluf_(f[tt][e] * rstd[tt] * lgv[e] + lbv[e]);
            u32x4 wv; wv.x = pk2(y[0], y[1]); wv.y = pk2(y[2], y[3]); wv.z = pk2(y[4], y[5]); wv.w = pk2(y[6], y[7]);
            *(u32x4*)(BRB + (size_t)(t0 + 4 * w + tt) * 512 + lane * 8) = wv; } }
    __syncthreads();
}

__device__ __forceinline__ void attn_unit(const PA& a, int l, int unit, LAS unsigned char* lds, int tid) {
    const int lane = tid & 63, w = tid >> 6, fr = lane & 15, kg = lane >> 4;
    LAS bf16* Kt = (LAS bf16*)lds; LAS bf16* Vt = (LAS bf16*)(lds + 18432); LAS bf16* P = (LAS bf16*)(lds + 35840 + w * 8704);
    const bf16* Q = (const bf16*)(a.ws() + WS_Q); const bf16* K = (const bf16*)(a.ws() + WS_K); const bf16* VT = (const bf16*)(a.ws() + WS_VT); const bf16* VCT = (const bf16*)(a.ws() + WS_VCT);
    bf16* BRC = (bf16*)(a.ws() + WS_BR) + (size_t)2 * NTOK * 512;
    int b, qblk, hkv, hp, qrow0; bool isctx;
    if (unit < 1024) { b = unit >> 8; qblk = (unit >> 2) & 63; hkv = (unit >> 1) & 1; hp = unit & 1; isctx = false; qrow0 = b * SEQ + qblk * 128; }
    else { const int uu = unit - 1024; b = uu >> 3; qblk = (uu >> 2) & 1; hkv = (uu >> 1) & 1; hp = uu & 1; isctx = true; qrow0 = NLAT + b * CTXL + qblk * 128; }
    const int hq0 = hkv * 4 + hp * 2;
    const bf16* qp = Q + (size_t)(qrow0 + 16 * w + fr) * 512 + hq0 * 64 + kg * 8;
    bf16x8 qf[2][2]; float mrow[2][4], lp[2][4]; f32x4 o[2][4];
#pragma unroll
    for (int h = 0; h < 2; ++h) { qf[h][0] = *(const bf16x8*)(qp + h * 64); qf[h][1] = *(const bf16x8*)(qp + h * 64 + 32); const float sinkv = a.in(I_SINK)[l * 8 + hq0 + h] * LOG2E;
#pragma unroll
        for (int j = 0; j < 4; ++j) { mrow[h][j] = sinkv; lp[h][j] = (fr == 0) ? 1.f : 0.f; o[h][j] = (f32x4){0.f, 0.f, 0.f, 0.f}; } }
    const int tfirst = isctx ? 3 : (qblk > 0 ? 0 : 1);
    u32x4 kq[2], vq[2];
#define ATT_TILE_PTRS(t, kbase, vbase, vp) do { if ((t) < 3) { const int kb_ = qblk + (t) - 1; kbase = K + (size_t)(b * SEQ + kb_ * 128) * 128 + hkv * 64; vbase = VT + (size_t)((b * 2 + hkv) * 64) * SEQ + kb_ * 128; vp = SEQ; } \
        else { kbase = K + (size_t)(NLAT + b * CTXL + ((t) - 3) * 128) * 128 + hkv * 64; vbase = VCT + (size_t)((b * 2 + hkv) * 64) * CTXL + ((t) - 3) * 128; vp = CTXL; } } while (0)
#define ATT_TILE_LOAD(t) do { const bf16* kb0_; const bf16* vb0_; int vp_; ATT_TILE_PTRS(t, kb0_, vb0_, vp_); \
        _Pragma("unroll") for (int i_ = 0; i_ < 2; ++i_) { const int c_ = tid + 512 * i_; kq[i_] = *(const u32x4*)(kb0_ + (size_t)(c_ >> 3) * 128 + (c_ & 7) * 8); vq[i_] = *(const u32x4*)(vb0_ + (size_t)(c_ >> 4) * vp_ + (c_ & 15) * 8); } } while (0)
    ATT_TILE_LOAD(tfirst);
    for (int t = tfirst; t < 5; ++t) {
        if (t == 2 && !isctx && qblk == 63) continue;
        __syncthreads();
#pragma unroll
        for (int i = 0; i < 2; ++i) { const int c = tid + 512 * i; *(LAS u32x4*)(Kt + (c >> 3) * 72 + (c & 7) * 8) = kq[i]; *(LAS u32x4*)(Vt + (c >> 4) * 136 + (c & 15) * 8) = vq[i]; }
        __syncthreads();
        { int tn = t + 1; if (tn == 2 && !isctx && qblk == 63) tn = 3; if (tn < 5) ATT_TILE_LOAD(tn); }
        {
            f32x4 s[2][8];
#pragma unroll
            for (int nt = 0; nt < 8; ++nt) { const LAS bf16* kp = Kt + (nt * 16 + fr) * 72 + kg * 8;
                const bf16x8 k0 = *(const LAS bf16x8*)kp, k1 = *(const LAS bf16x8*)(kp + 32);
#pragma unroll
                for (int h = 0; h < 2; ++h) { s[h][nt] = MFMA16(qf[h][0], k0, ((f32x4){0.f, 0.f, 0.f, 0.f})); s[h][nt] = MFMA16(qf[h][1], k1, s[h][nt]); } }
#pragma unroll
            for (int h = 0; h < 2; ++h) {
                LAS bf16* Ph = P + h * 2176;
                if (t == 0 || t == 2) {
#pragma unroll
                    for (int nt = 0; nt < 8; ++nt)
#pragma unroll
                        for (int j = 0; j < 4; ++j) { const int qi = 16 * w + kg * 4 + j, ki = nt * 16 + fr; const bool ok = (t == 0) ? (qi <= ki) : (ki <= qi); if (!ok) s[h][nt][j] = -1e30f; } }
                float alpha[4];
#pragma unroll
                for (int j = 0; j < 4; ++j) { float mx = s[h][0][j];
#pragma unroll
                    for (int nt = 1; nt < 8; ++nt) mx = fmaxf(mx, s[h][nt][j]);
                    mx = fmaxf(mx, shx<1>(mx)); mx = fmaxf(mx, shx<2>(mx)); mx = fmaxf(mx, shx<4>(mx)); mx = fmaxf(mx, shx<8>(mx));
                    const float mn = fmaxf(mrow[h][j], mx); alpha[j] = __builtin_amdgcn_exp2f(mrow[h][j] - mn); mrow[h][j] = mn; lp[h][j] *= alpha[j]; }
#pragma unroll
                for (int nt = 0; nt < 8; ++nt)
#pragma unroll
                    for (int j = 0; j < 4; ++j) { const float p = __builtin_amdgcn_exp2f(s[h][nt][j] - mrow[h][j]); lp[h][j] += p; Ph[(kg * 4 + j) * 136 + nt * 16 + fr] = (bf16)f2bf(p); }
#pragma unroll
                for (int dt = 0; dt < 4; ++dt) { o[h][dt][0] *= alpha[0]; o[h][dt][1] *= alpha[1]; o[h][dt][2] *= alpha[2]; o[h][dt][3] *= alpha[3]; }
            }
            WAVE_LDS_SYNC();
#pragma unroll
            for (int ks = 0; ks < 4; ++ks) { const bf16x8 pa0 = *(const LAS bf16x8*)(P + fr * 136 + ks * 32 + kg * 8), pa1 = *(const LAS bf16x8*)(P + 2176 + fr * 136 + ks * 32 + kg * 8);
#pragma unroll
                for (int dt = 0; dt < 4; ++dt) { const bf16x8 vb = *(const LAS bf16x8*)(Vt + (dt * 16 + fr) * 136 + ks * 32 + kg * 8); o[0][dt] = MFMA16(pa0, vb, o[0][dt]); o[1][dt] = MFMA16(pa1, vb, o[1][dt]); } }
            WAVE_LDS_SYNC();
        }
    }
#undef ATT_TILE_LOAD
#undef ATT_TILE_PTRS
#pragma unroll
    for (int h = 0; h < 2; ++h)
#pragma unroll
        for (int j = 0; j < 4; ++j) { float s = lp[h][j]; s += shx<1>(s); s += shx<2>(s); s += shx<4>(s); s += shx<8>(s); const float inv = 1.f / s;
#pragma unroll
            for (int dt = 0; dt < 4; ++dt) BRC[(size_t)(qrow0 + 16 * w + kg * 4 + j) * 512 + (hq0 + h) * 64 + dt * 16 + fr] = (bf16)f2bf(o[h][dt][j] * inv); }
}

__device__ __forceinline__ void s5disc_thread(const PA& a, int idx) {
    const int p = idx & 63, g = (idx >> 6) & 31, dir = (idx >> 11) & 1, l = idx >> 12;
    const double are = a.in(I_ARE)[idx], aim = a.in(I_AIM)[idx], dt = exp((double)a.in(I_LSTEP)[(l * 2 + dir) * 32 + g]);
    const double er = exp(are * dt), lrd = er * cos(aim * dt), lid = er * sin(aim * dt);
    const double den = are * are + aim * aim, cr = ((lrd - 1.0) * are + lid * aim) / den, ci = (lid * are - (lrd - 1.0) * aim) / den;
    float* dsc = (float*)(a.ws() + WS_S5DISC) + (size_t)idx * 34;
    dsc[0] = (float)lrd; dsc[1] = (float)lid;
    const float* bre = a.in(I_BRE) + (size_t)((l * 32 + g) * 64 + p) * 16; const float* bim = a.in(I_BIM) + (size_t)((l * 32 + g) * 64 + p) * 16;
    for (int c = 0; c < 16; ++c) { const double br = bre[c], bi = bim[c]; dsc[2 + c] = (float)(cr * br - ci * bi); dsc[18 + c] = (float)(cr * bi + ci * br); }
}
constexpr int NCHUNK = NTOK / 64;
constexpr size_t S5T_KT = 0, S5T_AS = 65536, S5T_AC = 65536 + 524288, S5T_BYTES = 65536 + 2 * 524288;
constexpr size_t WS_S5T = WS_YF;
constexpr size_t WS_SLOC = WS_S5T + 36 * MiB;
constexpr size_t WS_SIN = WS_SLOC + 18 * MiB;
constexpr size_t WS_LT = WS_SIN + 10 * MiB;
static_assert(WS_LT + 65536 <= WS_END, "S5 scratch inside the map");

__device__ __forceinline__ void s5_tables_unit(const PA& a, int l, int g, LAS unsigned char* lds, int tid) {
    LAS f32x2* pw = (LAS f32x2*)lds; LAS f32x2* Bb = (LAS f32x2*)(lds + 66560); LAS f32x2* Cc = (LAS f32x2*)(lds + 82944); LAS float* K0 = (LAS float*)(lds + 99328);
    unsigned char* tb = a.ws() + WS_S5T + (size_t)g * S5T_BYTES;
    bf16* KT = (bf16*)(tb + S5T_KT); bf16* AS = (bf16*)(tb + S5T_AS); bf16* AC = (bf16*)(tb + S5T_AC);
    if (tid < 128) {
        const int dir = tid >> 6, p = tid & 63, pi = ((l * 2 + dir) * 32 + g) * 64 + p;
        const float* dsc = (const float*)(a.ws() + WS_S5DISC) + (size_t)pi * 34;
        const double lr = dsc[0], li = dsc[1];
        float one_ = 1.f; asm volatile("" : "+v"(one_));
        double pr = (double)one_, pim = 0.0;
        for (int d = 0; d <= 64; ++d) { pw[(dir * 65 + d) * 64 + p] = (f32x2){(float)pr, (float)pim}; const double nr = pr * lr - pim * li, ni = pr * li + pim * lr; pr = nr; pim = ni; }
        ((f32x2*)(a.ws() + WS_LT))[(g * 2 + dir) * 64 + p] = pw[(dir * 65 + 64) * 64 + p];
        for (int c = 0; c < 16; ++c) Bb[(dir * 64 + p) * 16 + c] = (f32x2){dsc[2 + c], dsc[18 + c]};
    } else {
        for (int i = tid - 128; i < 2048; i += 384) { const int dir = i >> 10, o = (i >> 6) & 15, p = i & 63; const size_t ix = (size_t)(((l * 2 + dir) * 32 + g) * 16 + o) * 64 + p;
            Cc[i] = (f32x2){a.in(I_CRE)[ix], a.in(I_CIM)[ix]}; }
    }
    __syncthreads();
    {
        const int dir = tid >> 8, oc = tid & 255, o = oc >> 4, c = oc & 15;
        float K[64];
#pragma unroll
        for (int d = 0; d < 64; ++d) K[d] = 0.f;
        for (int p = 0; p < 64; ++p) { const f32x2 cc = Cc[(dir * 16 + o) * 64 + p], bb = Bb[(dir * 64 + p) * 16 + c]; const float cbr = cc.x * bb.x - cc.y * bb.y, cbi = cc.x * bb.y + cc.y * bb.x;
#pragma unroll
            for (int d = 0; d < 64; ++d) { const f32x2 w = pw[(dir * 65 + d) * 64 + p]; K[d] += cbr * w.x - cbi * w.y; } }
        K0[dir * 256 + oc] = K[0];
#pragma unroll
        for (int d = 1; d < 64; ++d) KT[(size_t)(dir == 0 ? 63 + d : 63 - d) * 256 + oc] = (bf16)f2bf(K[d]);
        __syncthreads();
        if (dir == 0) KT[(size_t)63 * 256 + oc] = (bf16)f2bf(K0[oc] + K0[256 + oc] + (o == c ? a.in(I_S5D)[l * 512 + g * 16 + o] : 0.f));
    }
    for (int it = tid; it < 32768; it += 512) {
        const int ch = it & 1, tau = (it >> 1) & 63, m = (it >> 7) & 127, dir = it >> 14, ri = m >> 6, p = m & 63, e = dir == 0 ? 63 - tau : tau;
        const f32x2 w = pw[(dir * 65 + e) * 64 + p]; float v[8];
#pragma unroll
        for (int j = 0; j < 8; ++j) { const f32x2 bb = Bb[(dir * 64 + p) * 16 + ch * 8 + j]; v[j] = ri ? (w.x * bb.y + w.y * bb.x) : (w.x * bb.x - w.y * bb.y); }
        u32x4 o4; o4.x = pk2(v[0], v[1]); o4.y = pk2(v[2], v[3]); o4.z = pk2(v[4], v[5]); o4.w = pk2(v[6], v[7]);
        *(u32x4*)(AS + (size_t)(dir * 128 + m) * 1024 + tau * 16 + ch * 8) = o4; }
    for (int it = tid; it < 32768; it += 512) {
        const int p8 = it & 7, ri = (it >> 3) & 1, o = (it >> 4) & 15, tau = (it >> 8) & 63, dir = it >> 14, e = dir == 0 ? tau + 1 : 64 - tau; float v[8];
#pragma unroll
        for (int j = 0; j < 8; ++j) { const int p = p8 * 8 + j; const f32x2 cc = Cc[(dir * 16 + o) * 64 + p], w = pw[(dir * 65 + e) * 64 + p]; v[j] = ri ? -(cc.x * w.y + cc.y * w.x) : (cc.x * w.x - cc.y * w.y); }
        u32x4 o4; o4.x = pk2(v[0], v[1]); o4.y = pk2(v[2], v[3]); o4.z = pk2(v[4], v[5]); o4.w = pk2(v[6], v[7]);
        *(u32x4*)(AC + (size_t)(dir * 1024 + tau * 16 + o) * 128 + ri * 64 + p8 * 8) = o4; }
    __syncthreads();
}
constexpr int S5U_PITCH = 2064;
__device__ __forceinline__ void s5_stage_u(const PA& a, int g, int nb, LAS unsigned char* lds, int tid) {
    const unsigned char* src = a.ws() + WS_U + ((size_t)g * NTOK + (size_t)nb * 48 * 64) * 32;
    __syncthreads();
    u32x4 tmp[12];
#pragma unroll
    for (int j = 0; j < 12; ++j) { const unsigned i = (unsigned)tid + 512u * j; tmp[j] = *(const u32x4*)(src + i * 16u); }
#pragma unroll
    for (int j = 0; j < 12; ++j) { const unsigned i = (unsigned)tid + 512u * j; *(LAS u32x4*)(lds + (i >> 7) * S5U_PITCH + (i & 127u) * 16u) = tmp[j]; }
    __syncthreads();
}
__device__ __forceinline__ void s5_state_unit(const PA& a, int unit, LAS unsigned char* lds, int tid) {
    const int lane = tid & 63, w = tid >> 6, fr = lane & 15, kg = lane >> 4;
    const int nb = unit % 11, g = unit / 11;
    s5_stage_u(a, g, nb, lds, tid);
    const bf16* AS = (const bf16*)(a.ws() + WS_S5T + (size_t)g * S5T_BYTES + S5T_AS) + (size_t)(16 * w + fr) * 1024 + kg * 8;
    const LAS unsigned char* ub = lds + fr * S5U_PITCH + (kg >> 1) * 32 + (kg & 1) * 16;
    f32x4 acc[2][3];
#pragma unroll
    for (int d = 0; d < 2; ++d)
#pragma unroll
        for (int nt = 0; nt < 3; ++nt) acc[d][nt] = (f32x4){0.f, 0.f, 0.f, 0.f};
#pragma unroll 4
    for (int ks = 0; ks < 32; ++ks) { const bf16x8 af0 = *(const bf16x8*)(AS + ks * 32), af1 = *(const bf16x8*)(AS + (size_t)128 * 1024 + ks * 32);
#pragma unroll
        for (int nt = 0; nt < 3; ++nt) { const bf16x8 bfr = *(const LAS bf16x8*)(ub + nt * 16 * S5U_PITCH + ks * 64); acc[0][nt] = MFMA16(af0, bfr, acc[0][nt]); acc[1][nt] = MFMA16(af1, bfr, acc[1][nt]); } }
    float* SL = (float*)(a.ws() + WS_SLOC);
#pragma unroll
    for (int d = 0; d < 2; ++d)
#pragma unroll
        for (int nt = 0; nt < 3; ++nt) { const int chunk = nb * 48 + nt * 16 + fr; *(f32x4*)(SL + (size_t)((chunk * 32 + g) * 2 + d) * 128 + 16 * w + kg * 4) = acc[d][nt]; }
}
#define S5C_CHUNK(i) ((i) < 4 ? 512 + b * 4 + (dir == 0 ? (i) : 3 - (i)) : b * 128 + (dir == 0 ? (i) - 4 : 131 - (i)))
#define S5C_LOAD(LR, LI, OFF, I0) _Pragma("unroll") for (int k = 0; k < 12; ++k) { OFF[k] = (size_t)((S5C_CHUNK((I0) + k) * 32 + g) * 2 + dir) * 128; LR[k] = SL[OFF[k] + p]; LI[k] = SL[OFF[k] + 64 + p]; }
#define S5C_FOLD(LR, LI, OFF) _Pragma("unroll") for (int k = 0; k < 12; ++k) { SI[OFF[k] + p] = (bf16)f2bf(sr); SI[OFF[k] + 64 + p] = (bf16)f2bf(si); \
        const float nr = lt.x * sr - lt.y * si + LR[k], ni = lt.x * si + lt.y * sr + LI[k]; sr = nr; si = ni; }
__device__ __forceinline__ void s5_carry_seq(const PA& a, int seq, int lane) {
    const int dir = seq & 1, g = (seq >> 1) & 31, b = seq >> 6, p = lane;
    const f32x2 lt = ((const f32x2*)(a.ws() + WS_LT))[(g * 2 + dir) * 64 + p];
    const float* SL = (const float*)(a.ws() + WS_SLOC); bf16* SI = (bf16*)(a.ws() + WS_SIN);
    float sr = 0.f, si = 0.f;
    float lrA[12], liA[12], lrB[12], liB[12]; size_t offA[12], offB[12];
    S5C_LOAD(lrA, liA, offA, 0)
#pragma unroll 1
    for (int i0 = 0; i0 < 120; i0 += 24) {
        S5C_LOAD(lrB, liB, offB, i0 + 12)
        S5C_FOLD(lrA, liA, offA)
        S5C_LOAD(lrA, liA, offA, i0 + 24)
        S5C_FOLD(lrB, liB, offB)
    }
    S5C_FOLD(lrA, liA, offA)
}
#undef S5C_CHUNK
#undef S5C_LOAD
#undef S5C_FOLD
__device__ __forceinline__ void s5_out_unit(const PA& a, int unit, LAS unsigned char* lds, int tid_) {
    int tid = tid_; asm volatile("" : "+v"(tid));
    const int lane = tid & 63, w = tid >> 6, fr = lane & 15, kg = lane >> 4;
    const int nb = unit % 11, g = unit / 11;
    s5_stage_u(a, g, nb, lds, tid);
    const unsigned char* tb = a.ws() + WS_S5T + (size_t)g * S5T_BYTES;
    const bf16* KT = (const bf16*)(tb + S5T_KT) + (size_t)(8 * w + 63 - (kg >> 1)) * 256 + fr * 16 + (kg & 1) * 8;
    const bf16* AC = (const bf16*)(tb + S5T_AC) + (size_t)(8 * w * 16 + fr) * 128 + kg * 8;
    const LAS unsigned char* ub = lds + fr * S5U_PITCH + (kg >> 1) * 32 + (kg & 1) * 16;
    const bf16* SI = (const bf16*)(a.ws() + WS_SIN) + (size_t)(((nb * 48 + fr) * 32 + g) * 2) * 128 + kg * 8;
    f32x4 acc[8][3];
#pragma unroll
    for (int i = 0; i < 8; ++i)
#pragma unroll
        for (int nt = 0; nt < 3; ++nt) acc[i][nt] = (f32x4){0.f, 0.f, 0.f, 0.f};
    bf16x8 W[8];
#pragma unroll
    for (int j = 0; j < 8; ++j) W[j] = *(const bf16x8*)(KT + j * 256);
#pragma unroll 1
    for (int kk = 0; kk < 8; ++kk) {
#pragma unroll
        for (int u = 0; u < 4; ++u) { const int ks = 4 * kk + u;
            if (ks > 0) { W[(16 - 2 * u) & 7] = *(const bf16x8*)(KT + (-2 * ks) * 256); W[(17 - 2 * u) & 7] = *(const bf16x8*)(KT + (-2 * ks + 1) * 256); }
            bf16x8 bfr[3];
#pragma unroll
            for (int nt = 0; nt < 3; ++nt) bfr[nt] = *(const LAS bf16x8*)(ub + nt * 16 * S5U_PITCH + ks * 64);
#pragma unroll
            for (int i = 0; i < 8; ++i)
#pragma unroll
                for (int nt = 0; nt < 3; ++nt) acc[i][nt] = MFMA16(W[(i + 16 - 2 * u) & 7], bfr[nt], acc[i][nt]); } }
#pragma unroll
    for (int dir = 0; dir < 2; ++dir)
#pragma unroll
        for (int ks = 0; ks < 4; ++ks) { bf16x8 bfr[3];
#pragma unroll
            for (int nt = 0; nt < 3; ++nt) bfr[nt] = *(const bf16x8*)(SI + (size_t)(nt * 16 * 32 * 2 + dir) * 128 + ks * 32);
#pragma unroll
            for (int i = 0; i < 8; ++i) { const bf16x8 af = *(const bf16x8*)(AC + (size_t)(dir * 1024 + i * 16) * 128 + ks * 32);
#pragma unroll
                for (int nt = 0; nt < 3; ++nt) acc[i][nt] = MFMA16(af, bfr[nt], acc[i][nt]); } }
    bf16* YG = (bf16*)(a.ws() + WS_YG);
#pragma unroll
    for (int i = 0; i < 8; ++i)
#pragma unroll
        for (int nt = 0; nt < 3; ++nt) { const int chunk = nb * 48 + nt * 16 + fr; const size_t row = (size_t)chunk * 64 + 8 * w + i; const f32x4 v = acc[i][nt];
            *(u32x2*)(YG + row * 512 + g * 16 + kg * 4) = (u32x2){pk2(gelu_tanh(v.x), gelu_tanh(v.y)), pk2(gelu_tanh(v.z), gelu_tanh(v.w))}; }
}

constexpr int RING_BYTES = 131072, MISC_OFF = RING_BYTES, LDS_BYTES = RING_BYTES + 1024;
#ifndef THIN_GRID
#define THIN_GRID 192
#endif
__device__ unsigned g_bar[64];
__device__ __forceinline__ void grid_barrier_counter(unsigned G) {
    asm volatile("s_waitcnt vmcnt(0)" ::: "memory");
    __syncthreads();
    if (threadIdx.x == 0) {
        __builtin_amdgcn_fence(__ATOMIC_RELEASE, "agent");
        asm volatile("s_waitcnt vmcnt(0)" ::: "memory");
        unsigned* ctr = &g_bar[0]; asm volatile("" : "+s"(ctr));
        const unsigned old = __hip_atomic_fetch_add(ctr, 1u, __ATOMIC_RELAXED, __HIP_MEMORY_SCOPE_AGENT);
        const unsigned target = (old / G + 1u) * G;
        unsigned sp = 0u;
        while ((int)(__hip_atomic_load(ctr, __ATOMIC_RELAXED, __HIP_MEMORY_SCOPE_AGENT) - target) < 0) { __builtin_amdgcn_s_sleep(2); if (++sp > (1u << 24)) break; }
        __builtin_amdgcn_fence(__ATOMIC_ACQUIRE, "agent");
        asm volatile("s_waitcnt vmcnt(0)" ::: "memory");
    }
    __syncthreads();
}
#ifdef USE_XCD_BAR
constexpr int CW_BAR = 4096; constexpr size_t CTL_ZERO_BYTES = 64 * 1024;
static_assert((CW_BAR + XCD_BAR_WORDS) * 4 <= (int)CTL_ZERO_BYTES, "barrier words inside the memset region");
#define GRID_BAR() do { XcdBarrier b_; b_.bar = (unsigned*)(a.ws() + WS_CTL) + CW_BAR; b_.x = xb_xcc_id(); b_.st = MISC + 8; xcd_barrier(b_); } while (0)
#else
#define GRID_BAR() do { int g_ = G0; asm volatile("" : "+s"(g_)); grid_barrier_counter((unsigned)g_); } while (0)
#endif
#define GEMM_PHASE(EpiT, Aptr, Bptr, M_, N_, K_, Eobj) do { pg8::Gemm g_{}; g_.A = (Aptr); g_.Bt = (Bptr); g_.M = (M_); g_.N = (N_); g_.K = (K_); g_.pad = 0; g_.sA = 0; g_.sB = 0; \
    pg8::StaticOrder S_; S_.init((M_), (N_), G, bid); pg8::gemm_phase<EpiT, pg8::StaticOrder, true, true>(ldsL, g_, S_, (Eobj), tid); } while (0)
#define PH_BEGIN int bid = bid0, G = Gsel; asm volatile("" : "+s"(bid), "+s"(G)); const int tid = FRESH_TID(), lane = tid & 63, wave = __builtin_amdgcn_readfirstlane(tid >> 6), gw = bid * 8 + wave, NGW = G * 8; unsigned char* ws = a.ws(); (void)lane; (void)gw; (void)NGW; (void)ws;
#define WSP(T, off) ((T*)(ws + (off)))
#define RUN(REPS, GSEL, ...) _Pragma("unroll 1") for (int rep_ = 0; rep_ < (REPS); ++rep_) { { const int Gsel = (GSEL); if (bid0 < Gsel) { __VA_ARGS__ } } GRID_BAR(); }
#define RUN2(REPS, GT, THINBODY, OTHERBODY) _Pragma("unroll 1") for (int rep_ = 0; rep_ < (REPS); ++rep_) { const int Gt_ = (GT); if (bid0 < Gt_) { const int Gsel = Gt_; THINBODY } else { const int Gsel = Ggemm; const int Gthin_ = Gt_; OTHERBODY } GRID_BAR(); }
#define GATES_EARLY(lo, hi) { PH_BEGIN EpiGate E; E.o = WSP(bf16, WS_G); E.rs = WSP(const float, WS_RS1); E.shw = WSP(const float, WS_SHWG); \
    pg8::Gemm g_{}; g_.A = WSP(const bf16, WS_H); g_.Bt = WSP(const bf16, WS_WG); g_.M = Mrows; g_.N = DFF; g_.K = D; g_.pad = 0; g_.sA = 0; g_.sB = 0; \
    pg8::RangeOrder S_; S_.init(Mrows, DFF, (lo), (hi), G - Gthin_, bid - Gthin_); pg8::gemm_phase<EpiGate, pg8::RangeOrder, true, true>(ldsL, g_, S_, E, tid); }
#ifndef GRID_C
#define GRID_C Gthin
#endif
#ifndef GRID_C2
#define GRID_C2 Gthin
#endif
#if defined(USE_XCD_BAR) && !defined(NO_CARRY_IN_C)
#define CARRY_IN_C 1
constexpr int CW_S5CNT = 8192;
#define CARRY_BLOCK(CB) __syncthreads(); \
    if (tid == 0) { unsigned* bar_ = (unsigned*)(ws + WS_CTL) + CW_BAR; unsigned* c_ = (unsigned*)(ws + WS_CTL) + CW_S5CNT + 64 * l; \
                    XB_SPIN(xb_ld(c_) < 352u, bar_); __builtin_amdgcn_fence(__ATOMIC_ACQUIRE, "agent"); asm volatile("s_waitcnt vmcnt(0)" ::: "memory"); } \
    __syncthreads(); \
    for (int s = (CB) * 8 + wave; s < 256; s += 32 * 8) s5_carry_seq(a, s, lane);
#endif
#ifndef GRID_D
#define GRID_D Gthin
#endif
#ifndef GRID_A
#define GRID_A Gthin
#endif
#ifndef ECR
#define ECR 5
#endif
#ifndef REP_GMLP
#define REP_GMLP 1
#endif
#ifndef REP_CONV
#define REP_CONV 1
#endif
#ifndef REP_ATTN
#define REP_ATTN 1
#endif
#ifndef REP_S5S
#define REP_S5S 1
#endif
#ifndef REP_A
#define REP_A 1
#endif
#ifndef REP_B
#define REP_B 1
#endif
#ifndef REP_C
#define REP_C 1
#endif
#ifndef REP_C2
#define REP_C2 1
#endif
#ifndef REP_D
#define REP_D 1
#endif
#ifndef REP_E
#define REP_E 1
#endif
#ifndef REP_F
#define REP_F 1
#endif
#ifndef REP_H
#define REP_H 1
#endif
#ifndef REP_I
#define REP_I 1
#endif

__global__ void __launch_bounds__(512, 2) mega_fwd(Args args) {
    extern __shared__ __attribute__((aligned(16))) unsigned char lds[];
    LAS unsigned char* ldsL = (LAS unsigned char*)lds;
    const int Ggemm = (int)gridDim.x, Gthin = Ggemm < THIN_GRID ? Ggemm : THIN_GRID;
    const int bid0 = blockIdx.x, G0 = gridDim.x, wave_s = __builtin_amdgcn_readfirstlane((int)threadIdx.x >> 6);
    volatile LAS unsigned* MISC = (volatile LAS unsigned*)(ldsL + MISC_OFF);
    PA a; a.tab = MISC + 64;
#ifdef USE_XCD_BAR
    if (threadIdx.x < 64) MISC[threadIdx.x] = 0u;
#endif
    if (threadIdx.x == 64) {
#pragma unroll
        for (int i = 0; i < 34; ++i) { const unsigned long long v = (unsigned long long)args.in[i]; a.tab[2 * i] = (unsigned)v; a.tab[2 * i + 1] = (unsigned)(v >> 32); }
        { const unsigned long long v = (unsigned long long)args.out; a.tab[68] = (unsigned)v; a.tab[69] = (unsigned)(v >> 32); }
        { const unsigned long long v = (unsigned long long)args.ws; a.tab[70] = (unsigned)v; a.tab[71] = (unsigned)(v >> 32); }
    }
    __syncthreads();
#ifdef USE_XCD_BAR
    { XcdBarrier bar0 = xcd_barrier_post((unsigned*)(a.ws() + WS_CTL) + CW_BAR, MISC + 8); (void)bar0; }
#endif

    RUN(1, Ggemm, { PH_BEGIN prologue_block(a, bid, ldsL, tid); if (bid >= 193 && bid < 193 + 32) s5disc_thread(a, (bid - 193) * 512 + tid); __syncthreads(); }
        { PH_BEGIN convert_layer(a, 0, (LAS float*)ldsL + wave * 32 * 65, gw, NGW, lane, bid * 512 + tid, G * 512); } )
    for (int l = 0; l < DEPTH; ++l) {
        const int Mrows = (l == DEPTH - 1) ? NLAT : NTOK;
        const int cb_ = (Ggemm - GRID_C >= 32) ? GRID_C : 0;
        const int eC = ECR * (Ggemm - GRID_C), eC2 = eC, eD = eC2 + 1 * (Ggemm - GRID_D);
        RUN(1, Ggemm,
            if (l == 0) {
            { PH_BEGIN for (int u = bid; u < 32; u += G) s5_tables_unit(a, l, u, ldsL, tid); }
            { PH_BEGIN norm_rows(a, l, 1, gw, NGW, lane, NTOK); neutral_norm1(a, bid * 512 + tid, G * 512); } }
            else {
            { PH_BEGIN rs2_rows(a, bid * 512 + tid, G * 512, NLAT, WS_RS1); norm_ctx_rows(a, l, gw, NGW, lane); }
            { PH_BEGIN shw_rows(a, l, 0, WSP(const bf16, WS_WIN), INC, WSP(float, WS_SHWIN), nullptr, ldsL, tid, gw, NGW); }
            { PH_BEGIN shw_rows(a, l, 0, WSP(const bf16, WS_WG), DFF, WSP(float, WS_SHWG), a.in(I_BGATE) + (size_t)l * 4 * D, ldsL, tid, gw, NGW); } } )
        RUN(REP_B, Ggemm,
            { PH_BEGIN EpiInProj E; E.ga = WSP(bf16, WS_GA); E.yb = WSP(bf16, WS_YB); E.q = WSP(bf16, WS_Q); E.k = WSP(bf16, WS_K); E.vT = WSP(bf16, WS_VT); E.vcT = WSP(bf16, WS_VCT); E.u = WSP(bf16, WS_U);
              E.rope = WSP(const f32x2, WS_ROPE); E.rs = WSP(const float, WS_RS1); E.shw = WSP(const float, WS_SHWIN); GEMM_PHASE(EpiInProj, WSP(const bf16, WS_H), WSP(const bf16, WS_WIN), NTOK, INC, D, E); } )
        RUN2(REP_C, GRID_C,
#ifdef CARRY_IN_C
            { PH_BEGIN unsigned n_ = 0u; for (int u = G - 1 - bid; u < 352; u += G) { s5_state_unit(a, u, ldsL, tid); ++n_; }
              asm volatile("s_waitcnt vmcnt(0)" ::: "memory"); __syncthreads();
              if (tid == 0) { __builtin_amdgcn_fence(__ATOMIC_RELEASE, "agent"); asm volatile("s_waitcnt vmcnt(0)" ::: "memory");
                              xb_add((unsigned*)(ws + WS_CTL) + CW_S5CNT + 64 * l, n_); } }
            { PH_BEGIN for (int u = G - 1 - bid; u < NTOK / 128; u += G) gmlp_unit(a, l, u, ldsL, tid); }
            { PH_BEGIN for (int u = bid; u < NTOK / 32; u += G) conv_unit(a, l, u, ldsL, tid); }
            { PH_BEGIN for (int u = bid; u < 1024 + 32; u += G) attn_unit(a, l, u, ldsL, tid); }
            { PH_BEGIN shw_rows(a, l, 3, WSP(const bf16, WS_WF1), DFF, WSP(float, WS_SHW), nullptr, ldsL, tid, gw, NGW); }
            { PH_BEGIN if (cb_ == 0 && bid < 32) { CARRY_BLOCK(bid) } },
#else
            { PH_BEGIN for (int r_ = 0; r_ < REP_GMLP; ++r_) for (int u = G - 1 - bid; u < NTOK / 128; u += G) gmlp_unit(a, l, u, ldsL, tid); }
            { PH_BEGIN for (int r_ = 0; r_ < REP_CONV; ++r_) for (int u = bid; u < NTOK / 32; u += G) conv_unit(a, l, u, ldsL, tid); }
            { PH_BEGIN for (int r_ = 0; r_ < REP_ATTN; ++r_) for (int u = bid; u < 1024 + 32; u += G) attn_unit(a, l, u, ldsL, tid); }
            { PH_BEGIN for (int r_ = 0; r_ < REP_S5S; ++r_) for (int u = G - 1 - bid; u < 352; u += G) s5_state_unit(a, u, ldsL, tid); }
            { PH_BEGIN shw_rows(a, l, 3, WSP(const bf16, WS_WF1), DFF, WSP(float, WS_SHW), nullptr, ldsL, tid, gw, NGW); },
#endif
#ifdef CARRY_IN_C
            GATES_EARLY(0, eC) { PH_BEGIN if (cb_ != 0 && bid - cb_ < 32) { CARRY_BLOCK(bid - cb_) } } )
#else
            GATES_EARLY(0, eC) )
#endif
#ifndef CARRY_IN_C
        RUN2(REP_C2, GRID_C2, { PH_BEGIN if ((wave & 3) == 0) for (int s = bid * 2 + (wave >> 2); s < 256; s += G * 2) s5_carry_seq(a, s, lane); }, GATES_EARLY(eC, eC2) )
#endif
        RUN2(REP_D, GRID_D, { PH_BEGIN for (int u = bid; u < 352; u += G) s5_out_unit(a, u, ldsL, tid); __syncthreads(); }, GATES_EARLY(eC2, eD) )
        RUN(REP_E, Ggemm,
            { PH_BEGIN EpiGlu E; E.o = WSP(bf16, WS_BR) + (size_t)3 * NTOK * 512; GEMM_PHASE(EpiGlu, WSP(const bf16, WS_YG), WSP(const bf16, WS_WGLU), Mrows, 1024, DB, E); }
            { PH_BEGIN EpiGate E; E.o = WSP(bf16, WS_G); E.rs = WSP(const float, WS_RS1); E.shw = WSP(const float, WS_SHWG);
              pg8::Gemm g_{}; g_.A = WSP(const bf16, WS_H); g_.Bt = WSP(const bf16, WS_WG); g_.M = Mrows; g_.N = DFF; g_.K = D; g_.pad = 0; g_.sA = 0; g_.sB = 0;
              pg8::RangeOrder S_; S_.init(Mrows, DFF, eD, 1 << 30, G, (bid + (G >> 1)) % G);
              pg8::gemm_phase<EpiGate, pg8::RangeOrder, true, true>(ldsL, g_, S_, E, tid); } )
        RUN(REP_F, Ggemm,
            { PH_BEGIN EpiMerge E; E.gate = WSP(const bf16, WS_G); E.mg = WSP(bf16, WS_MG);
              pg8::Gemm g_{}; g_.A = WSP(const bf16, WS_BR); g_.Bt = WSP(const bf16, WS_WBR); g_.M = Mrows; g_.N = D; g_.K = DB; g_.pad = 0; g_.sA = (size_t)NTOK * 512 * 2; g_.sB = (size_t)D * DB * 2;
              pg8::QuadOrder S_; S_.init(Mrows, D, G, bid); pg8::gemm_phase<EpiMerge, pg8::QuadOrder, true, true>(ldsL, g_, S_, E, tid); } )
        RUN(1, Ggemm,
            { PH_BEGIN EpiResidN E; E.srcl = l == 0 ? a.in(I_X) : (const float*)a.out(); E.srcc = l == 0 ? a.in(I_CTX) : WSP(const float, WS_XC); E.dstl = a.out(); E.dstc = WSP(float, WS_XC);
              E.modg = WSP(const float, WS_MOD) + (size_t)l * 5 * 12288 + 2 * D; E.xg = WSP(bf16, WS_H); E.ng2 = a.in(I_N2G) + l * D; E.sc2 = WSP(const float, WS_MOD) + (size_t)l * 5 * 12288 + 4 * D; E.ps = WSP(float, WS_PS);
              GEMM_PHASE(EpiResidN, WSP(const bf16, WS_MG), WSP(const bf16, WS_WOUT), NLAT, D, D, E); }
            if (l + 1 < DEPTH) {
            { PH_BEGIN EpiPart E; E.part = WSP(float, WS_PART);
              pg8::Gemm g_{}; g_.A = WSP(const bf16, WS_MG); g_.Bt = WSP(const bf16, WS_WOUT); g_.M = NTOK; g_.N = D; g_.K = D / 4; g_.pad = D; g_.sA = (size_t)(D / 4) * 2; g_.sB = (size_t)(D / 4) * 2;
              pg8::SliceOrder S_; S_.init(NLAT / 256, NCTX / 256, D / 256, 128, bid < 128 ? bid : -1); pg8::gemm_phase<EpiPart, pg8::SliceOrder, true, true>(ldsL, g_, S_, E, tid); } } )
        RUN(REP_H, Ggemm, { PH_BEGIN rs2_rows(a, bid * 512 + tid, G * 512, NLAT); if (l + 1 < DEPTH) outproj_ctx_rows(a, l, gw, NGW, lane); } )
        RUN(REP_I, Ggemm,
            { PH_BEGIN EpiFfn1 E; E.o = WSP(bf16, WS_G); E.rs = WSP(const float, WS_RS2); E.shw = WSP(const float, WS_SHW); GEMM_PHASE(EpiFfn1, WSP(const bf16, WS_H), WSP(const bf16, WS_WF1), Mrows, DFF, D, E); } )
        RUN(1, Ggemm,
            if (l + 1 < DEPTH) {
            { PH_BEGIN EpiResidN E; E.srcl = a.out(); E.srcc = WSP(const float, WS_XC); E.dstl = a.out(); E.dstc = WSP(float, WS_XC); E.modg = WSP(const float, WS_MOD) + (size_t)l * 5 * 12288 + 5 * D;
              E.xg = WSP(bf16, WS_H); E.ng2 = a.in(I_N1G) + (l + 1) * D; E.sc2 = WSP(const float, WS_MOD) + (size_t)(l + 1) * 5 * 12288 + 1 * D; E.ps = WSP(float, WS_PS);
              GEMM_PHASE(EpiResidN, WSP(const bf16, WS_G), WSP(const bf16, (l & 1) ? WS_WF2B : WS_WF2), NLAT, D, DFF, E); } }
            else {
            { PH_BEGIN EpiResid E; E.srcl = a.out(); E.srcc = WSP(const float, WS_XC); E.dstl = a.out(); E.dstc = WSP(float, WS_XC); E.modg = WSP(const float, WS_MOD) + (size_t)l * 5 * 12288 + 5 * D;
              GEMM_PHASE(EpiResid, WSP(const bf16, WS_G), WSP(const bf16, (l & 1) ? WS_WF2B : WS_WF2), NLAT, D, DFF, E); } }
            if (l + 1 < DEPTH) {
            { PH_BEGIN EpiPart E; E.part = WSP(float, WS_PART);
              pg8::Gemm g_{}; g_.A = WSP(const bf16, WS_G); g_.Bt = WSP(const bf16, (l & 1) ? WS_WF2B : WS_WF2); g_.M = NTOK; g_.N = D; g_.K = DFF / 4; g_.pad = DFF; g_.sA = (size_t)(DFF / 4) * 2; g_.sB = (size_t)(DFF / 4) * 2;
              pg8::SliceOrder S_; S_.init(NLAT / 256, NCTX / 256, D / 256, 128, bid < 128 ? bid : -1); pg8::gemm_phase<EpiPart, pg8::SliceOrder, true, true>(ldsL, g_, S_, E, tid); }
            { PH_BEGIN constexpr int ISPLIT = 23000;
              if (bid >= 128 && bid < G - 32) convert_layer(a, l + 1, (LAS float*)ldsL + wave * 32 * 65, (bid - 128) * 8 + wave, (G - 160) * 8, lane, (bid - 128) * 512 + tid, (G - 160) * 512, 0, ISPLIT);
              else if (bid < 128) convert_layer(a, l + 1, (LAS float*)ldsL + wave * 32 * 65, bid * 8 + wave, 128 * 8, lane, bid * 512 + tid, 128 * 512, ISPLIT, 1 << 30); }
            { PH_BEGIN if (bid >= G - 32) s5_tables_unit(a, l + 1, bid - (G - 32), ldsL, tid); } } )
    }
    { const int Gsel = Ggemm; PH_BEGIN final_rows(a, gw, NGW, lane); }
}

extern "C" void kernel_launch(void* const* d_in, const int* in_sizes, int n_in, void* d_out, int out_size, void* d_ws, size_t ws_size, hipStream_t stream) {
    static int grid = 0;
    if (grid == 0) {
        if (n_in != 34 || ws_size < WS_TOTAL) { fprintf(stderr, "kernel_launch: unexpected n_in %d or ws_size %zu (< %zu)\n", n_in, ws_size, (size_t)WS_TOTAL); grid = -1; return; }
        int dev = 0, cus = 0, per_cu = 0;
        if (hipGetDevice(&dev) != hipSuccess || hipDeviceGetAttribute(&cus, hipDeviceAttributeMultiprocessorCount, dev) != hipSuccess) { grid = -1; return; }
        if (hipFuncSetAttribute((const void*)mega_fwd, hipFuncAttributeMaxDynamicSharedMemorySize, LDS_BYTES) != hipSuccess) { fprintf(stderr, "kernel_launch: hipFuncSetAttribute failed\n"); grid = -1; return; }
        if (hipOccupancyMaxActiveBlocksPerMultiprocessor(&per_cu, (const void*)mega_fwd, 512, LDS_BYTES) != hipSuccess || per_cu < 1) { fprintf(stderr, "kernel_launch: occupancy query says %d\n", per_cu); }
        (void)hipGetLastError();
        grid = cus;
        if (grid < 225) { fprintf(stderr, "kernel_launch: %d CUs: the prologue needs >= 225 workgroups\n", grid); grid = -1; return; }
    }
    if (grid < 0) return;
#ifdef USE_XCD_BAR
    (void)hipMemsetAsync((char*)d_ws + WS_CTL, 0, CTL_ZERO_BYTES, stream);
#endif
    Args a{}; for (int i = 0; i < 34; ++i) a.in[i] = (const float*)d_in[i]; a.out = (float*)d_out; a.ws = (unsigned char*)d_ws; a.layer = 0; a.which = 0;
    hipLaunchKernelGGL(mega_fwd, dim3(grid), dim3(512), LDS_BYTES, stream, a);
}
```

```cpp
#include <hip/hip_runtime.h>
#include <cstdio>
#include <cstdint>
#define USE_XCD_BAR 1


#define ECR 7

namespace pg8 {
#define PG8_LAS __attribute__((address_space(3)))
typedef unsigned short bf16_t;
typedef short bf16x8 __attribute__((ext_vector_type(8)));
typedef float f32x4 __attribute__((ext_vector_type(4)));
typedef unsigned u32x4 __attribute__((ext_vector_type(4)));
constexpr int BM = 256, BK = 64, HALF = 128, HTB = HALF * BK * 2  , STAGE_BYTES = 8 * HTB, NXCD = 8, WGM = 8;

__host__ __device__ __forceinline__ int lds_byte(int r, int c) { const int st = (r >> 4) * 2 + (c >> 5), rr = r & 15, cc = c & 31, ob = rr * 64 + cc * 2; return st * 1024 + (ob ^ (((ob >> 9) & 1) << 5)); }
__host__ __device__ __forceinline__ void stage_rc(int b, int& R, int& C) { const int st = b / 1024, sb = b % 1024, swz = sb ^ (((sb >> 9) & 1) << 5); R = (st >> 1) * 16 + swz / 64; C = (st & 1) * 32 + (swz % 64) / 2; }
__host__ __device__ __forceinline__ int perm32(int rho) { const int n = rho >> 4, i = rho & 15; return 8 * (i >> 2) + 4 * n + (i & 3); }

struct Unit { int pm, pn, kb; };
struct Gemm { const bf16_t* A; const bf16_t* Bt; int M, N, K, pad; size_t sA, sB; };

struct StaticOrder {
    int nM, nN, nwg, G, c;
    __host__ __device__ void init(int M, int N, int G_, int c_) { nM = M / BM; nN = N / BM; nwg = nM * nN; G = G_; c = c_; }
    __host__ __device__ bool next(int i, Unit& u) const {
        const long L = (long)i * G + c; if (L >= nwg) return false;
        int wgid = (int)L; { const int q = nwg / NXCD, r = nwg % NXCD, xcd = wgid % NXCD, off = wgid / NXCD; wgid = (xcd < r ? xcd * (q + 1) : r * (q + 1) + (xcd - r) * q) + off; }
        const int nig = WGM * nN, gid = wgid / nig, fm = gid * WGM, gsz = (nM - fm) < WGM ? (nM - fm) : WGM;
        u.pm = fm + ((wgid % nig) % gsz); u.pn = (wgid % nig) / gsz; u.kb = 0; return true;
    }
    __device__ __forceinline__ void a_ready(const Unit&) const {}
    __device__ __forceinline__ void done(const Unit&) const {}
};
struct RangeOrder {
    StaticOrder T; int base, end, Gp, cp;
    __host__ __device__ void init(int M, int N, int base_, int end_, int Gp_, int cp_) { T.init(M, N, 1, 0); base = base_; end = end_ < T.nwg ? end_ : T.nwg; Gp = Gp_; cp = cp_; }
    __host__ __device__ bool next(int i, Unit& u) const { const int L = base + i * Gp + cp; if (L >= end) return false; return T.next(L, u); }
    __device__ __forceinline__ void a_ready(const Unit&) const {}
    __device__ __forceinline__ void done(const Unit&) const {}
};
struct SliceOrder {
    int pm0, nN, n, Gp, cp;
    __host__ __device__ void init(int pm0_, int nP, int nN_, int Gp_, int cp_) { pm0 = pm0_; nN = nN_; n = nP * nN_ * 4; Gp = Gp_; cp = cp_; }
    __host__ __device__ bool next(int i, Unit& u) const { const int L = i * Gp + cp; if (cp < 0 || L >= n) return false; u.kb = L & 3; u.pn = (L >> 2) % nN; u.pm = pm0 + (L >> 2) / nN; return true; }
    __device__ __forceinline__ void a_ready(const Unit&) const {}
    __device__ __forceinline__ void done(const Unit&) const {}
};
struct QuadOrder {
    StaticOrder T;
    __host__ __device__ void init(int M, int N, int G_, int c_) { T.init(M, N, G_, c_); }
    __host__ __device__ bool next(int i, Unit& u) const { const bool ok = T.next(i >> 2, u); u.kb = i & 3; return ok; }
    __device__ __forceinline__ void a_ready(const Unit&) const {}
    __device__ __forceinline__ void done(const Unit&) const {}
};


template <class Epi, class Sched, bool ALIGN_EPI = false, bool SP2 = false>
__device__ __forceinline__ void gemm_phase(PG8_LAS unsigned char* lds, const Gemm g, const Sched& S, const Epi& E, const int tid) {
    const int wid = __builtin_amdgcn_readfirstlane(tid >> 6), lane = tid & 63, wr = wid >> 2, wc = wid & 3, fr = lane & 15, fq = lane >> 4;
    const int K = g.K, nt = K / BK, LD = g.pad > 0 ? g.pad : g.K;
    unsigned voffA[2], voffB[2];
#pragma unroll
    for (int i = 0; i < 2; ++i) { int R, C; stage_rc(tid * 16 + i * 8192, R, C); const int Rb = Epi::PERM ? ((R & ~31) + perm32(R & 31)) : R;
        voffA[i] = (unsigned)(R * LD + C) * 2u; voffB[i] = (unsigned)(Rb * LD + C) * 2u; }
    const size_t kstep = (size_t)(BK * 2);
    const size_t hstep = (size_t)HALF * LD * 2;
    const size_t tstep = 2 * hstep;
    const unsigned ldsw = (unsigned)wid * 1024u;
    const int aoff = lds_byte(wr * 64 + fr, fq * 8), boff = lds_byte(wc * 32 + fr, fq * 8);
#define PG8_SA(b, h) (((b) * 2 + (h)) * HTB)
#define PG8_SB(b, h) ((4 + (b) * 2 + (h)) * HTB)
#define PG8_STAGE(bufoff, gbase, voff) do { _Pragma("unroll") for (int _i = 0; _i < 2; ++_i) \
        __builtin_amdgcn_global_load_lds((const unsigned*)((const char*)(gbase) + (voff)[_i]), (PG8_LAS unsigned*)(lds + (bufoff) + ldsw + _i * 8192), 16, 0, 0); } while (0)
#define PG8_LDA(dst, b, h) do { _Pragma("unroll") for (int m = 0; m < 4; ++m) _Pragma("unroll") for (int k = 0; k < 2; ++k) dst[m][k] = *(const PG8_LAS bf16x8*)(lds + PG8_SA(b, h) + aoff + m * 2048 + k * 1024); } while (0)
#define PG8_LDB(dst, b, h) do { _Pragma("unroll") for (int n = 0; n < 2; ++n) _Pragma("unroll") for (int k = 0; k < 2; ++k) dst[n][k] = *(const PG8_LAS bf16x8*)(lds + PG8_SB(b, h) + boff + n * 2048 + k * 1024); } while (0)
#define PG8_MMA(ai, bj, At, Bt) do { __builtin_amdgcn_s_setprio(1); _Pragma("unroll") for (int m = 0; m < 4; ++m) _Pragma("unroll") for (int n = 0; n < 2; ++n) _Pragma("unroll") for (int k = 0; k < 2; ++k) \
        acc[ai][bj][m][n] = __builtin_amdgcn_mfma_f32_16x16x32_bf16(Bt[n][k], At[m][k], acc[ai][bj][m][n], 0, 0, 0); __builtin_amdgcn_s_setprio(0); } while (0)
#define PG8_WAIT_V(n) asm volatile("s_waitcnt vmcnt(" #n ")" ::: "memory")
#define PG8_WAIT_L(n) asm volatile("s_waitcnt lgkmcnt(" #n ")" ::: "memory")
#define PG8_BAR __builtin_amdgcn_s_barrier()
#define PG8_SCHED __builtin_amdgcn_sched_barrier(0)
    Unit cur, nxt; int ui = 0;
    if (!S.next(0, cur)) return;
    f32x4 acc[2][2][4][2];
#pragma unroll
    for (int a = 0; a < 2; ++a)
#pragma unroll
        for (int b = 0; b < 2; ++b)
#pragma unroll
            for (int m = 0; m < 4; ++m)
#pragma unroll
                for (int n = 0; n < 2; ++n) acc[a][b][m][n] = (f32x4){0.f, 0.f, 0.f, 0.f};
    bf16x8 At[4][2], B0[2][2], B1[2][2];
    const char* cA = (const char*)g.A + (size_t)cur.pm * tstep + (size_t)cur.kb * g.sA; const char* cB = (const char*)g.Bt + (size_t)cur.pn * tstep + (size_t)cur.kb * g.sB;
    S.a_ready(cur);
    if constexpr (SP2) {
        PG8_STAGE(PG8_SB(0, 0), cB, voffB); PG8_STAGE(PG8_SB(0, 1), cB + hstep, voffB); PG8_STAGE(PG8_SA(0, 0), cA, voffA); PG8_STAGE(PG8_SA(0, 1), cA + hstep, voffA);
        if (wr == 1) PG8_BAR;
        PG8_WAIT_V(2); PG8_BAR;
        PG8_STAGE(PG8_SB(1, 0), cB + kstep, voffB); PG8_STAGE(PG8_SA(1, 0), cA + kstep, voffA); PG8_STAGE(PG8_SB(1, 1), cB + hstep + kstep, voffB);
        PG8_WAIT_V(6); PG8_BAR;
    } else {
        PG8_STAGE(PG8_SB(0, 0), cB, voffB); PG8_STAGE(PG8_SA(0, 0), cA, voffA); PG8_STAGE(PG8_SB(0, 1), cB + hstep, voffB); PG8_STAGE(PG8_SA(0, 1), cA + hstep, voffA);
        if (wr == 1) PG8_BAR;
        PG8_WAIT_V(4); PG8_BAR;
        PG8_STAGE(PG8_SB(1, 0), cB + kstep, voffB); PG8_STAGE(PG8_SA(1, 0), cA + kstep, voffA); PG8_STAGE(PG8_SB(1, 1), cB + hstep + kstep, voffB);
        PG8_WAIT_V(6); PG8_BAR;
    }
    for (;;) {
        const bool has_next = S.next(ui + 1, nxt);
        const char* nA = has_next ? (const char*)g.A + (size_t)nxt.pm * tstep + (size_t)nxt.kb * g.sA : cA; const char* nB = has_next ? (const char*)g.Bt + (size_t)nxt.pn * tstep + (size_t)nxt.kb * g.sB : cB;
        for (int t = 0; t < nt; t += 2) {
            const bool last = (t == nt - 2);
            const char* a1 = cA + (size_t)(t + 1) * kstep;
            const char* a2 = last ? nA : cA + (size_t)(t + 2) * kstep; const char* b2 = last ? nB : cB + (size_t)(t + 2) * kstep;
            const char* a3 = a2 + kstep; const char* b3 = b2 + kstep;
            if (last && has_next) S.a_ready(nxt);
            if constexpr (SP2) {
            PG8_LDB(B0, 0, 0); PG8_LDB(B1, 0, 1); PG8_SCHED; PG8_LDA(At, 0, 0); PG8_STAGE(PG8_SA(1, 1), a1 + hstep, voffA);
            PG8_WAIT_V(8); PG8_WAIT_L(0); PG8_BAR; PG8_MMA(0, 0, At, B0); PG8_MMA(0, 1, At, B1); PG8_BAR; PG8_SCHED;
            PG8_LDA(At, 0, 1); PG8_STAGE(PG8_SB(0, 0), b2, voffB); PG8_STAGE(PG8_SB(0, 1), b2 + hstep, voffB); PG8_STAGE(PG8_SA(0, 0), a2, voffA);
            PG8_WAIT_V(8); PG8_WAIT_L(0); PG8_BAR; PG8_MMA(1, 0, At, B0); PG8_MMA(1, 1, At, B1); PG8_BAR; PG8_SCHED;
            PG8_LDB(B0, 1, 0); PG8_LDB(B1, 1, 1); PG8_SCHED; PG8_LDA(At, 1, 0); PG8_STAGE(PG8_SA(0, 1), a2 + hstep, voffA);
            PG8_WAIT_V(8); PG8_WAIT_L(0); PG8_BAR; PG8_MMA(0, 0, At, B0); PG8_MMA(0, 1, At, B1); PG8_BAR; PG8_SCHED;
            PG8_LDA(At, 1, 1); PG8_STAGE(PG8_SB(1, 0), b3, voffB); PG8_STAGE(PG8_SB(1, 1), b3 + hstep, voffB); PG8_STAGE(PG8_SA(1, 0), a3, voffA);
            PG8_WAIT_V(8); PG8_WAIT_L(0); PG8_BAR; PG8_MMA(1, 0, At, B0); PG8_MMA(1, 1, At, B1); PG8_BAR; PG8_SCHED;
            } else {
            PG8_LDB(B0, 0, 0); PG8_SCHED; PG8_LDA(At, 0, 0); PG8_STAGE(PG8_SA(1, 1), a1 + hstep, voffA);
            PG8_WAIT_L(8); PG8_BAR; PG8_WAIT_L(0); PG8_MMA(0, 0, At, B0); PG8_BAR; PG8_SCHED;
            PG8_LDB(B1, 0, 1); PG8_STAGE(PG8_SB(0, 0), b2, voffB);
            PG8_BAR; PG8_WAIT_L(0); PG8_MMA(0, 1, At, B1); PG8_BAR;
            PG8_LDA(At, 0, 1); PG8_STAGE(PG8_SA(0, 0), a2, voffA);
            PG8_BAR; PG8_WAIT_L(0); PG8_MMA(1, 0, At, B0); PG8_BAR; PG8_SCHED;
            PG8_STAGE(PG8_SB(0, 1), b2 + hstep, voffB);
            PG8_WAIT_V(6); PG8_BAR; PG8_MMA(1, 1, At, B1); PG8_BAR;
            PG8_LDB(B0, 1, 0); PG8_SCHED; PG8_LDA(At, 1, 0); PG8_STAGE(PG8_SA(0, 1), a2 + hstep, voffA);
            PG8_WAIT_L(8); PG8_BAR; PG8_WAIT_L(0); PG8_MMA(0, 0, At, B0); PG8_BAR; PG8_SCHED;
            PG8_LDB(B1, 1, 1); PG8_STAGE(PG8_SB(1, 0), b3, voffB);
            PG8_BAR; PG8_WAIT_L(0); PG8_MMA(0, 1, At, B1); PG8_BAR;
            PG8_LDA(At, 1, 1); PG8_STAGE(PG8_SA(1, 0), a3, voffA);
            PG8_BAR; PG8_WAIT_L(0); PG8_MMA(1, 0, At, B0); PG8_BAR; PG8_SCHED;
            PG8_STAGE(PG8_SB(1, 1), b3 + hstep, voffB);
            PG8_WAIT_V(6); PG8_BAR; PG8_MMA(1, 1, At, B1); PG8_BAR;
            }
        }
        if constexpr (ALIGN_EPI) { if (wr == 0) PG8_BAR; }
        if constexpr (!Epi::AFTER_DRAIN) { E(acc, cur, wr, wc, fr, fq); S.done(cur); }
        if (!has_next) break;
#pragma unroll
        for (int a = 0; a < 2; ++a)
#pragma unroll
            for (int b = 0; b < 2; ++b)
#pragma unroll
                for (int m = 0; m < 4; ++m)
#pragma unroll
                    for (int n = 0; n < 2; ++n) acc[a][b][m][n] = (f32x4){0.f, 0.f, 0.f, 0.f};
        cur = nxt; cA = nA; cB = nB; ++ui;
        if constexpr (ALIGN_EPI) { if (wr == 1) PG8_BAR; }
    }
    PG8_WAIT_V(0);
    if constexpr (!ALIGN_EPI) { if (wr == 0) PG8_BAR; }
    PG8_BAR;
    if constexpr (Epi::AFTER_DRAIN) { E.fused(acc, cur, wr, wc, fr, fq, lds, wid, lane); S.done(cur); }
#undef PG8_SA
#undef PG8_SB
#undef PG8_STAGE
#undef PG8_LDA
#undef PG8_LDB
#undef PG8_MMA
#undef PG8_WAIT_V
#undef PG8_WAIT_L
#undef PG8_BAR
#undef PG8_SCHED
}
}

typedef unsigned short bf16;
typedef short bf16x8 __attribute__((ext_vector_type(8)));
typedef float f32x4 __attribute__((ext_vector_type(4)));
typedef float f32x2 __attribute__((ext_vector_type(2)));
typedef unsigned u32x4 __attribute__((ext_vector_type(4)));
typedef unsigned u32x2 __attribute__((ext_vector_type(2)));
#define LAS __attribute__((address_space(3)))
constexpr int D = 2048, NB = 4, SEQ = 8192, DEPTH = 4, CTXL = 256;
constexpr int NLAT = NB * SEQ, NCTX = NB * CTXL, NTOK = NLAT + NCTX;
constexpr int DB = 512, INC = 3328, DFF = 8192, NMOD = 6;
constexpr float EPS = 1e-6f, LOG2E = 1.4426950408889634f, QSCALE = 0.125f * 1.4426950408889634f;
constexpr size_t MiB = 1u << 20;
constexpr size_t WS_CTL = 0, WS_MOD = 1 * MiB, WS_ROPE = 2 * MiB, WS_GWS = 2 * MiB + 256 * 1024;
constexpr size_t WS_WIN = 64 * MiB, WS_WG = 77 * MiB, WS_WBR = 109 * MiB, WS_WOUT = 117 * MiB, WS_WF1 = 125 * MiB, WS_WF2 = 157 * MiB, WS_WGLU = 189 * MiB;
constexpr size_t WS_XC = 190 * MiB, WS_H = 198 * MiB, WS_GA = 330 * MiB, WS_YB = 396 * MiB, WS_Q = 429 * MiB, WS_K = 462 * MiB, WS_VT = 471 * MiB, WS_U = 480 * MiB;
constexpr size_t WS_BR = 514 * MiB, WS_MG = 646 * MiB, WS_G = 778 * MiB, WS_YF = 1306 * MiB, WS_YBK = 1372 * MiB, WS_END = 1438 * MiB;
constexpr size_t WF2_BYTES = (size_t)DFF * D * 2, WS_WF2B = WS_END;
constexpr size_t WS_TOTAL = WS_END + 32 * MiB;
constexpr size_t WS_PS = 1372 * MiB, WS_RS2 = 1378 * MiB, WS_SHW = 1379 * MiB;
constexpr size_t WS_SHWIN = 1380 * MiB, WS_SHWG = 1381 * MiB, WS_RS1 = 1382 * MiB;
constexpr size_t WS_PART = 1384 * MiB;
constexpr size_t WS_YG = WS_GA, WS_MBUF = WS_H;
constexpr size_t WS_VCT = WS_VT + 8 * MiB;
constexpr size_t WS_S5DISC = 4 * MiB;

typedef __bf16 bf16x2_t __attribute__((ext_vector_type(2)));
__device__ __forceinline__ unsigned pk2(float lo, float hi) { const f32x2 v = {lo, hi}; return __builtin_bit_cast(unsigned, __builtin_convertvector(v, bf16x2_t)); }
__device__ __forceinline__ unsigned f2bf(float f) { return pk2(f, f) & 0xffffu; }
__device__ __forceinline__ float bf2f(unsigned b) { return __builtin_bit_cast(float, b << 16); }
__device__ __forceinline__ float bflo(unsigned w) { return __builtin_bit_cast(float, w << 16); }
__device__ __forceinline__ float bfhi(unsigned w) { return __builtin_bit_cast(float, w & 0xffff0000u); }
__device__ __forceinline__ float sigmoidf_(float x) { return __builtin_amdgcn_rcpf(1.f + __builtin_amdgcn_exp2f(-x * LOG2E)); }
__device__ __forceinline__ float gelu_tanh(float x) { const float y = 0.7978845608028654f * (x + 0.044715f * x * x * x); return x * sigmoidf_(2.f * y); }
__device__ __forceinline__ float siluf_(float x) { return x * sigmoidf_(x); }
__device__ __forceinline__ int lane_fresh() { int l; asm volatile("v_mbcnt_lo_u32_b32 %0, -1, 0\n\tv_mbcnt_hi_u32_b32 %0, -1, %0" : "=v"(l)); return l; }
template <int M> __device__ __forceinline__ float shx(float v) {
    if constexpr (M < 32) return __builtin_bit_cast(float, __builtin_amdgcn_ds_swizzle(__builtin_bit_cast(int, v), (M << 10) | 0x1f));
    else return __builtin_bit_cast(float, __builtin_amdgcn_ds_bpermute((lane_fresh() ^ 32) << 2, __builtin_bit_cast(int, v)));
}
__device__ __forceinline__ float wave_sum(float v) { v += shx<1>(v); v += shx<2>(v); v += shx<4>(v); v += shx<8>(v); v += shx<16>(v); v += shx<32>(v); return v; }
struct Args { const float* in[34]; float* out; unsigned char* ws; int layer, which; };
enum { I_X = 0, I_C, I_CTX, I_CCTX, I_WMOD, I_BMOD, I_N1G, I_N2G, I_WIN, I_GLNG, I_GLNB, I_GWS, I_GBS, I_CW, I_CB, I_CLNG, I_CLNB, I_SINK, I_ARE, I_AIM, I_LSTEP, I_BRE, I_BIM, I_CRE, I_CIM,
       I_S5D, I_WGLU, I_WBR, I_WGATE, I_BGATE, I_WOUT, I_WF1, I_WF2, I_FINALG };

struct PA {
    volatile LAS unsigned* tab;
    __device__ __forceinline__ unsigned long long get(int i) const { unsigned z; asm volatile("v_mov_b32 %0, 0" : "=v"(z)); volatile LAS unsigned* t = (volatile LAS unsigned*)((LAS unsigned char*)tab + z); unsigned lo = t[2 * i], hi = t[2 * i + 1]; lo = __builtin_amdgcn_readfirstlane(lo); hi = __builtin_amdgcn_readfirstlane(hi); return ((unsigned long long)hi << 32) | lo; }
    __device__ __forceinline__ const float* in(int i) const { return (const float*)(const __attribute__((address_space(1))) float*)get(i); }
    __device__ __forceinline__ float* out() const { return (float*)(__attribute__((address_space(1))) float*)get(34); }
    __device__ __forceinline__ unsigned char* ws() const { return (unsigned char*)(__attribute__((address_space(1))) unsigned char*)get(35); }
};
#define FRESH_TID() ({ int w_ = wave_s; asm volatile("" : "+s"(w_)); int t_ = (w_ << 6) | lane_fresh(); asm volatile("" : "+v"(t_)); t_; })

#define XB_TMO      128
#define XB_XCNT(j)  (256  + 64 * (j))
#define XB_XSUB(j)  (1280 + 64 * (j))
#define XB_XGEN(j)  (2304 + 64 * (j))
#define XB_TOP      3328
#define XB_TOPGEN   3392
#define XCD_BAR_WORDS 3456
#define XB_SPIN_CAP (1u << 22)

__device__ __forceinline__ unsigned xb_ld(unsigned* p)              { return __hip_atomic_load(p, __ATOMIC_RELAXED, __HIP_MEMORY_SCOPE_AGENT); }
__device__ __forceinline__ unsigned xb_add(unsigned* p, unsigned v) { return __hip_atomic_fetch_add(p, v, __ATOMIC_RELAXED, __HIP_MEMORY_SCOPE_AGENT); }
__device__ __forceinline__ unsigned xb_xcc_id() { return (unsigned)__builtin_amdgcn_s_getreg((3 << 11) | 20) & 0xFu; }
#define XB_SPIN(cond, bar) do { unsigned _sp = 0; while (cond) { __builtin_amdgcn_s_sleep(1); \
    if ((++_sp & 255u) == 0u) { if (xb_ld(&(bar)[XB_TMO])) break; if (_sp > XB_SPIN_CAP) { atomicAdd(&(bar)[XB_TMO], 1u); break; } } } } while (0)

struct XcdBarrier {
    unsigned* bar; unsigned x;
    volatile LAS unsigned* st;
};

__device__ __forceinline__ XcdBarrier xcd_barrier_post(unsigned* bar, volatile LAS unsigned* st) {
    XcdBarrier b; b.bar = bar; b.x = xb_xcc_id(); b.st = st;
    if (threadIdx.x == 0) (void)xb_add(&bar[XB_XCNT(b.x)], 1u);
    return b;
}
__device__ __forceinline__ void xcd_barrier_complete(unsigned* bar, unsigned x, unsigned& nloc, unsigned& nx) {
    const unsigned G = gridDim.x * gridDim.y * gridDim.z;
    unsigned sum, cnt, mine, sp = 0u;
    for (;;) {
        sum = 0u; cnt = 0u; mine = 0u;
#pragma unroll
        for (unsigned j = 0; j < 16; ++j) { const unsigned c = xb_ld(&bar[XB_XCNT(j)]); sum += c; cnt += (c > 0u) ? 1u : 0u; mine = (j == x) ? c : mine; }
        if (sum == G) break;
        __builtin_amdgcn_s_sleep(1);
        if ((++sp & 255u) == 0u) { if (xb_ld(&bar[XB_TMO])) break; if (sp > XB_SPIN_CAP) { atomicAdd(&bar[XB_TMO], 1u); break; } }
    }
    nloc = mine > 0u ? mine : 1u; nx = cnt > 0u ? cnt : 1u;
}

__device__ __forceinline__ void xcd_barrier(const XcdBarrier& b) {
    asm volatile("s_waitcnt vmcnt(0)" ::: "memory");
    __syncthreads();
    if (threadIdx.x == 0) {
        unsigned* bar = b.bar;
        __builtin_amdgcn_s_waitcnt(0);
        unsigned nloc = b.st[0], nx = b.st[1];
        if (nloc == 0u) { xcd_barrier_complete(bar, b.x, nloc, nx); b.st[0] = nloc; b.st[1] = nx; }
        const unsigned old = xb_add(&bar[XB_XSUB(b.x)], 1u);
        const unsigned gen = old / nloc;
        if (old + 1u == (gen + 1u) * nloc) {
            __builtin_amdgcn_fence(__ATOMIC_RELEASE, "agent");
            asm volatile("s_waitcnt vmcnt(0)" ::: "memory");
            const unsigned og = xb_add(&bar[XB_TOP], 1u);
            const unsigned tg = og / nx;
            if (og + 1u == (tg + 1u) * nx) xb_add(&bar[XB_TOPGEN], 1u);
            else XB_SPIN(xb_ld(&bar[XB_TOPGEN]) == tg, bar);
            __builtin_amdgcn_fence(__ATOMIC_ACQUIRE, "agent");
            xb_add(&bar[XB_XGEN(b.x)], 1u);
            asm volatile("s_waitcnt vmcnt(0)" ::: "memory");
        } else {
            XB_SPIN(xb_ld(&bar[XB_XGEN(b.x)]) == gen, bar);
            __builtin_amdgcn_fence(__ATOMIC_ACQUIRE, "agent");
            asm volatile("s_waitcnt vmcnt(0)" ::: "memory");
        }
    }
    __syncthreads();
}

__device__ __forceinline__ void prologue_block(const PA& a, int bid, LAS unsigned char* lds, int tid) {
    if (bid > 192) return;
    if (bid == 192) {
        f32x2* rt = (f32x2*)(a.ws() + WS_ROPE);
        for (int i = tid; i < 2048; i += 512) { const int pos = i >> 4, fi = i & 15; const double inv = pow(10000.0, -(double)fi / 16.0); const double ang = (double)pos * inv;
            rt[i] = (f32x2){(float)cos(ang), (float)sin(ang)}; }
        return;
    }
    LAS float* sc = (LAS float*)lds; LAS float* part = (LAS float*)(lds + 40960);
    const float* c = a.in(I_C); const float* cc = a.in(I_CCTX);
    for (int i = tid; i < 5 * 2048; i += 512) { const int s = i >> 11, k = i & 2047; const float v = s < 4 ? c[s * 2048 + k] : cc[k]; sc[i] = v / (1.f + expf(-v)); }
    __syncthreads();
    const int col = bid * 256 + (tid & 255), kh = tid >> 8;
    const int l = col / 12288, j = col % 12288;
    const float* w = a.in(I_WMOD) + (size_t)l * 2048 * 12288 + (size_t)kh * 1024 * 12288 + j;
    float acc[5] = {0.f, 0.f, 0.f, 0.f, 0.f};
#pragma unroll 1
    for (int k0 = 0; k0 < 1024; k0 += 32) { float wv[32];
#pragma unroll
        for (int k = 0; k < 32; ++k) wv[k] = w[(size_t)(k0 + k) * 12288];
#pragma unroll
        for (int k = 0; k < 32; ++k)
#pragma unroll
            for (int s = 0; s < 5; ++s) acc[s] += sc[s * 2048 + kh * 1024 + k0 + k] * wv[k]; }
    if (kh == 1) {
#pragma unroll
        for (int s = 0; s < 5; ++s) part[s * 256 + (tid & 255)] = acc[s]; }
    __syncthreads();
    if (kh == 0) { const float b = a.in(I_BMOD)[l * 12288 + j]; float* mv = (float*)(a.ws() + WS_MOD);
#pragma unroll
        for (int s = 0; s < 5; ++s) mv[(size_t)(l * 5 + s) * 12288 + j] = acc[s] + part[s * 256 + (tid & 255)] + b; }
}

__device__ __forceinline__ int inproj_map(int n) {
    if (n < 1024) return n;
    if (n < 2048) { const int m = n - 1024; return 1024 + (m < 512 ? 2 * m : 2 * (m - 512) + 1); }
    if (n < 2688) { const int base = n < 2560 ? 2048 : 2560; const int m = n - base, head = m >> 6, d = m & 63, half = d >> 5, i = d & 31; return base + head * 64 + half * 32 + 2 * (i & 15) + (i >> 4); }
    return n;
}
__device__ __forceinline__ int rowmap(int mode, int n) {
    if (mode == 1) return inproj_map(n);
    if (mode == 2) return n < 512 ? 2 * n : 2 * (n - 512) + 1;
    return n;
}
__device__ __forceinline__ void cvt_item(const float* W, int K, int N, bf16* WT, int mode, LAS float* scr, int item, int lane) {
    const int nblk = N / 64, kb = item / nblk, nb = item % nblk, k0 = 32 * kb, n0 = 64 * nb;
    f32x4 v[8];
#pragma unroll
    for (int i = 0; i < 8; ++i) v[i] = *(const f32x4*)(W + (size_t)(k0 + 4 * i + (lane >> 4)) * N + n0 + (lane & 15) * 4);
#pragma unroll
    for (int i = 0; i < 8; ++i) { LAS float* s = scr + (4 * i + (lane >> 4)) * 65 + (lane & 15) * 4; s[0] = v[i].x; s[1] = v[i].y; s[2] = v[i].z; s[3] = v[i].w; }
    asm volatile("s_waitcnt lgkmcnt(0)" ::: "memory");
#pragma unroll
    for (int j = 0; j < 4; ++j) { const int idx = lane + 64 * j, n = idx >> 2, c = idx & 3; const LAS float* s = scr + (8 * c) * 65 + n;
        u32x4 o; o.x = pk2(s[0 * 65], s[1 * 65]); o.y = pk2(s[2 * 65], s[3 * 65]); o.z = pk2(s[4 * 65], s[5 * 65]); o.w = pk2(s[6 * 65], s[7 * 65]);
        *(u32x4*)(WT + (size_t)rowmap(mode, n0 + n) * K + k0 + 8 * c) = o; }
    asm volatile("s_waitcnt lgkmcnt(0)" ::: "memory");
}
__device__ __forceinline__ void convert_layer(const PA& a, int l, LAS float* scr, int gw, int NGW, int lane, int gtid, int nthr, int it_lo = 0, int it_hi = 1 << 30) {
    unsigned char* ws = a.ws();
    constexpr int I_IN = 64 * 52, I_G = 64 * 32, I_B = 16 * 32, I_O = 64 * 32, I_1 = 64 * 128, I_2 = 256 * 32, I_GL = 16 * 16;
    constexpr int NITEMS = I_IN + 4 * I_G + 4 * I_B + I_O + I_1 + I_2 + I_GL;
    const int it_end = it_hi < NITEMS ? it_hi : NITEMS;
    for (int it = it_lo + gw; it < it_end; it += NGW) {
        int r = it;
        if (r < I_IN) { cvt_item(a.in(I_WIN) + (size_t)l * D * INC, D, INC, (bf16*)(ws + WS_WIN), 1, scr, r, lane); continue; } r -= I_IN;
        if (r < 4 * I_G) { const int k = r / I_G; cvt_item(a.in(I_WGATE) + (size_t)(l * 4 + k) * D * D, D, D, (bf16*)(ws + WS_WG) + (size_t)k * D * D, 0, scr, r % I_G, lane); continue; } r -= 4 * I_G;
        if (r < 4 * I_B) { const int k = r / I_B; cvt_item(a.in(I_WBR) + (size_t)(l * 4 + k) * DB * D, DB, D, (bf16*)(ws + WS_WBR) + (size_t)k * D * DB, 0, scr, r % I_B, lane); continue; } r -= 4 * I_B;
        if (r < I_O) { cvt_item(a.in(I_WOUT) + (size_t)l * D * D, D, D, (bf16*)(ws + WS_WOUT), 0, scr, r, lane); continue; } r -= I_O;
        if (r < I_1) { cvt_item(a.in(I_WF1) + (size_t)l * D * DFF, D, DFF, (bf16*)(ws + WS_WF1), 0, scr, r, lane); continue; } r -= I_1;
        if (r < I_2) { cvt_item(a.in(I_WF2) + (size_t)l * DFF * D, DFF, D, (bf16*)(ws + ((l & 1) ? WS_WF2B : WS_WF2)), 0, scr, r, lane); continue; } r -= I_2;
        cvt_item(a.in(I_WGLU) + (size_t)l * DB * 1024, DB, 1024, (bf16*)(ws + WS_WGLU), 2, scr, r, lane);
    }
    bf16* gws = (bf16*)(ws + WS_GWS); const float* gsrc = a.in(I_GWS) + (size_t)l * 65536;
    if (it_lo == 0) for (int i = gtid; i < 65536; i += nthr) gws[i] = (bf16)f2bf(gsrc[i]);
}

__device__ __forceinline__ const float* xrow_src(const PA& a, int layer, int which, int r) {
    if (layer == 0 && which == 1) return r < NLAT ? a.in(I_X) + (size_t)r * D : a.in(I_CTX) + (size_t)(r - NLAT) * D;
    return r < NLAT ? a.out() + (size_t)r * D : (const float*)(a.ws() + WS_XC) + (size_t)(r - NLAT) * D;
}
__device__ __forceinline__ void norm_rows(const PA& a, int layer, int which, int gw, int NGW, int lane, int nrows) {
    const float* ng = a.in(which == 1 ? I_N1G : I_N2G) + layer * D;
    bf16* H = (bf16*)(a.ws() + WS_H);
    const float* mvb = (const float*)(a.ws() + WS_MOD) + (size_t)(layer * 5) * 12288 + (which == 1 ? 0 : 3) * D;
    f32x4 ca[8], cb[8]; int cur = -1;
#pragma unroll 1
    for (int r0 = gw; r0 < nrows; r0 += 3 * NGW) {
        f32x4 v[3][8]; float ss[3];
#pragma unroll
        for (int q = 0; q < 3; ++q) { const int r = r0 + q * NGW; const int rr = r < nrows ? r : r0; const f32x4* xr = (const f32x4*)xrow_src(a, layer, which, rr) + lane; ss[q] = 0.f;
#pragma unroll
            for (int j = 0; j < 8; ++j) v[q][j] = xr[64 * j]; }
#pragma unroll
        for (int q = 0; q < 3; ++q) {
#pragma unroll
            for (int j = 0; j < 8; ++j) ss[q] += (v[q][j].x * v[q][j].x + v[q][j].y * v[q][j].y) + (v[q][j].z * v[q][j].z + v[q][j].w * v[q][j].w); }
#pragma unroll
        for (int q = 0; q < 3; ++q) ss[q] = wave_sum(ss[q]);
#pragma unroll
        for (int q = 0; q < 3; ++q) { const int r = r0 + q * NGW; if (r < nrows) {
            const float rs = 1.f / sqrtf(ss[q] * (1.f / D) + EPS);
            const int s = r < NLAT ? (r >> 13) : 4;
            if (s != cur) { cur = s; const float* mv = mvb + (size_t)s * 12288;
#pragma unroll
                for (int j = 0; j < 8; ++j) { const int col = (lane + 64 * j) * 4; ca[j] = *(const f32x4*)(ng + col) * (*(const f32x4*)(mv + D + col) + 1.f); cb[j] = *(const f32x4*)(mv + col); } }
            u32x2* o8 = (u32x2*)(H + (size_t)r * D) + lane;
#pragma unroll
            for (int j = 0; j < 8; ++j) { const f32x4 y = (v[q][j] * rs) * ca[j] + cb[j]; o8[64 * j] = (u32x2){pk2(y.x, y.y), pk2(y.z, y.w)}; } } }
    }
}

__device__ __forceinline__ void norm_ctx_rows(const PA& a, int layer, int gw, int NGW, int lane) {
    const float* ng = a.in(I_N1G) + layer * D; bf16* H = (bf16*)(a.ws() + WS_H);
    const float* mv = (const float*)(a.ws() + WS_MOD) + (size_t)(layer * 5 + 4) * 12288;
    const float* g2 = (const float*)(a.ws() + WS_MOD) + (size_t)((layer - 1) * 5 + 4) * 12288 + 5 * D;
    const float* part = (const float*)(a.ws() + WS_PART);
    for (int rc = gw; rc < NCTX; rc += NGW) {
        f32x4* xr = (f32x4*)(a.ws() + WS_XC + (size_t)rc * D * 4) + lane; f32x4 v[8]; float ss = 0.f;
#pragma unroll
        for (int j = 0; j < 8; ++j) { const int col = (lane + 64 * j) * 4; const float* pp = part + (size_t)rc * D + col;
            const f32x4 p = ((*(const f32x4*)pp + *(const f32x4*)(pp + (size_t)NCTX * D)) + *(const f32x4*)(pp + (size_t)2 * NCTX * D)) + *(const f32x4*)(pp + (size_t)3 * NCTX * D);
            v[j] = xr[64 * j] + *(const f32x4*)(g2 + col) * p; xr[64 * j] = v[j];
            ss += (v[j].x * v[j].x + v[j].y * v[j].y) + (v[j].z * v[j].z + v[j].w * v[j].w); }
        const float sm = wave_sum(ss); if (lane == 0) ((float*)(a.ws() + WS_RS1))[NLAT + rc] = 1.f / sqrtf(sm * (1.f / D) + EPS);
        u32x2* o8 = (u32x2*)(H + (size_t)(NLAT + rc) * D) + lane;
#pragma unroll
        for (int j = 0; j < 8; ++j) { const int col = (lane + 64 * j) * 4;
            const f32x4 y = v[j] * *(const f32x4*)(ng + col) * (*(const f32x4*)(mv + D + col) + 1.f);
            o8[64 * j] = (u32x2){pk2(y.x, y.y), pk2(y.z, y.w)}; }
    }
}

__device__ __forceinline__ void merge_ctx_rows(const PA& a, int gw, int NGW, int lane) {
    const float* part = (const float*)(a.ws() + WS_PART); bf16* MGp = (bf16*)(a.ws() + WS_MG);
    for (int rc = gw; rc < NCTX; rc += NGW) {
        u32x2* o8 = (u32x2*)(MGp + (size_t)(NLAT + rc) * D) + lane; f32x4 v[8];
#pragma unroll
        for (int j = 0; j < 8; ++j) { const int col = (lane + 64 * j) * 4; const float* pp = part + (size_t)rc * D + col;
            v[j] = ((*(const f32x4*)pp + *(const f32x4*)(pp + (size_t)NCTX * D)) + *(const f32x4*)(pp + (size_t)2 * NCTX * D)) + *(const f32x4*)(pp + (size_t)3 * NCTX * D); }
#pragma unroll
        for (int j = 0; j < 8; ++j) o8[64 * j] = (u32x2){pk2(v[j].x, v[j].y), pk2(v[j].z, v[j].w)};
    }
}
__device__ __forceinline__ void outproj_ctx_rows(const PA& a, int layer, int gw, int NGW, int lane) {
    const float* ng = a.in(I_N2G) + layer * D; bf16* H = (bf16*)(a.ws() + WS_H);
    const float* mv = (const float*)(a.ws() + WS_MOD) + (size_t)(layer * 5 + 4) * 12288;
    const float* part = (const float*)(a.ws() + WS_PART);
    const float* srcb = layer == 0 ? a.in(I_CTX) : (const float*)(a.ws() + WS_XC);
    for (int rc = gw; rc < NCTX; rc += NGW) {
        const f32x4* xs = (const f32x4*)(srcb + (size_t)rc * D) + lane; f32x4* xr = (f32x4*)(a.ws() + WS_XC + (size_t)rc * D * 4) + lane; f32x4 v[8]; float ss = 0.f;
#pragma unroll
        for (int j = 0; j < 8; ++j) { const int col = (lane + 64 * j) * 4; const float* pp = part + (size_t)rc * D + col;
            const f32x4 p = ((*(const f32x4*)pp + *(const f32x4*)(pp + (size_t)NCTX * D)) + *(const f32x4*)(pp + (size_t)2 * NCTX * D)) + *(const f32x4*)(pp + (size_t)3 * NCTX * D);
            v[j] = xs[64 * j] + *(const f32x4*)(mv + 2 * D + col) * p; }
#pragma unroll
        for (int j = 0; j < 8; ++j) { xr[64 * j] = v[j]; ss += (v[j].x * v[j].x + v[j].y * v[j].y) + (v[j].z * v[j].z + v[j].w * v[j].w); }
        const float sm = wave_sum(ss); if (lane == 0) ((float*)(a.ws() + WS_RS2))[NLAT + rc] = 1.f / sqrtf(sm * (1.f / D) + EPS);
        u32x2* o8 = (u32x2*)(H + (size_t)(NLAT + rc) * D) + lane;
#pragma unroll
        for (int j = 0; j < 8; ++j) { const int col = (lane + 64 * j) * 4;
            const f32x4 y = v[j] * *(const f32x4*)(ng + col) * (*(const f32x4*)(mv + 4 * D + col) + 1.f);
            o8[64 * j] = (u32x2){pk2(y.x, y.y), pk2(y.z, y.w)}; }
    }
}

__device__ __forceinline__ void final_rows(const PA& a, int gw, int NGW, int lane) {
    const float* fg = a.in(I_FINALG);
#pragma unroll 1
    for (int r0 = gw; r0 < NLAT; r0 += 2 * NGW) {
        f32x4 v[2][8]; float ss[2];
#pragma unroll
        for (int q = 0; q < 2; ++q) { const int r = r0 + q * NGW; const int rr = r < NLAT ? r : r0; const f32x4* xr = (const f32x4*)(a.out() + (size_t)rr * D) + lane; ss[q] = 0.f;
#pragma unroll
            for (int j = 0; j < 8; ++j) v[q][j] = xr[64 * j]; }
#pragma unroll
        for (int q = 0; q < 2; ++q) {
#pragma unroll
            for (int j = 0; j < 8; ++j) ss[q] += (v[q][j].x * v[q][j].x + v[q][j].y * v[q][j].y) + (v[q][j].z * v[q][j].z + v[q][j].w * v[q][j].w); }
#pragma unroll
        for (int q = 0; q < 2; ++q) ss[q] = wave_sum(ss[q]);
#pragma unroll
        for (int q = 0; q < 2; ++q) { const int r = r0 + q * NGW; if (r < NLAT) { const float rs = 1.f / sqrtf(ss[q] * (1.f / D) + EPS); f32x4* xw = (f32x4*)(a.out() + (size_t)r * D) + lane;
#pragma unroll
            for (int j = 0; j < 8; ++j) { const int col = (lane + 64 * j) * 4; xw[64 * j] = v[q][j] * rs * *(const f32x4*)(fg + col); } } }
    }
}

__device__ __forceinline__ void rs2_rows(const PA& a, int gtid, int nthr, int nrows, size_t rs_off = WS_RS2) {
    const f32x4* ps = (const f32x4*)(a.ws() + WS_PS); float* rs = (float*)(a.ws() + rs_off);
    for (int r = gtid; r < nrows; r += nthr) { float s = 0.f;
#pragma unroll
        for (int j = 0; j < 8; ++j) { const f32x4 p = ps[(size_t)r * 8 + j]; s += (p.x + p.y) + (p.z + p.w); }
        rs[r] = 1.f / sqrtf(s * (1.f / D) + EPS); }
}
__device__ __forceinline__ void shw_rows(const PA& a, int l, int shidx, const bf16* W, int N, float* out, const float* bias, LAS unsigned char* lds, int tid, int gw, int NGW) {
    LAS float* sh = (LAS float*)lds; const int lane = tid & 63;
    const float* mv = (const float*)(a.ws() + WS_MOD) + (size_t)l * 5 * 12288 + shidx * D;
    __syncthreads();
    { float t20[20];
#pragma unroll
      for (int j = 0; j < 20; ++j) { const int i = tid + 512 * j; t20[j] = mv[(size_t)(i >> 11) * 12288 + (i & 2047)]; }
#pragma unroll
      for (int j = 0; j < 20; ++j) sh[tid + 512 * j] = t20[j]; }
    __syncthreads();
    for (int n = gw; n < N; n += NGW) { float acc[5] = {0.f, 0.f, 0.f, 0.f, 0.f};
#pragma unroll
        for (int j = 0; j < 4; ++j) { const int k0 = j * 512 + lane * 8; const u32x4 x = *(const u32x4*)(W + (size_t)n * D + k0);
            const float wv[8] = {bflo(x.x), bfhi(x.x), bflo(x.y), bfhi(x.y), bflo(x.z), bfhi(x.z), bflo(x.w), bfhi(x.w)};
#pragma unroll
            for (int s = 0; s < 5; ++s) { const f32x4 h0 = *(const LAS f32x4*)(sh + s * 2048 + k0), h1 = *(const LAS f32x4*)(sh + s * 2048 + k0 + 4);
                acc[s] += (wv[0] * h0.x + wv[1] * h0.y) + (wv[2] * h0.z + wv[3] * h0.w) + (wv[4] * h1.x + wv[5] * h1.y) + (wv[6] * h1.z + wv[7] * h1.w); } }
        const float bn = bias ? bias[n] : 0.f;
#pragma unroll
        for (int s = 0; s < 5; ++s) { const float t = wave_sum(acc[s]); if (lane == 0) out[(size_t)s * N + n] = t + bn; } }
    __syncthreads();
}

__device__ __forceinline__ void neutral_norm1(const PA& a, int gtid, int nthr) {
    float* rs1 = (float*)(a.ws() + WS_RS1); float* si = (float*)(a.ws() + WS_SHWIN); float* sg = (float*)(a.ws() + WS_SHWG); const float* bg = a.in(I_BGATE);
    for (int i = gtid; i < NTOK; i += nthr) rs1[i] = 1.f;
    for (int i = gtid; i < 5 * INC; i += nthr) si[i] = 0.f;
    for (int i = gtid; i < 5 * DFF; i += nthr) sg[i] = bg[i % DFF];
}

using pg8::Unit;
#define EPI_LOOP _Pragma("unroll") for (int ai = 0; ai < 2; ++ai) _Pragma("unroll") for (int m = 0; m < 4; ++m) _Pragma("unroll") for (int bj = 0; bj < 2; ++bj)

struct EpiInProj {
    static constexpr bool PERM = true, AFTER_DRAIN = false;
    bf16 *ga, *yb, *q, *k, *vT, *vcT, *u; const f32x2* rope; const float* rs; const float* shw;
    __device__ __forceinline__ void operator()(const f32x4 (&acc)[2][2][4][2], const Unit& un, int wr, int wc, int fr, int fq) const {
        const int pn = un.pn, rbase = un.pm * 256 + wr * 64 + fr, cw = wc * 32 + 8 * fq;
        const bool lat = un.pm < (NLAT / 256);
        const float* sw = shw + (size_t)(lat ? (un.pm >> 5) : 4) * INC + pn * 256 + cw;
        f32x4 s0[2], s1[2]; float rr[2][4];
#pragma unroll
        for (int bj = 0; bj < 2; ++bj) { s0[bj] = *(const f32x4*)(sw + bj * 128); s1[bj] = *(const f32x4*)(sw + bj * 128 + 4); }
#pragma unroll
        for (int ai = 0; ai < 2; ++ai)
#pragma unroll
            for (int m = 0; m < 4; ++m) rr[ai][m] = rs[rbase + ai * 128 + m * 16];
        const bool ropetile = lat && pn >= 8 && pn <= 10; const int pih_ = cw & 63, half_ = pih_ >> 5, i0_ = (pih_ & 31) >> 1;
#pragma unroll
        for (int ai = 0; ai < 2; ++ai) {
        f32x4 rp[4][2];
        if (ropetile) {
#pragma unroll
            for (int m = 0; m < 4; ++m) { const int t = (rbase + ai * 128 + m * 16) & (SEQ - 1), pos = half_ ? (t & 63) : (t >> 6); const f32x4* rq = (const f32x4*)(rope + pos * 16 + i0_); rp[m][0] = rq[0]; rp[m][1] = rq[1]; } }
#pragma unroll
        for (int m = 0; m < 4; ++m)
#pragma unroll
        for (int bj = 0; bj < 2; ++bj) {
            const int row = rbase + ai * 128 + m * 16; const int ct = bj * 128 + cw;
            const f32x4 v0 = acc[ai][bj][m][0] * rr[ai][m] + s0[bj], v1 = acc[ai][bj][m][1] * rr[ai][m] + s1[bj];
            if (pn < 4) {
                u32x4 w; w.x = pk2(gelu_tanh(v0.x), gelu_tanh(v0.y)); w.y = pk2(gelu_tanh(v0.z), gelu_tanh(v0.w)); w.z = pk2(gelu_tanh(v1.x), gelu_tanh(v1.y)); w.w = pk2(gelu_tanh(v1.z), gelu_tanh(v1.w));
                *(u32x4*)(ga + (size_t)row * 1024 + pn * 256 + ct) = w;
            } else if (pn < 8) {
                u32x2 w; w.x = pk2(v0.x * sigmoidf_(v0.y), v0.z * sigmoidf_(v0.w)); w.y = pk2(v1.x * sigmoidf_(v1.y), v1.z * sigmoidf_(v1.w));
                *(u32x2*)(yb + (size_t)row * 512 + (((pn - 4) * 256 + ct) >> 1)) = w;
            } else if (pn < 10 || (pn == 10 && bj == 0)) {
                const bool isq = pn < 10; const int cs = isq ? (pn - 8) * 256 + ct : ct;
                float x[8] = {v0.x, v0.y, v0.z, v0.w, v1.x, v1.y, v1.z, v1.w};
                if (lat) { const f32x4 ra = rp[m][0], rb = rp[m][1]; const float cc[4] = {ra.x, ra.z, rb.x, rb.z}, sn[4] = {ra.y, ra.w, rb.y, rb.w};
#pragma unroll
                    for (int jj = 0; jj < 4; ++jj) { const float x1 = x[2 * jj], x2 = x[2 * jj + 1]; x[2 * jj] = x1 * cc[jj] - x2 * sn[jj]; x[2 * jj + 1] = x1 * sn[jj] + x2 * cc[jj]; } }
                const float sc = isq ? QSCALE : 1.f;
                u32x4 w; w.x = pk2(x[0] * sc, x[1] * sc); w.y = pk2(x[2] * sc, x[3] * sc); w.z = pk2(x[4] * sc, x[5] * sc); w.w = pk2(x[6] * sc, x[7] * sc);
                if (isq) *(u32x4*)(q + (size_t)row * 512 + cs) = w; else *(u32x4*)(k + (size_t)row * 128 + cs) = w;
            } else if (pn == 10) {
                const int dc = ct - 128; const float x[8] = {v0.x, v0.y, v0.z, v0.w, v1.x, v1.y, v1.z, v1.w};
                if (lat) { const int b = row >> 13, t = row & (SEQ - 1);
#pragma unroll
                    for (int e = 0; e < 8; ++e) vT[((size_t)(b * 128 + dc + e)) * SEQ + t] = (bf16)f2bf(x[e]); }
                else { const int rc = row - NLAT, b = rc >> 8, t = rc & 255;
#pragma unroll
                    for (int e = 0; e < 8; ++e) vcT[((size_t)(b * 128 + dc + e)) * CTXL + t] = (bf16)f2bf(x[e]); }
            } else {
                u32x4 w; w.x = pk2(v0.x, v0.y); w.y = pk2(v0.z, v0.w); w.z = pk2(v1.x, v1.y); w.w = pk2(v1.z, v1.w);
                const int col = (pn - 11) * 256 + ct;
                *(u32x4*)(u + ((size_t)(col >> 4) * NTOK + row) * 16 + (col & 15)) = w;
            }
        } }
    }
};
struct EpiGlu {
    static constexpr bool PERM = true, AFTER_DRAIN = false;
    bf16* o;
    __device__ __forceinline__ void operator()(const f32x4 (&acc)[2][2][4][2], const Unit& un, int wr, int wc, int fr, int fq) const {
        const int rbase = un.pm * 256 + wr * 64 + fr, cw = un.pn * 256 + wc * 32 + 8 * fq;
        EPI_LOOP { const int row = rbase + ai * 128 + m * 16; const f32x4 v0 = acc[ai][bj][m][0], v1 = acc[ai][bj][m][1];
            u32x2 w; w.x = pk2(v0.x * sigmoidf_(v0.y), v0.z * sigmoidf_(v0.w)); w.y = pk2(v1.x * sigmoidf_(v1.y), v1.z * sigmoidf_(v1.w));
            *(u32x2*)(o + (size_t)row * 512 + ((cw + bj * 128) >> 1)) = w; }
    }
};
template <int ACT  > struct EpiAct {
    static constexpr bool PERM = true, AFTER_DRAIN = false;
    bf16* o; const float* bias; int ldc, pad;
    __device__ __forceinline__ void operator()(const f32x4 (&acc)[2][2][4][2], const Unit& un, int wr, int wc, int fr, int fq) const {
        const int rbase = un.pm * 256 + wr * 64 + fr, cw = un.pn * 256 + wc * 32 + 8 * fq;
        f32x4 b0[2], b1[2];
#pragma unroll
        for (int bj = 0; bj < 2; ++bj) { b0[bj] = ACT == 0 ? *(const f32x4*)(bias + cw + bj * 128) : (f32x4){0.f, 0.f, 0.f, 0.f}; b1[bj] = ACT == 0 ? *(const f32x4*)(bias + cw + bj * 128 + 4) : (f32x4){0.f, 0.f, 0.f, 0.f}; }
        EPI_LOOP { const int row = rbase + ai * 128 + m * 16, col = cw + bj * 128; f32x4 v0 = acc[ai][bj][m][0], v1 = acc[ai][bj][m][1];
            if (ACT == 0) { v0 += b0[bj]; v1 += b1[bj];
                v0 = (f32x4){sigmoidf_(v0.x), sigmoidf_(v0.y), sigmoidf_(v0.z), sigmoidf_(v0.w)}; v1 = (f32x4){sigmoidf_(v1.x), sigmoidf_(v1.y), sigmoidf_(v1.z), sigmoidf_(v1.w)}; }
            else { v0 = __builtin_elementwise_max(v0, (f32x4){0.f, 0.f, 0.f, 0.f}); v1 = __builtin_elementwise_max(v1, (f32x4){0.f, 0.f, 0.f, 0.f}); v0 = v0 * v0; v1 = v1 * v1; }
            u32x4 w; w.x = pk2(v0.x, v0.y); w.y = pk2(v0.z, v0.w); w.z = pk2(v1.x, v1.y); w.w = pk2(v1.z, v1.w);
            *(u32x4*)(o + (size_t)row * ldc + col) = w; }
    }
};
struct EpiGate {
    static constexpr bool PERM = true, AFTER_DRAIN = false;
    bf16* o; const float* rs; const float* shw;
    __device__ __forceinline__ void operator()(const f32x4 (&acc)[2][2][4][2], const Unit& un, int wr, int wc, int fr, int fq) const {
        const int rbase = un.pm * 256 + wr * 64 + fr, cw = un.pn * 256 + wc * 32 + 8 * fq;
        const int slot = un.pm < (NLAT / 256) ? (un.pm >> 5) : 4; const float* sw = shw + (size_t)slot * DFF;
        f32x4 s0[2], s1[2]; float rr[2][4];
#pragma unroll
        for (int bj = 0; bj < 2; ++bj) { s0[bj] = *(const f32x4*)(sw + cw + bj * 128); s1[bj] = *(const f32x4*)(sw + cw + bj * 128 + 4); }
#pragma unroll
        for (int ai = 0; ai < 2; ++ai)
#pragma unroll
            for (int m = 0; m < 4; ++m) rr[ai][m] = rs[rbase + ai * 128 + m * 16];
        EPI_LOOP { const int row = rbase + ai * 128 + m * 16, col = cw + bj * 128; const float r = rr[ai][m];
            f32x4 v0 = acc[ai][bj][m][0] * r + s0[bj], v1 = acc[ai][bj][m][1] * r + s1[bj];
            v0 = (f32x4){sigmoidf_(v0.x), sigmoidf_(v0.y), sigmoidf_(v0.z), sigmoidf_(v0.w)}; v1 = (f32x4){sigmoidf_(v1.x), sigmoidf_(v1.y), sigmoidf_(v1.z), sigmoidf_(v1.w)};
            u32x4 w; w.x = pk2(v0.x, v0.y); w.y = pk2(v0.z, v0.w); w.z = pk2(v1.x, v1.y); w.w = pk2(v1.z, v1.w);
            *(u32x4*)(o + (size_t)row * DFF + col) = w; }
    }
};
struct EpiMerge {
    static constexpr bool PERM = true, AFTER_DRAIN = false;
    const bf16* gate; bf16* mg;
    __device__ __forceinline__ void operator()(const f32x4 (&acc)[2][2][4][2], const Unit& un, int wr, int wc, int fr, int fq) const {
        const int rbase = un.pm * 256 + wr * 64 + fr, cw = un.pn * 256 + wc * 32 + 8 * fq, kb = un.kb;
#pragma unroll
        for (int ai = 0; ai < 2; ++ai) {
            u32x4 ga_[4][2], pa_[4][2];
#pragma unroll
            for (int m = 0; m < 4; ++m)
#pragma unroll
                for (int bj = 0; bj < 2; ++bj) { const int row = rbase + ai * 128 + m * 16, col = cw + bj * 128; ga_[m][bj] = *(const u32x4*)(gate + (size_t)row * DFF + kb * D + col);
                    pa_[m][bj] = kb > 0 ? *(const u32x4*)(mg + (size_t)row * D + col) : (u32x4){0u, 0u, 0u, 0u}; }
#pragma unroll
            for (int m = 0; m < 4; ++m)
#pragma unroll
                for (int bj = 0; bj < 2; ++bj) { const int row = rbase + ai * 128 + m * 16, col = cw + bj * 128; const f32x4 v0 = acc[ai][bj][m][0], v1 = acc[ai][bj][m][1]; const u32x4 gw = ga_[m][bj], pm = pa_[m][bj];
                    const f32x4 r0 = (f32x4){bflo(gw.x) * v0.x, bfhi(gw.x) * v0.y, bflo(gw.y) * v0.z, bfhi(gw.y) * v0.w} + (f32x4){bflo(pm.x), bfhi(pm.x), bflo(pm.y), bfhi(pm.y)};
                    const f32x4 r1 = (f32x4){bflo(gw.z) * v1.x, bfhi(gw.z) * v1.y, bflo(gw.w) * v1.z, bfhi(gw.w) * v1.w} + (f32x4){bflo(pm.z), bfhi(pm.z), bflo(pm.w), bfhi(pm.w)};
                    u32x4 w; w.x = pk2(r0.x, r0.y); w.y = pk2(r0.z, r0.w); w.z = pk2(r1.x, r1.y); w.w = pk2(r1.z, r1.w); *(u32x4*)(mg + (size_t)row * D + col) = w; } }
    }
};
struct EpiMergePart {
    static constexpr bool PERM = true, AFTER_DRAIN = false;
    const bf16* gate; float* part;
    __device__ __forceinline__ void operator()(const f32x4 (&acc)[2][2][4][2], const Unit& un, int wr, int wc, int fr, int fq) const {
        const int rbase = un.pm * 256 + wr * 64 + fr, cw = un.pn * 256 + wc * 32 + 8 * fq, kb = un.kb;
        float* pb = part + (size_t)kb * NCTX * D;
#pragma unroll
        for (int ai = 0; ai < 2; ++ai) {
            u32x4 ga_[4][2];
#pragma unroll
            for (int m = 0; m < 4; ++m)
#pragma unroll
                for (int bj = 0; bj < 2; ++bj) ga_[m][bj] = *(const u32x4*)(gate + (size_t)(rbase + ai * 128 + m * 16) * DFF + kb * D + cw + bj * 128);
#pragma unroll
            for (int m = 0; m < 4; ++m)
#pragma unroll
                for (int bj = 0; bj < 2; ++bj) { const int row = rbase + ai * 128 + m * 16 - NLAT, col = cw + bj * 128; const f32x4 v0 = acc[ai][bj][m][0], v1 = acc[ai][bj][m][1]; const u32x4 gw = ga_[m][bj];
                    float* dp = pb + (size_t)row * D + col;
                    *(f32x4*)dp = (f32x4){bflo(gw.x) * v0.x, bfhi(gw.x) * v0.y, bflo(gw.y) * v0.z, bfhi(gw.y) * v0.w};
                    *(f32x4*)(dp + 4) = (f32x4){bflo(gw.z) * v1.x, bfhi(gw.z) * v1.y, bflo(gw.w) * v1.z, bfhi(gw.w) * v1.w}; } }
    }
};
struct EpiResidN {
    static constexpr bool PERM = true, AFTER_DRAIN = false;
    const float *srcl, *srcc; float *dstl, *dstc; const float* modg; bf16* xg; const float* ng2; const float* sc2; float* ps;
    __device__ __forceinline__ void operator()(const f32x4 (&acc)[2][2][4][2], const Unit& un, int wr, int wc, int fr_, int fq_) const {
        const int ln_ = lane_fresh(), fr = ln_ & 15, fq = ln_ >> 4; (void)fr_; (void)fq_;
        const int rbase = un.pm * 256 + wr * 64 + fr, cw = un.pn * 256 + wc * 32 + 8 * fq;
        const bool lat = un.pm < (NLAT / 256);
        const int slot = lat ? (un.pm >> 5) : 4;
        const float* src = lat ? srcl : srcc; float* dst = lat ? dstl : dstc; const int radj = lat ? 0 : NLAT;
        const float* gp = modg + (size_t)slot * 12288; const float* sp2 = sc2 + (size_t)slot * 12288;
        float ssq[2][4];
#pragma unroll
        for (int ai = 0; ai < 2; ++ai)
#pragma unroll
            for (int m = 0; m < 4; ++m) ssq[ai][m] = 0.f;
        f32x4 g0[2], g1[2], y0s[2], y1s[2];
#pragma unroll
        for (int bj = 0; bj < 2; ++bj) { const int col = cw + bj * 128; g0[bj] = *(const f32x4*)(gp + col); g1[bj] = *(const f32x4*)(gp + col + 4);
            y0s[bj] = *(const f32x4*)(ng2 + col) * (*(const f32x4*)(sp2 + col) + 1.f); y1s[bj] = *(const f32x4*)(ng2 + col + 4) * (*(const f32x4*)(sp2 + col + 4) + 1.f); }
#pragma unroll
        for (int ai = 0; ai < 2; ++ai) {
            f32x4 xa[4][2][2];
#pragma unroll
            for (int m = 0; m < 4; ++m)
#pragma unroll
                for (int bj = 0; bj < 2; ++bj) { const float* sp = src + (size_t)(rbase + ai * 128 + m * 16 - radj) * D + cw + bj * 128; xa[m][bj][0] = *(const f32x4*)sp; xa[m][bj][1] = *(const f32x4*)(sp + 4); }
#pragma unroll
            for (int m = 0; m < 4; ++m)
#pragma unroll
                for (int bj = 0; bj < 2; ++bj) { const int row = rbase + ai * 128 + m * 16, col = cw + bj * 128; const f32x4 v0 = acc[ai][bj][m][0], v1 = acc[ai][bj][m][1];
                    float* dp = dst + (size_t)(row - radj) * D + col;
                    const f32x4 x0 = xa[m][bj][0] + g0[bj] * v0, x1 = xa[m][bj][1] + g1[bj] * v1;
                    *(f32x4*)dp = x0; *(f32x4*)(dp + 4) = x1;
                    ssq[ai][m] += (x0.x * x0.x + x0.y * x0.y) + (x0.z * x0.z + x0.w * x0.w) + (x1.x * x1.x + x1.y * x1.y) + (x1.z * x1.z + x1.w * x1.w);
                    const f32x4 y0 = x0 * y0s[bj], y1 = x1 * y1s[bj];
                    u32x4 w; w.x = pk2(y0.x, y0.y); w.y = pk2(y0.z, y0.w); w.z = pk2(y1.x, y1.y); w.w = pk2(y1.z, y1.w); *(u32x4*)(xg + (size_t)row * D + col) = w; } }
#pragma unroll
        for (int ai = 0; ai < 2; ++ai)
#pragma unroll
            for (int m = 0; m < 4; ++m) { float s = ssq[ai][m]; s += shx<16>(s); s += shx<32>(s);
                if (fq == 0) ps[((size_t)(rbase + ai * 128 + m * 16) * 8 + un.pn) * 4 + wc] = s; }
    }
};
struct EpiFfn1 {
    static constexpr bool PERM = true, AFTER_DRAIN = false;
    bf16* o; const float* rs; const float* shw;
    __device__ __forceinline__ void operator()(const f32x4 (&acc)[2][2][4][2], const Unit& un, int wr, int wc, int fr, int fq) const {
        const int rbase = un.pm * 256 + wr * 64 + fr, cw = un.pn * 256 + wc * 32 + 8 * fq;
        const int slot = un.pm < (NLAT / 256) ? (un.pm >> 5) : 4; const float* sw = shw + (size_t)slot * DFF;
        f32x4 s0[2], s1[2]; float rr[2][4];
#pragma unroll
        for (int bj = 0; bj < 2; ++bj) { s0[bj] = *(const f32x4*)(sw + cw + bj * 128); s1[bj] = *(const f32x4*)(sw + cw + bj * 128 + 4); }
#pragma unroll
        for (int ai = 0; ai < 2; ++ai)
#pragma unroll
            for (int m = 0; m < 4; ++m) rr[ai][m] = rs[rbase + ai * 128 + m * 16];
        EPI_LOOP { const int row = rbase + ai * 128 + m * 16, col = cw + bj * 128; const float r = rr[ai][m];
            f32x4 v0 = acc[ai][bj][m][0] * r + s0[bj], v1 = acc[ai][bj][m][1] * r + s1[bj];
            v0 = __builtin_elementwise_max(v0, (f32x4){0.f, 0.f, 0.f, 0.f}); v1 = __builtin_elementwise_max(v1, (f32x4){0.f, 0.f, 0.f, 0.f}); v0 = v0 * v0; v1 = v1 * v1;
            u32x4 w; w.x = pk2(v0.x, v0.y); w.y = pk2(v0.z, v0.w); w.z = pk2(v1.x, v1.y); w.w = pk2(v1.z, v1.w);
            *(u32x4*)(o + (size_t)row * DFF + col) = w; }
    }
};
struct EpiPart {
    static constexpr bool PERM = true, AFTER_DRAIN = false;
    float* part;
    __device__ __forceinline__ void operator()(const f32x4 (&acc)[2][2][4][2], const Unit& un, int wr, int wc, int fr, int fq) const {
        const int rbase = un.pm * 256 + wr * 64 + fr - NLAT, cw = un.pn * 256 + wc * 32 + 8 * fq;
        float* pb = part + (size_t)un.kb * NCTX * D;
        EPI_LOOP { const int row = rbase + ai * 128 + m * 16, col = cw + bj * 128; float* dp = pb + (size_t)row * D + col; *(f32x4*)dp = acc[ai][bj][m][0]; *(f32x4*)(dp + 4) = acc[ai][bj][m][1]; }
    }
};
struct EpiResid {
    static constexpr bool PERM = true, AFTER_DRAIN = false;
    const float *srcl, *srcc; float *dstl, *dstc; const float* modg;
    __device__ __forceinline__ void operator()(const f32x4 (&acc)[2][2][4][2], const Unit& un, int wr, int wc, int fr, int fq) const {
        const int rbase = un.pm * 256 + wr * 64 + fr, cw = un.pn * 256 + wc * 32 + 8 * fq;
        const bool lat = un.pm < (NLAT / 256);
        const int slot = lat ? (un.pm >> 5) : 4;
        const float* src = lat ? srcl : srcc; float* dst = lat ? dstl : dstc; const int radj = lat ? 0 : NLAT;
        const float* gp = modg + (size_t)slot * 12288;
        f32x4 g0[2], g1[2];
#pragma unroll
        for (int bj = 0; bj < 2; ++bj) { g0[bj] = *(const f32x4*)(gp + cw + bj * 128); g1[bj] = *(const f32x4*)(gp + cw + bj * 128 + 4); }
#pragma unroll
        for (int ai = 0; ai < 2; ++ai) {
            f32x4 xa[4][2][2];
#pragma unroll
            for (int m = 0; m < 4; ++m)
#pragma unroll
                for (int bj = 0; bj < 2; ++bj) { const float* sp = src + (size_t)(rbase + ai * 128 + m * 16 - radj) * D + cw + bj * 128; xa[m][bj][0] = *(const f32x4*)sp; xa[m][bj][1] = *(const f32x4*)(sp + 4); }
#pragma unroll
            for (int m = 0; m < 4; ++m)
#pragma unroll
                for (int bj = 0; bj < 2; ++bj) { float* dp = dst + (size_t)(rbase + ai * 128 + m * 16 - radj) * D + cw + bj * 128;
                    *(f32x4*)dp = xa[m][bj][0] + g0[bj] * acc[ai][bj][m][0]; *(f32x4*)(dp + 4) = xa[m][bj][1] + g1[bj] * acc[ai][bj][m][1]; } }
    }
};

#define MFMA16(a, b, c) __builtin_amdgcn_mfma_f32_16x16x32_bf16((a), (b), (c), 0, 0, 0)
#define WAVE_LDS_SYNC() asm volatile("s_waitcnt lgkmcnt(0)" ::: "memory")
__device__ __forceinline__ void gmlp_unit(const PA& a, int l, int ch, LAS unsigned char* lds, int tid) {
    const int lane = tid & 63, w = tid >> 6, fr = lane & 15, kg = lane >> 4;
    LAS f32x2* st = (LAS f32x2*)lds; LAS bf16* vt = (LAS bf16*)(lds + 1024); LAS bf16* wsl = (LAS bf16*)(lds + 35840);
    const bf16* GA = (const bf16*)(a.ws() + WS_GA); bf16* BRA = (bf16*)(a.ws() + WS_BR); const bf16* GWS = (const bf16*)(a.ws() + WS_GWS);
    const float* lng = a.in(I_GLNG) + l * DB; const float* lnb = a.in(I_GLNB) + l * DB; const float* bs = a.in(I_GBS) + l * 512;
    const int row0 = ch * 128;
#pragma unroll 1
    for (int rr0 = 0; rr0 < 16; rr0 += 4) {
        float f[4][8], mean[4], rstd[4];
#pragma unroll
        for (int k = 0; k < 4; ++k) { const u32x4 x = *(const u32x4*)(GA + (size_t)(row0 + w * 16 + rr0 + k) * 1024 + 512 + lane * 8);
            f[k][0] = bflo(x.x); f[k][1] = bfhi(x.x); f[k][2] = bflo(x.y); f[k][3] = bfhi(x.y); f[k][4] = bflo(x.z); f[k][5] = bfhi(x.z); f[k][6] = bflo(x.w); f[k][7] = bfhi(x.w); }
#pragma unroll
        for (int k = 0; k < 4; ++k) { float s = 0.f;
#pragma unroll
            for (int e = 0; e < 8; ++e) s += f[k][e];
            mean[k] = wave_sum(s) * (1.f / 512.f); }
#pragma unroll
        for (int k = 0; k < 4; ++k) { float s2 = 0.f;
#pragma unroll
            for (int e = 0; e < 8; ++e) { const float d = f[k][e] - mean[k]; s2 += d * d; }
            rstd[k] = 1.f / sqrtf(wave_sum(s2) * (1.f / 512.f) + EPS); }
        if (lane == 0) {
#pragma unroll
            for (int k = 0; k < 4; ++k) st[w * 16 + rr0 + k] = (f32x2){mean[k], rstd[k]}; } }
    __syncthreads();
    for (int g = 0; g < 4; ++g) {
        { const int q = tid >> 2, cs = (tid & 3) * 32; const f32x2 ms = st[q];
#pragma unroll
            for (int k4 = 0; k4 < 4; ++k4) { const int c0 = cs + k4 * 8; const u32x4 x = *(const u32x4*)(GA + (size_t)(row0 + q) * 1024 + 512 + g * 128 + c0);
                const float f[8] = {bflo(x.x), bfhi(x.x), bflo(x.y), bfhi(x.y), bflo(x.z), bfhi(x.z), bflo(x.w), bfhi(x.w)};
                const f32x4 g0 = *(const f32x4*)(lng + g * 128 + c0), g1 = *(const f32x4*)(lng + g * 128 + c0 + 4), b0 = *(const f32x4*)(lnb + g * 128 + c0), b1 = *(const f32x4*)(lnb + g * 128 + c0 + 4);
                const float gg[8] = {g0.x, g0.y, g0.z, g0.w, g1.x, g1.y, g1.z, g1.w}, bb[8] = {b0.x, b0.y, b0.z, b0.w, b1.x, b1.y, b1.z, b1.w};
#pragma unroll
                for (int e = 0; e < 8; ++e) vt[(c0 + e) * 136 + q] = (bf16)f2bf((f[e] - ms.x) * ms.y * gg[e] + bb[e]); }
#pragma unroll
            for (int i = 0; i < 4; ++i) { const int c = tid + 512 * i, p = c >> 4, q8 = (c & 15) * 8;
                *(LAS u32x4*)(wsl + p * 136 + q8) = *(const u32x4*)(GWS + (size_t)(g * 128 + p) * 128 + q8); } }
        __syncthreads();
        f32x4 acc[8];
#pragma unroll
        for (int pt = 0; pt < 8; ++pt) acc[pt] = (f32x4){0.f, 0.f, 0.f, 0.f};
#pragma unroll
        for (int ks = 0; ks < 4; ++ks) { const bf16x8 afr = *(const LAS bf16x8*)(vt + (16 * w + fr) * 136 + ks * 32 + kg * 8);
#pragma unroll
            for (int pt = 0; pt < 8; ++pt) { const bf16x8 bfr = *(const LAS bf16x8*)(wsl + (pt * 16 + fr) * 136 + ks * 32 + kg * 8); acc[pt] = MFMA16(afr, bfr, acc[pt]); } }
        const int c0 = g * 128 + 16 * w + kg * 4;
        u32x2 uxs[8]; float bsps[8];
#pragma unroll
        for (int pt = 0; pt < 8; ++pt) { const int p = pt * 16 + fr; uxs[pt] = *(const u32x2*)(GA + (size_t)(row0 + p) * 1024 + c0); bsps[pt] = bs[g * 128 + p]; }
#pragma unroll
        for (int pt = 0; pt < 8; ++pt) { const int p = pt * 16 + fr; const u32x2 ux = uxs[pt]; const float bsp = bsps[pt];
            *(u32x2*)(BRA + (size_t)(row0 + p) * 512 + c0) = (u32x2){pk2(bflo(ux.x) * (acc[pt].x + bsp), bfhi(ux.x) * (acc[pt].y + bsp)), pk2(bflo(ux.y) * (acc[pt].z + bsp), bfhi(ux.y) * (acc[pt].w + bsp))}; }
        __syncthreads();
    }
}
__device__ __forceinline__ void conv_unit(const PA& a, int l, int un, LAS unsigned char* lds, int tid) {
    LAS float* ybuf = (LAS float*)lds;
    const bf16* YB = (const bf16*)(a.ws() + WS_YB); bf16* BRB = (bf16*)(a.ws() + WS_BR) + (size_t)NTOK * 512;
    const int lane = tid & 63, w = tid >> 6;
    const int t0 = un * 32; int s0, s1;
    if (t0 < NLAT) { s0 = t0 & ~(SEQ - 1); s1 = s0 + SEQ; } else { s0 = NLAT + ((t0 - NLAT) & ~(CTXL - 1)); s1 = s0 + CTXL; }
    const int cp = tid & 255, half = tid >> 8, rb = t0 + half * 16 - 15;
    const float* cw = a.in(I_CW) + (size_t)l * 31 * 512 + 2 * cp;
    f32x2 wt[31];
#pragma unroll
    for (int i = 0; i < 31; ++i) wt[i] = *(const f32x2*)(cw + i * 512);
    f32x2 o[16];
#pragma unroll
    for (int j = 0; j < 16; ++j) o[j] = (f32x2){0.f, 0.f};
    unsigned xin[46];
#pragma unroll
    for (int r = 0; r < 46; ++r) { const int row = rb + r, rc = row < s0 ? s0 : (row >= s1 ? s1 - 1 : row); xin[r] = *(const unsigned*)(YB + (size_t)rc * 512 + 2 * cp); }
#pragma unroll
    for (int r = 0; r < 46; ++r) { const int row = rb + r; const unsigned x = (row >= s0 && row < s1) ? xin[r] : 0u; const f32x2 v = (f32x2){bflo(x), bfhi(x)};
#pragma unroll
        for (int j = 0; j < 16; ++j) if (r - j >= 0 && r - j <= 30) o[j] += wt[r - j] * v; }
    const f32x2 cb = *(const f32x2*)(a.in(I_CB) + l * 512 + 2 * cp);
#pragma unroll
    for (int j = 0; j < 16; ++j) *(LAS f32x2*)(ybuf + (half * 16 + j) * 512 + 2 * cp) = o[j] + cb;
    __syncthreads();
    const float* lg = a.in(I_CLNG) + l * 512 + lane * 8; const float* lb = a.in(I_CLNB) + l * 512 + lane * 8;
    { float f[4][8], mean[4], rstd[4];
#pragma unroll
        for (int tt = 0; tt < 4; ++tt) { const int tok = 4 * w + tt; const f32x4 p0 = *(const LAS f32x4*)(ybuf + tok * 512 + lane * 8), p1 = *(const LAS f32x4*)(ybuf + tok * 512 + lane * 8 + 4);
            f[tt][0] = p0.x; f[tt][1] = p0.y; f[tt][2] = p0.z; f[tt][3] = p0.w; f[tt][4] = p1.x; f[tt][5] = p1.y; f[tt][6] = p1.z; f[tt][7] = p1.w; }
#pragma unroll
        for (int tt = 0; tt < 4; ++tt) { float s = 0.f;
#pragma unroll
            for (int e = 0; e < 8; ++e) s += f[tt][e];
            mean[tt] = wave_sum(s) * (1.f / 512.f); }
#pragma unroll
        for (int tt = 0; tt < 4; ++tt) { float s2 = 0.f;
#pragma unroll
            for (int e = 0; e < 8; ++e) { f[tt][e] -= mean[tt]; s2 += f[tt][e] * f[tt][e]; }
            rstd[tt] = 1.f / sqrtf(wave_sum(s2) * (1.f / 512.f) + EPS); }
        float lgv[8], lbv[8];
#pragma unroll
        for (int e = 0; e < 8; ++e) { lgv[e] = lg[e]; lbv[e] = lb[e]; }
#pragma unroll
        for (int tt = 0; tt < 4; ++tt) { float y[8];
#pragma unroll
            for (int e = 0; e < 8; ++e) y[e] = siluf_(f[tt][e] * rstd[tt] * lgv[e] + lbv[e]);
            u32x4 wv; wv.x = pk2(y[0], y[1]); wv.y = pk2(y[2], y[3]); wv.z = pk2(y[4], y[5]); wv.w = pk2(y[6], y[7]);
            *(u32x4*)(BRB + (size_t)(t0 + 4 * w + tt) * 512 + lane * 8) = wv; } }
    __syncthreads();
}

__device__ __forceinline__ void attn_unit(const PA& a, int l, int unit, LAS unsigned char* lds, int tid) {
    const int lane = tid & 63, w = tid >> 6, fr = lane & 15, kg = lane >> 4;
    LAS bf16* Kt = (LAS bf16*)lds; LAS bf16* Vt = (LAS bf16*)(lds + 18432); LAS bf16* P = (LAS bf16*)(lds + 35840 + w * 8704);
    const bf16* Q = (const bf16*)(a.ws() + WS_Q); const bf16* K = (const bf16*)(a.ws() + WS_K); const bf16* VT = (const bf16*)(a.ws() + WS_VT); const bf16* VCT = (const bf16*)(a.ws() + WS_VCT);
    bf16* BRC = (bf16*)(a.ws() + WS_BR) + (size_t)2 * NTOK * 512;
    int b, qblk, hkv, hp, qrow0; bool isctx;
    if (unit < 1024) { b = unit >> 8; qblk = (unit >> 2) & 63; hkv = (unit >> 1) & 1; hp = unit & 1; isctx = false; qrow0 = b * SEQ + qblk * 128; }
    else { const int uu = unit - 1024; b = uu >> 3; qblk = (uu >> 2) & 1; hkv = (uu >> 1) & 1; hp = uu & 1; isctx = true; qrow0 = NLAT + b * CTXL + qblk * 128; }
    const int hq0 = hkv * 4 + hp * 2;
    const bf16* qp = Q + (size_t)(qrow0 + 16 * w + fr) * 512 + hq0 * 64 + kg * 8;
    bf16x8 qf[2][2]; float mrow[2][4], lp[2][4]; f32x4 o[2][4];
#pragma unroll
    for (int h = 0; h < 2; ++h) { qf[h][0] = *(const bf16x8*)(qp + h * 64); qf[h][1] = *(const bf16x8*)(qp + h * 64 + 32); const float sinkv = a.in(I_SINK)[l * 8 + hq0 + h] * LOG2E;
#pragma unroll
        for (int j = 0; j < 4; ++j) { mrow[h][j] = sinkv; lp[h][j] = (fr == 0) ? 1.f : 0.f; o[h][j] = (f32x4){0.f, 0.f, 0.f, 0.f}; } }
    const int tfirst = isctx ? 3 : (qblk > 0 ? 0 : 1);
    u32x4 kq[2], vq[2];
#define ATT_TILE_PTRS(t, kbase, vbase, vp) do { if ((t) < 3) { const int kb_ = qblk + (t) - 1; kbase = K + (size_t)(b * SEQ + kb_ * 128) * 128 + hkv * 64; vbase = VT + (size_t)((b * 2 + hkv) * 64) * SEQ + kb_ * 128; vp = SEQ; } \
        else { kbase = K + (size_t)(NLAT + b * CTXL + ((t) - 3) * 128) * 128 + hkv * 64; vbase = VCT + (size_t)((b * 2 + hkv) * 64) * CTXL + ((t) - 3) * 128; vp = CTXL; } } while (0)
#define ATT_TILE_LOAD(t) do { const bf16* kb0_; const bf16* vb0_; int vp_; ATT_TILE_PTRS(t, kb0_, vb0_, vp_); \
        _Pragma("unroll") for (int i_ = 0; i_ < 2; ++i_) { const int c_ = tid + 512 * i_; kq[i_] = *(const u32x4*)(kb0_ + (size_t)(c_ >> 3) * 128 + (c_ & 7) * 8); vq[i_] = *(const u32x4*)(vb0_ + (size_t)(c_ >> 4) * vp_ + (c_ & 15) * 8); } } while (0)
    ATT_TILE_LOAD(tfirst);
    for (int t = tfirst; t < 5; ++t) {
        if (t == 2 && !isctx && qblk == 63) continue;
        __syncthreads();
#pragma unroll
        for (int i = 0; i < 2; ++i) { const int c = tid + 512 * i; *(LAS u32x4*)(Kt + (c >> 3) * 72 + (c & 7) * 8) = kq[i]; *(LAS u32x4*)(Vt + (c >> 4) * 136 + (c & 15) * 8) = vq[i]; }
        __syncthreads();
        { int tn = t + 1; if (tn == 2 && !isctx && qblk == 63) tn = 3; if (tn < 5) ATT_TILE_LOAD(tn); }
        {
            f32x4 s[2][8];
#pragma unroll
            for (int nt = 0; nt < 8; ++nt) { const LAS bf16* kp = Kt + (nt * 16 + fr) * 72 + kg * 8;
                const bf16x8 k0 = *(const LAS bf16x8*)kp, k1 = *(const LAS bf16x8*)(kp + 32);
#pragma unroll
                for (int h = 0; h < 2; ++h) { s[h][nt] = MFMA16(qf[h][0], k0, ((f32x4){0.f, 0.f, 0.f, 0.f})); s[h][nt] = MFMA16(qf[h][1], k1, s[h][nt]); } }
#pragma unroll
            for (int h = 0; h < 2; ++h) {
                LAS bf16* Ph = P + h * 2176;
                if (t == 0 || t == 2) {
#pragma unroll
                    for (int nt = 0; nt < 8; ++nt)
#pragma unroll
                        for (int j = 0; j < 4; ++j) { const int qi = 16 * w + kg * 4 + j, ki = nt * 16 + fr; const bool ok = (t == 0) ? (qi <= ki) : (ki <= qi); if (!ok) s[h][nt][j] = -1e30f; } }
                float alpha[4];
#pragma unroll
                for (int j = 0; j < 4; ++j) { float mx = s[h][0][j];
#pragma unroll
                    for (int nt = 1; nt < 8; ++nt) mx = fmaxf(mx, s[h][nt][j]);
                    mx = fmaxf(mx, shx<1>(mx)); mx = fmaxf(mx, shx<2>(mx)); mx = fmaxf(mx, shx<4>(mx)); mx = fmaxf(mx, shx<8>(mx));
                    const float mn = fmaxf(mrow[h][j], mx); alpha[j] = __builtin_amdgcn_exp2f(mrow[h][j] - mn); mrow[h][j] = mn; lp[h][j] *= alpha[j]; }
#pragma unroll
                for (int nt = 0; nt < 8; ++nt)
#pragma unroll
                    for (int j = 0; j < 4; ++j) { const float p = __builtin_amdgcn_exp2f(s[h][nt][j] - mrow[h][j]); lp[h][j] += p; Ph[(kg * 4 + j) * 136 + nt * 16 + fr] = (bf16)f2bf(p); }
#pragma unroll
                for (int dt = 0; dt < 4; ++dt) { o[h][dt][0] *= alpha[0]; o[h][dt][1] *= alpha[1]; o[h][dt][2] *= alpha[2]; o[h][dt][3] *= alpha[3]; }
            }
            WAVE_LDS_SYNC();
#pragma unroll
            for (int ks = 0; ks < 4; ++ks) { const bf16x8 pa0 = *(const LAS bf16x8*)(P + fr * 136 + ks * 32 + kg * 8), pa1 = *(const LAS bf16x8*)(P + 2176 + fr * 136 + ks * 32 + kg * 8);
#pragma unroll
                for (int dt = 0; dt < 4; ++dt) { const bf16x8 vb = *(const LAS bf16x8*)(Vt + (dt * 16 + fr) * 136 + ks * 32 + kg * 8); o[0][dt] = MFMA16(pa0, vb, o[0][dt]); o[1][dt] = MFMA16(pa1, vb, o[1][dt]); } }
            WAVE_LDS_SYNC();
        }
    }
#undef ATT_TILE_LOAD
#undef ATT_TILE_PTRS
#pragma unroll
    for (int h = 0; h < 2; ++h)
#pragma unroll
        for (int j = 0; j < 4; ++j) { float s = lp[h][j]; s += shx<1>(s); s += shx<2>(s); s += shx<4>(s); s += shx<8>(s); const float inv = 1.f / s;
#pragma unroll
            for (int dt = 0; dt < 4; ++dt) BRC[(size_t)(qrow0 + 16 * w + kg * 4 + j) * 512 + (hq0 + h) * 64 + dt * 16 + fr] = (bf16)f2bf(o[h][dt][j] * inv); }
}

__device__ __forceinline__ void s5disc_thread(const PA& a, int idx) {
    const int p = idx & 63, g = (idx >> 6) & 31, dir = (idx >> 11) & 1, l = idx >> 12;
    const double are = a.in(I_ARE)[idx], aim = a.in(I_AIM)[idx], dt = exp((double)a.in(I_LSTEP)[(l * 2 + dir) * 32 + g]);
    const double er = exp(are * dt), lrd = er * cos(aim * dt), lid = er * sin(aim * dt);
    const double den = are * are + aim * aim, cr = ((lrd - 1.0) * are + lid * aim) / den, ci = (lid * are - (lrd - 1.0) * aim) / den;
    float* dsc = (float*)(a.ws() + WS_S5DISC) + (size_t)idx * 34;
    dsc[0] = (float)lrd; dsc[1] = (float)lid;
    const float* bre = a.in(I_BRE) + (size_t)((l * 32 + g) * 64 + p) * 16; const float* bim = a.in(I_BIM) + (size_t)((l * 32 + g) * 64 + p) * 16;
    for (int c = 0; c < 16; ++c) { const double br = bre[c], bi = bim[c]; dsc[2 + c] = (float)(cr * br - ci * bi); dsc[18 + c] = (float)(cr * bi + ci * br); }
}
constexpr int NCHUNK = NTOK / 64;
constexpr size_t S5T_KT = 0, S5T_AS = 65536, S5T_AC = 65536 + 524288, S5T_BYTES = 65536 + 2 * 524288;
constexpr size_t WS_S5T = WS_YF;
constexpr size_t WS_SLOC = WS_S5T + 36 * MiB;
constexpr size_t WS_SIN = WS_SLOC + 18 * MiB;
constexpr size_t WS_LT = WS_SIN + 10 * MiB;
static_assert(WS_LT + 65536 <= WS_END, "S5 scratch inside the map");

__device__ __forceinline__ void s5_tables_unit(const PA& a, int l, int g, LAS unsigned char* lds, int tid) {
    LAS f32x2* pw = (LAS f32x2*)lds; LAS f32x2* Bb = (LAS f32x2*)(lds + 66560); LAS f32x2* Cc = (LAS f32x2*)(lds + 82944); LAS float* K0 = (LAS float*)(lds + 99328);
    unsigned char* tb = a.ws() + WS_S5T + (size_t)g * S5T_BYTES;
    bf16* KT = (bf16*)(tb + S5T_KT); bf16* AS = (bf16*)(tb + S5T_AS); bf16* AC = (bf16*)(tb + S5T_AC);
    if (tid < 128) {
        const int dir = tid >> 6, p = tid & 63, pi = ((l * 2 + dir) * 32 + g) * 64 + p;
        const float* dsc = (const float*)(a.ws() + WS_S5DISC) + (size_t)pi * 34;
        const double lr = dsc[0], li = dsc[1];
        float one_ = 1.f; asm volatile("" : "+v"(one_));
        double pr = (double)one_, pim = 0.0;
        for (int d = 0; d <= 64; ++d) { pw[(dir * 65 + d) * 64 + p] = (f32x2){(float)pr, (float)pim}; const double nr = pr * lr - pim * li, ni = pr * li + pim * lr; pr = nr; pim = ni; }
        ((f32x2*)(a.ws() + WS_LT))[(g * 2 + dir) * 64 + p] = pw[(dir * 65 + 64) * 64 + p];
        for (int c = 0; c < 16; ++c) Bb[(dir * 64 + p) * 16 + c] = (f32x2){dsc[2 + c], dsc[18 + c]};
    } else {
        for (int i = tid - 128; i < 2048; i += 384) { const int dir = i >> 10, o = (i >> 6) & 15, p = i & 63; const size_t ix = (size_t)(((l * 2 + dir) * 32 + g) * 16 + o) * 64 + p;
            Cc[i] = (f32x2){a.in(I_CRE)[ix], a.in(I_CIM)[ix]}; }
    }
    __syncthreads();
    {
        const int dir = tid >> 8, oc = tid & 255, o = oc >> 4, c = oc & 15;
        float K[64];
#pragma unroll
        for (int d = 0; d < 64; ++d) K[d] = 0.f;
        for (int p = 0; p < 64; ++p) { const f32x2 cc = Cc[(dir * 16 + o) * 64 + p], bb = Bb[(dir * 64 + p) * 16 + c]; const float cbr = cc.x * bb.x - cc.y * bb.y, cbi = cc.x * bb.y + cc.y * bb.x;
#pragma unroll
            for (int d = 0; d < 64; ++d) { const f32x2 w = pw[(dir * 65 + d) * 64 + p]; K[d] += cbr * w.x - cbi * w.y; } }
        K0[dir * 256 + oc] = K[0];
#pragma unroll
        for (int d = 1; d < 64; ++d) KT[(size_t)(dir == 0 ? 63 + d : 63 - d) * 256 + oc] = (bf16)f2bf(K[d]);
        __syncthreads();
        if (dir == 0) KT[(size_t)63 * 256 + oc] = (bf16)f2bf(K0[oc] + K0[256 + oc] + (o == c ? a.in(I_S5D)[l * 512 + g * 16 + o] : 0.f));
    }
    for (int it = tid; it < 32768; it += 512) {
        const int ch = it & 1, tau = (it >> 1) & 63, m = (it >> 7) & 127, dir = it >> 14, ri = m >> 6, p = m & 63, e = dir == 0 ? 63 - tau : tau;
        const f32x2 w = pw[(dir * 65 + e) * 64 + p]; float v[8];
#pragma unroll
        for (int j = 0; j < 8; ++j) { const f32x2 bb = Bb[(dir * 64 + p) * 16 + ch * 8 + j]; v[j] = ri ? (w.x * bb.y + w.y * bb.x) : (w.x * bb.x - w.y * bb.y); }
        u32x4 o4; o4.x = pk2(v[0], v[1]); o4.y = pk2(v[2], v[3]); o4.z = pk2(v[4], v[5]); o4.w = pk2(v[6], v[7]);
        *(u32x4*)(AS + (size_t)(dir * 128 + m) * 1024 + tau * 16 + ch * 8) = o4; }
    for (int it = tid; it < 32768; it += 512) {
        const int p8 = it & 7, ri = (it >> 3) & 1, o = (it >> 4) & 15, tau = (it >> 8) & 63, dir = it >> 14, e = dir == 0 ? tau + 1 : 64 - tau; float v[8];
#pragma unroll
        for (int j = 0; j < 8; ++j) { const int p = p8 * 8 + j; const f32x2 cc = Cc[(dir * 16 + o) * 64 + p], w = pw[(dir * 65 + e) * 64 + p]; v[j] = ri ? -(cc.x * w.y + cc.y * w.x) : (cc.x * w.x - cc.y * w.y); }
        u32x4 o4; o4.x = pk2(v[0], v[1]); o4.y = pk2(v[2], v[3]); o4.z = pk2(v[4], v[5]); o4.w = pk2(v[6], v[7]);
        *(u32x4*)(AC + (size_t)(dir * 1024 + tau * 16 + o) * 128 + ri * 64 + p8 * 8) = o4; }
    __syncthreads();
}
constexpr int S5U_PITCH = 2064;
__device__ __forceinline__ void s5_stage_u(const PA& a, int g, int nb, LAS unsigned char* lds, int tid) {
    const unsigned char* src = a.ws() + WS_U + ((size_t)g * NTOK + (size_t)nb * 48 * 64) * 32;
    __syncthreads();
    u32x4 tmp[12];
#pragma unroll
    for (int j = 0; j < 12; ++j) { const unsigned i = (unsigned)tid + 512u * j; tmp[j] = *(const u32x4*)(src + i * 16u); }
#pragma unroll
    for (int j = 0; j < 12; ++j) { const unsigned i = (unsigned)tid + 512u * j; *(LAS u32x4*)(lds + (i >> 7) * S5U_PITCH + (i & 127u) * 16u) = tmp[j]; }
    __syncthreads();
}
__device__ __forceinline__ void s5_state_unit(const PA& a, int unit, LAS unsigned char* lds, int tid) {
    const int lane = tid & 63, w = tid >> 6, fr = lane & 15, kg = lane >> 4;
    const int nb = unit % 11, g = unit / 11;
    s5_stage_u(a, g, nb, lds, tid);
    const bf16* AS = (const bf16*)(a.ws() + WS_S5T + (size_t)g * S5T_BYTES + S5T_AS) + (size_t)(16 * w + fr) * 1024 + kg * 8;
    const LAS unsigned char* ub = lds + fr * S5U_PITCH + (kg >> 1) * 32 + (kg & 1) * 16;
    f32x4 acc[2][3];
#pragma unroll
    for (int d = 0; d < 2; ++d)
#pragma unroll
        for (int nt = 0; nt < 3; ++nt) acc[d][nt] = (f32x4){0.f, 0.f, 0.f, 0.f};
#pragma unroll 4
    for (int ks = 0; ks < 32; ++ks) { const bf16x8 af0 = *(const bf16x8*)(AS + ks * 32), af1 = *(const bf16x8*)(AS + (size_t)128 * 1024 + ks * 32);
#pragma unroll
        for (int nt = 0; nt < 3; ++nt) { const bf16x8 bfr = *(const LAS bf16x8*)(ub + nt * 16 * S5U_PITCH + ks * 64); acc[0][nt] = MFMA16(af0, bfr, acc[0][nt]); acc[1][nt] = MFMA16(af1, bfr, acc[1][nt]); } }
    float* SL = (float*)(a.ws() + WS_SLOC);
#pragma unroll
    for (int d = 0; d < 2; ++d)
#pragma unroll
        for (int nt = 0; nt < 3; ++nt) { const int chunk = nb * 48 + nt * 16 + fr; *(f32x4*)(SL + (size_t)((chunk * 32 + g) * 2 + d) * 128 + 16 * w + kg * 4) = acc[d][nt]; }
}
#define S5C_CHUNK(i) ((i) < 4 ? 512 + b * 4 + (dir == 0 ? (i) : 3 - (i)) : b * 128 + (dir == 0 ? (i) - 4 : 131 - (i)))
#define S5C_LOAD(LR, LI, OFF, I0) _Pragma("unroll") for (int k = 0; k < 12; ++k) { OFF[k] = (size_t)((S5C_CHUNK((I0) + k) * 32 + g) * 2 + dir) * 128; LR[k] = SL[OFF[k] + p]; LI[k] = SL[OFF[k] + 64 + p]; }
#define S5C_FOLD(LR, LI, OFF) _Pragma("unroll") for (int k = 0; k < 12; ++k) { SI[OFF[k] + p] = (bf16)f2bf(sr); SI[OFF[k] + 64 + p] = (bf16)f2bf(si); \
        const float nr = lt.x * sr - lt.y * si + LR[k], ni = lt.x * si + lt.y * sr + LI[k]; sr = nr; si = ni; }
__device__ __forceinline__ void s5_carry_seq(const PA& a, int seq, int lane) {
    const int dir = seq & 1, g = (seq >> 1) & 31, b = seq >> 6, p = lane;
    const f32x2 lt = ((const f32x2*)(a.ws() + WS_LT))[(g * 2 + dir) * 64 + p];
    const float* SL = (const float*)(a.ws() + WS_SLOC); bf16* SI = (bf16*)(a.ws() + WS_SIN);
    float sr = 0.f, si = 0.f;
    float lrA[12], liA[12], lrB[12], liB[12]; size_t offA[12], offB[12];
    S5C_LOAD(lrA, liA, offA, 0)
#pragma unroll 1
    for (int i0 = 0; i0 < 120; i0 += 24) {
        S5C_LOAD(lrB, liB, offB, i0 + 12)
        S5C_FOLD(lrA, liA, offA)
        S5C_LOAD(lrA, liA, offA, i0 + 24)
        S5C_FOLD(lrB, liB, offB)
    }
    S5C_FOLD(lrA, liA, offA)
}
#undef S5C_CHUNK
#undef S5C_LOAD
#undef S5C_FOLD
__device__ __forceinline__ void s5_out_unit(const PA& a, int unit, LAS unsigned char* lds, int tid_) {
    int tid = tid_; asm volatile("" : "+v"(tid));
    const int lane = tid & 63, w = tid >> 6, fr = lane & 15, kg = lane >> 4;
    const int nb = unit % 11, g = unit / 11;
    s5_stage_u(a, g, nb, lds, tid);
    const unsigned char* tb = a.ws() + WS_S5T + (size_t)g * S5T_BYTES;
    const bf16* KT = (const bf16*)(tb + S5T_KT) + (size_t)(8 * w + 63 - (kg >> 1)) * 256 + fr * 16 + (kg & 1) * 8;
    const bf16* AC = (const bf16*)(tb + S5T_AC) + (size_t)(8 * w * 16 + fr) * 128 + kg * 8;
    const LAS unsigned char* ub = lds + fr * S5U_PITCH + (kg >> 1) * 32 + (kg & 1) * 16;
    const bf16* SI = (const bf16*)(a.ws() + WS_SIN) + (size_t)(((nb * 48 + fr) * 32 + g) * 2) * 128 + kg * 8;
    f32x4 acc[8][3];
#pragma unroll
    for (int i = 0; i < 8; ++i)
#pragma unroll
        for (int nt = 0; nt < 3; ++nt) acc[i][nt] = (f32x4){0.f, 0.f, 0.f, 0.f};
    bf16x8 W[8];
#pragma unroll
    for (int j = 0; j < 8; ++j) W[j] = *(const bf16x8*)(KT + j * 256);
#pragma unroll 1
    for (int kk = 0; kk < 8; ++kk) {
#pragma unroll
        for (int u = 0; u < 4; ++u) { const int ks = 4 * kk + u;
            if (ks > 0) { W[(16 - 2 * u) & 7] = *(const bf16x8*)(KT + (-2 * ks) * 256); W[(17 - 2 * u) & 7] = *(const bf16x8*)(KT + (-2 * ks + 1) * 256); }
            bf16x8 bfr[3];
#pragma unroll
            for (int nt = 0; nt < 3; ++nt) bfr[nt] = *(const LAS bf16x8*)(ub + nt * 16 * S5U_PITCH + ks * 64);
#pragma unroll
            for (int i = 0; i < 8; ++i)
#pragma unroll
                for (int nt = 0; nt < 3; ++nt) acc[i][nt] = MFMA16(W[(i + 16 - 2 * u) & 7], bfr[nt], acc[i][nt]); } }
#pragma unroll
    for (int dir = 0; dir < 2; ++dir)
#pragma unroll
        for (int ks = 0; ks < 4; ++ks) { bf16x8 bfr[3];
#pragma unroll
            for (int nt = 0; nt < 3; ++nt) bfr[nt] = *(const bf16x8*)(SI + (size_t)(nt * 16 * 32 * 2 + dir) * 128 + ks * 32);
#pragma unroll
            for (int i = 0; i < 8; ++i) { const bf16x8 af = *(const bf16x8*)(AC + (size_t)(dir * 1024 + i * 16) * 128 + ks * 32);
#pragma unroll
                for (int nt = 0; nt < 3; ++nt) acc[i][nt] = MFMA16(af, bfr[nt], acc[i][nt]); } }
    bf16* YG = (bf16*)(a.ws() + WS_YG);
#pragma unroll
    for (int i = 0; i < 8; ++i)
#pragma unroll
        for (int nt = 0; nt < 3; ++nt) { const int chunk = nb * 48 + nt * 16 + fr; const size_t row = (size_t)chunk * 64 + 8 * w + i; const f32x4 v = acc[i][nt];
            *(u32x2*)(YG + row * 512 + g * 16 + kg * 4) = (u32x2){pk2(gelu_tanh(v.x), gelu_tanh(v.y)), pk2(gelu_tanh(v.z), gelu_tanh(v.w))}; }
}

constexpr int RING_BYTES = 131072, MISC_OFF = RING_BYTES, LDS_BYTES = RING_BYTES + 1024;
#ifndef THIN_GRID
#define THIN_GRID 192
#endif
__device__ unsigned g_bar[64];
__device__ __forceinline__ void grid_barrier_counter(unsigned G) {
    asm volatile("s_waitcnt vmcnt(0)" ::: "memory");
    __syncthreads();
    if (threadIdx.x == 0) {
        __builtin_amdgcn_fence(__ATOMIC_RELEASE, "agent");
        asm volatile("s_waitcnt vmcnt(0)" ::: "memory");
        unsigned* ctr = &g_bar[0]; asm volatile("" : "+s"(ctr));
        const unsigned old = __hip_atomic_fetch_add(ctr, 1u, __ATOMIC_RELAXED, __HIP_MEMORY_SCOPE_AGENT);
        const unsigned target = (old / G + 1u) * G;
        unsigned sp = 0u;
        while ((int)(__hip_atomic_load(ctr, __ATOMIC_RELAXED, __HIP_MEMORY_SCOPE_AGENT) - target) < 0) { __builtin_amdgcn_s_sleep(2); if (++sp > (1u << 24)) break; }
        __builtin_amdgcn_fence(__ATOMIC_ACQUIRE, "agent");
        asm volatile("s_waitcnt vmcnt(0)" ::: "memory");
    }
    __syncthreads();
}
#ifdef USE_XCD_BAR
constexpr int CW_BAR = 4096; constexpr size_t CTL_ZERO_BYTES = 64 * 1024;
static_assert((CW_BAR + XCD_BAR_WORDS) * 4 <= (int)CTL_ZERO_BYTES, "barrier words inside the memset region");
#define GRID_BAR() do { XcdBarrier b_; b_.bar = (unsigned*)(a.ws() + WS_CTL) + CW_BAR; b_.x = xb_xcc_id(); b_.st = MISC + 8; xcd_barrier(b_); } while (0)
#else
#define GRID_BAR() do { int g_ = G0; asm volatile("" : "+s"(g_)); grid_barrier_counter((unsigned)g_); } while (0)
#endif
#define GEMM_PHASE(EpiT, Aptr, Bptr, M_, N_, K_, Eobj) do { pg8::Gemm g_{}; g_.A = (Aptr); g_.Bt = (Bptr); g_.M = (M_); g_.N = (N_); g_.K = (K_); g_.pad = 0; g_.sA = 0; g_.sB = 0; \
    pg8::StaticOrder S_; S_.init((M_), (N_), G, bid); pg8::gemm_phase<EpiT, pg8::StaticOrder, true, true>(ldsL, g_, S_, (Eobj), tid); } while (0)
#define PH_BEGIN int bid = bid0, G = Gsel; asm volatile("" : "+s"(bid), "+s"(G)); const int tid = FRESH_TID(), lane = tid & 63, wave = __builtin_amdgcn_readfirstlane(tid >> 6), gw = bid * 8 + wave, NGW = G * 8; unsigned char* ws = a.ws(); (void)lane; (void)gw; (void)NGW; (void)ws;
#define WSP(T, off) ((T*)(ws + (off)))
#define RUN(REPS, GSEL, ...) _Pragma("unroll 1") for (int rep_ = 0; rep_ < (REPS); ++rep_) { { const int Gsel = (GSEL); if (bid0 < Gsel) { __VA_ARGS__ } } GRID_BAR(); }
#define RUN2(REPS, GT, THINBODY, OTHERBODY) _Pragma("unroll 1") for (int rep_ = 0; rep_ < (REPS); ++rep_) { const int Gt_ = (GT); if (bid0 < Gt_) { const int Gsel = Gt_; THINBODY } else { const int Gsel = Ggemm; const int Gthin_ = Gt_; OTHERBODY } GRID_BAR(); }
#define GATES_EARLY(lo, hi) { PH_BEGIN EpiGate E; E.o = WSP(bf16, WS_G); E.rs = WSP(const float, WS_RS1); E.shw = WSP(const float, WS_SHWG); \
    pg8::Gemm g_{}; g_.A = WSP(const bf16, WS_H); g_.Bt = WSP(const bf16, WS_WG); g_.M = Mrows; g_.N = DFF; g_.K = D; g_.pad = 0; g_.sA = 0; g_.sB = 0; \
    pg8::RangeOrder S_; S_.init(Mrows, DFF, (lo), (hi), G - Gthin_, bid - Gthin_); pg8::gemm_phase<EpiGate, pg8::RangeOrder, true, true>(ldsL, g_, S_, E, tid); }
#ifndef GRID_C
#define GRID_C Gthin
#endif
#ifndef GRID_C2
#define GRID_C2 Gthin
#endif
#if defined(USE_XCD_BAR) && !defined(NO_CARRY_IN_C)
#define CARRY_IN_C 1
constexpr int CW_S5CNT = 8192;
#define CARRY_BLOCK(CB) __syncthreads(); \
    if (tid == 0) { unsigned* bar_ = (unsigned*)(ws + WS_CTL) + CW_BAR; unsigned* c_ = (unsigned*)(ws + WS_CTL) + CW_S5CNT + 64 * l; \
                    XB_SPIN(xb_ld(c_) < 352u, bar_); __builtin_amdgcn_fence(__ATOMIC_ACQUIRE, "agent"); asm volatile("s_waitcnt vmcnt(0)" ::: "memory"); } \
    __syncthreads(); \
    for (int s = (CB) * 8 + wave; s < 256; s += 32 * 8) s5_carry_seq(a, s, lane);
#endif
#ifndef GRID_D
#define GRID_D Gthin
#endif
#ifndef GRID_A
#define GRID_A Gthin
#endif
#ifndef ECR
#define ECR 5
#endif
#ifndef REP_GMLP
#define REP_GMLP 1
#endif
#ifndef REP_CONV
#define REP_CONV 1
#endif
#ifndef REP_ATTN
#define REP_ATTN 1
#endif
#ifndef REP_S5S
#define REP_S5S 1
#endif
#ifndef REP_A
#define REP_A 1
#endif
#ifndef REP_B
#define REP_B 1
#endif
#ifndef REP_C
#define REP_C 1
#endif
#ifndef REP_C2
#define REP_C2 1
#endif
#ifndef REP_D
#define REP_D 1
#endif
#ifndef REP_E
#define REP_E 1
#endif
#ifndef REP_F
#define REP_F 1
#endif
#ifndef REP_H
#define REP_H 1
#endif
#ifndef REP_I
#define REP_I 1
#endif

__global__ void __launch_bounds__(512, 2) mega_fwd(Args args) {
    extern __shared__ __attribute__((aligned(16))) unsigned char lds[];
    LAS unsigned char* ldsL = (LAS unsigned char*)lds;
    const int Ggemm = (int)gridDim.x, Gthin = Ggemm < THIN_GRID ? Ggemm : THIN_GRID;
    const int bid0 = blockIdx.x, G0 = gridDim.x, wave_s = __builtin_amdgcn_readfirstlane((int)threadIdx.x >> 6);
    volatile LAS unsigned* MISC = (volatile LAS unsigned*)(ldsL + MISC_OFF);
    PA a; a.tab = MISC + 64;
#ifdef USE_XCD_BAR
    if (threadIdx.x < 64) MISC[threadIdx.x] = 0u;
#endif
    if (threadIdx.x == 64) {
#pragma unroll
        for (int i = 0; i < 34; ++i) { const unsigned long long v = (unsigned long long)args.in[i]; a.tab[2 * i] = (unsigned)v; a.tab[2 * i + 1] = (unsigned)(v >> 32); }
        { const unsigned long long v = (unsigned long long)args.out; a.tab[68] = (unsigned)v; a.tab[69] = (unsigned)(v >> 32); }
        { const unsigned long long v = (unsigned long long)args.ws; a.tab[70] = (unsigned)v; a.tab[71] = (unsigned)(v >> 32); }
    }
    __syncthreads();
#ifdef USE_XCD_BAR
    { XcdBarrier bar0 = xcd_barrier_post((unsigned*)(a.ws() + WS_CTL) + CW_BAR, MISC + 8); (void)bar0; }
#endif

    RUN(1, Ggemm, { PH_BEGIN prologue_block(a, bid, ldsL, tid); if (bid >= 193 && bid < 193 + 32) s5disc_thread(a, (bid - 193) * 512 + tid); __syncthreads(); }
        { PH_BEGIN convert_layer(a, 0, (LAS float*)ldsL + wave * 32 * 65, gw, NGW, lane, bid * 512 + tid, G * 512); } )
    for (int l = 0; l < DEPTH; ++l) {
        const int Mrows = (l == DEPTH - 1) ? NLAT : NTOK;
        const int cb_ = (Ggemm - GRID_C >= 32) ? GRID_C : 0;
        const int eC = ECR * (Ggemm - GRID_C), eC2 = eC, eD = eC2 + 1 * (Ggemm - GRID_D);
        RUN(1, Ggemm,
            if (l == 0) {
            { PH_BEGIN for (int u = bid; u < 32; u += G) s5_tables_unit(a, l, u, ldsL, tid); }
            { PH_BEGIN norm_rows(a, l, 1, gw, NGW, lane, NTOK); neutral_norm1(a, bid * 512 + tid, G * 512); } }
            else {
            { PH_BEGIN rs2_rows(a, bid * 512 + tid, G * 512, NLAT, WS_RS1); norm_ctx_rows(a, l, gw, NGW, lane); }
            { PH_BEGIN shw_rows(a, l, 0, WSP(const bf16, WS_WIN), INC, WSP(float, WS_SHWIN), nullptr, ldsL, tid, gw, NGW); }
            { PH_BEGIN shw_rows(a, l, 0, WSP(const bf16, WS_WG), DFF, WSP(float, WS_SHWG), a.in(I_BGATE) + (size_t)l * 4 * D, ldsL, tid, gw, NGW); } } )
        RUN(REP_B, Ggemm,
            { PH_BEGIN EpiInProj E; E.ga = WSP(bf16, WS_GA); E.yb = WSP(bf16, WS_YB); E.q = WSP(bf16, WS_Q); E.k = WSP(bf16, WS_K); E.vT = WSP(bf16, WS_VT); E.vcT = WSP(bf16, WS_VCT); E.u = WSP(bf16, WS_U);
              E.rope = WSP(const f32x2, WS_ROPE); E.rs = WSP(const float, WS_RS1); E.shw = WSP(const float, WS_SHWIN); GEMM_PHASE(EpiInProj, WSP(const bf16, WS_H), WSP(const bf16, WS_WIN), NTOK, INC, D, E); } )
        RUN2(REP_C, GRID_C,
#ifdef CARRY_IN_C
            { PH_BEGIN unsigned n_ = 0u; for (int u = G - 1 - bid; u < 352; u += G) { s5_state_unit(a, u, ldsL, tid); ++n_; }
              asm volatile("s_waitcnt vmcnt(0)" ::: "memory"); __syncthreads();
              if (tid == 0) { __builtin_amdgcn_fence(__ATOMIC_RELEASE, "agent"); asm volatile("s_waitcnt vmcnt(0)" ::: "memory");
                              xb_add((unsigned*)(ws + WS_CTL) + CW_S5CNT + 64 * l, n_); } }
            { PH_BEGIN for (int u = G - 1 - bid; u < NTOK / 128; u += G) gmlp_unit(a, l, u, ldsL, tid); }
            { PH_BEGIN for (int u = bid; u < NTOK / 32; u += G) conv_unit(a, l, u, ldsL, tid); }
            { PH_BEGIN for (int u = bid; u < 1024 + 32; u += G) attn_unit(a, l, u, ldsL, tid); }
            { PH_BEGIN shw_rows(a, l, 3, WSP(const bf16, WS_WF1), DFF, WSP(float, WS_SHW), nullptr, ldsL, tid, gw, NGW); }
            { PH_BEGIN if (cb_ == 0 && bid < 32) { CARRY_BLOCK(bid) } },
#else
            { PH_BEGIN for (int r_ = 0; r_ < REP_GMLP; ++r_) for (int u = G - 1 - bid; u < NTOK / 128; u += G) gmlp_unit(a, l, u, ldsL, tid); }
            { PH_BEGIN for (int r_ = 0; r_ < REP_CONV; ++r_) for (int u = bid; u < NTOK / 32; u += G) conv_unit(a, l, u, ldsL, tid); }
            { PH_BEGIN for (int r_ = 0; r_ < REP_ATTN; ++r_) for (int u = bid; u < 1024 + 32; u += G) attn_unit(a, l, u, ldsL, tid); }
            { PH_BEGIN for (int r_ = 0; r_ < REP_S5S; ++r_) for (int u = G - 1 - bid; u < 352; u += G) s5_state_unit(a, u, ldsL, tid); }
            { PH_BEGIN shw_rows(a, l, 3, WSP(const bf16, WS_WF1), DFF, WSP(float, WS_SHW), nullptr, ldsL, tid, gw, NGW); },
#endif
#ifdef CARRY_IN_C
            GATES_EARLY(0, eC) { PH_BEGIN if (cb_ != 0 && bid - cb_ < 32) { CARRY_BLOCK(bid - cb_) } } )
#else
            GATES_EARLY(0, eC) )
#endif
#ifndef CARRY_IN_C
        RUN2(REP_C2, GRID_C2, { PH_BEGIN if ((wave & 3) == 0) for (int s = bid * 2 + (wave >> 2); s < 256; s += G * 2) s5_carry_seq(a, s, lane); }, GATES_EARLY(eC, eC2) )
#endif
        RUN2(REP_D, GRID_D, { PH_BEGIN for (int u = bid; u < 352; u += G) s5_out_unit(a, u, ldsL, tid); __syncthreads(); }, GATES_EARLY(eC2, eD) )
        RUN(REP_E, Ggemm,
            { PH_BEGIN EpiGlu E; E.o = WSP(bf16, WS_BR) + (size_t)3 * NTOK * 512; GEMM_PHASE(EpiGlu, WSP(const bf16, WS_YG), WSP(const bf16, WS_WGLU), Mrows, 1024, DB, E); }
            { PH_BEGIN EpiGate E; E.o = WSP(bf16, WS_G); E.rs = WSP(const float, WS_RS1); E.shw = WSP(const float, WS_SHWG);
              pg8::Gemm g_{}; g_.A = WSP(const bf16, WS_H); g_.Bt = WSP(const bf16, WS_WG); g_.M = Mrows; g_.N = DFF; g_.K = D; g_.pad = 0; g_.sA = 0; g_.sB = 0;
              pg8::RangeOrder S_; S_.init(Mrows, DFF, eD, 1 << 30, G, (bid + (G >> 1)) % G);
              pg8::gemm_phase<EpiGate, pg8::RangeOrder, true, true>(ldsL, g_, S_, E, tid); } )
        RUN(REP_F, Ggemm,
            { PH_BEGIN EpiMerge E; E.gate = WSP(const bf16, WS_G); E.mg = WSP(bf16, WS_MG);
              pg8::Gemm g_{}; g_.A = WSP(const bf16, WS_BR); g_.Bt = WSP(const bf16, WS_WBR); g_.M = NLAT; g_.N = D; g_.K = DB; g_.pad = 0; g_.sA = (size_t)NTOK * 512 * 2; g_.sB = (size_t)D * DB * 2;
              pg8::QuadOrder S_; S_.init(NLAT, D, G, bid); pg8::gemm_phase<EpiMerge, pg8::QuadOrder, true, true>(ldsL, g_, S_, E, tid); }
            if (l + 1 < DEPTH) {
            { PH_BEGIN EpiMergePart E; E.gate = WSP(const bf16, WS_G); E.part = WSP(float, WS_PART);
              pg8::Gemm g_{}; g_.A = WSP(const bf16, WS_BR); g_.Bt = WSP(const bf16, WS_WBR); g_.M = NTOK; g_.N = D; g_.K = DB; g_.pad = 0; g_.sA = (size_t)NTOK * 512 * 2; g_.sB = (size_t)D * DB * 2;
              pg8::SliceOrder S_; S_.init(NLAT / 256, NCTX / 256, D / 256, 128, bid >= G - 128 ? bid - (G - 128) : -1); pg8::gemm_phase<EpiMergePart, pg8::SliceOrder, true, true>(ldsL, g_, S_, E, tid); } } )
        if (l + 1 < DEPTH) { RUN(1, Ggemm, { PH_BEGIN merge_ctx_rows(a, gw, NGW, lane); } ) }
        RUN(1, Ggemm,
            { PH_BEGIN EpiResidN E; E.srcl = l == 0 ? a.in(I_X) : (const float*)a.out(); E.srcc = l == 0 ? a.in(I_CTX) : WSP(const float, WS_XC); E.dstl = a.out(); E.dstc = WSP(float, WS_XC);
              E.modg = WSP(const float, WS_MOD) + (size_t)l * 5 * 12288 + 2 * D; E.xg = WSP(bf16, WS_H); E.ng2 = a.in(I_N2G) + l * D; E.sc2 = WSP(const float, WS_MOD) + (size_t)l * 5 * 12288 + 4 * D; E.ps = WSP(float, WS_PS);
              GEMM_PHASE(EpiResidN, WSP(const bf16, WS_MG), WSP(const bf16, WS_WOUT), NLAT, D, D, E); }
            if (l + 1 < DEPTH) {
            { PH_BEGIN EpiPart E; E.part = WSP(float, WS_PART);
              pg8::Gemm g_{}; g_.A = WSP(const bf16, WS_MG); g_.Bt = WSP(const bf16, WS_WOUT); g_.M = NTOK; g_.N = D; g_.K = D / 4; g_.pad = D; g_.sA = (size_t)(D / 4) * 2; g_.sB = (size_t)(D / 4) * 2;
              pg8::SliceOrder S_; S_.init(NLAT / 256, NCTX / 256, D / 256, 128, bid < 128 ? bid : -1); pg8::gemm_phase<EpiPart, pg8::SliceOrder, true, true>(ldsL, g_, S_, E, tid); } } )
        RUN(REP_H, Ggemm, { PH_BEGIN rs2_rows(a, bid * 512 + tid, G * 512, NLAT); if (l + 1 < DEPTH) outproj_ctx_rows(a, l, gw, NGW, lane); } )
        RUN(REP_I, Ggemm,
            { PH_BEGIN EpiFfn1 E; E.o = WSP(bf16, WS_G); E.rs = WSP(const float, WS_RS2); E.shw = WSP(const float, WS_SHW); GEMM_PHASE(EpiFfn1, WSP(const bf16, WS_H), WSP(const bf16, WS_WF1), Mrows, DFF, D, E); } )
        RUN(1, Ggemm,
            if (l + 1 < DEPTH) {
            { PH_BEGIN EpiResidN E; E.srcl = a.out(); E.srcc = WSP(const float, WS_XC); E.dstl = a.out(); E.dstc = WSP(float, WS_XC); E.modg = WSP(const float, WS_MOD) + (size_t)l * 5 * 12288 + 5 * D;
              E.xg = WSP(bf16, WS_H); E.ng2 = a.in(I_N1G) + (l + 1) * D; E.sc2 = WSP(const float, WS_MOD) + (size_t)(l + 1) * 5 * 12288 + 1 * D; E.ps = WSP(float, WS_PS);
              GEMM_PHASE(EpiResidN, WSP(const bf16, WS_G), WSP(const bf16, (l & 1) ? WS_WF2B : WS_WF2), NLAT, D, DFF, E); } }
            else {
            { PH_BEGIN EpiResid E; E.srcl = a.out(); E.srcc = WSP(const float, WS_XC); E.dstl = a.out(); E.dstc = WSP(float, WS_XC); E.modg = WSP(const float, WS_MOD) + (size_t)l * 5 * 12288 + 5 * D;
              GEMM_PHASE(EpiResid, WSP(const bf16, WS_G), WSP(const bf16, (l & 1) ? WS_WF2B : WS_WF2), NLAT, D, DFF, E); } }
            if (l + 1 < DEPTH) {
            { PH_BEGIN EpiPart E; E.part = WSP(float, WS_PART);
              pg8::Gemm g_{}; g_.A = WSP(const bf16, WS_G); g_.Bt = WSP(const bf16, (l & 1) ? WS_WF2B : WS_WF2); g_.M = NTOK; g_.N = D; g_.K = DFF / 4; g_.pad = DFF; g_.sA = (size_t)(DFF / 4) * 2; g_.sB = (size_t)(DFF / 4) * 2;
              pg8::SliceOrder S_; S_.init(NLAT / 256, NCTX / 256, D / 256, 128, bid < 128 ? bid : -1); pg8::gemm_phase<EpiPart, pg8::SliceOrder, true, true>(ldsL, g_, S_, E, tid); }
            { PH_BEGIN constexpr int ISPLIT = 23000;
              if (bid >= 128 && bid < G - 32) convert_layer(a, l + 1, (LAS float*)ldsL + wave * 32 * 65, (bid - 128) * 8 + wave, (G - 160) * 8, lane, (bid - 128) * 512 + tid, (G - 160) * 512, 0, ISPLIT);
              else if (bid < 128) convert_layer(a, l + 1, (LAS float*)ldsL + wave * 32 * 65, bid * 8 + wave, 128 * 8, lane, bid * 512 + tid, 128 * 512, ISPLIT, 1 << 30); }
            { PH_BEGIN if (bid >= G - 32) s5_tables_unit(a, l + 1, bid - (G - 32), ldsL, tid); } } )
    }
    { const int Gsel = Ggemm; PH_BEGIN final_rows(a, gw, NGW, lane); }
}

extern "C" void kernel_launch(void* const* d_in, const int* in_sizes, int n_in, void* d_out, int out_size, void* d_ws, size_t ws_size, hipStream_t stream) {
    static int grid = 0;
    if (grid == 0) {
        if (n_in != 34 || ws_size < WS_TOTAL) { fprintf(stderr, "kernel_launch: unexpected n_in %d or ws_size %zu (< %zu)\n", n_in, ws_size, (size_t)WS_TOTAL); grid = -1; return; }
        int dev = 0, cus = 0, per_cu = 0;
        if (hipGetDevice(&dev) != hipSuccess || hipDeviceGetAttribute(&cus, hipDeviceAttributeMultiprocessorCount, dev) != hipSuccess) { grid = -1; return; }
        if (hipFuncSetAttribute((const void*)mega_fwd, hipFuncAttributeMaxDynamicSharedMemorySize, LDS_BYTES) != hipSuccess) { fprintf(stderr, "kernel_launch: hipFuncSetAttribute failed\n"); grid = -1; return; }
        if (hipOccupancyMaxActiveBlocksPerMultiprocessor(&per_cu, (const void*)mega_fwd, 512, LDS_BYTES) != hipSuccess || per_cu < 1) { fprintf(stderr, "kernel_launch: occupancy query says %d\n", per_cu); }
        (void)hipGetLastError();
        grid = cus;
        if (grid < 225) { fprintf(stderr, "kernel_launch: %d CUs: the prologue needs >= 225 workgroups\n", grid); grid = -1; return; }
    }
    if (grid < 0) return;
#ifdef USE_XCD_BAR
    (void)hipMemsetAsync((char*)d_ws + WS_CTL, 0, CTL_ZERO_BYTES, stream);
#endif
    Args a{}; for (int i = 0; i < 34; ++i) a.in[i] = (const float*)d_in[i]; a.out = (float*)d_out; a.ws = (unsigned char*)d_ws; a.layer = 0; a.which = 0;
    hipLaunchKernelGGL(mega_fwd, dim3(grid), dim3(512), LDS_BYTES, stream, a);
}
```
